# Optimizing an MI355X kernel written in HIP

```python
import math
import jax, jax.numpy as jnp
from jax import lax
import numpy as np

D_MODEL = 1024
BATCH = 2
SEQ = 8192
DEPTH = 4
DEC_BATCH = 32
DEC_SEQ = 8
PAST_LEN = 8192
PAGE_SIZE = 128

N_A_LAYERS = DEPTH // 2
N_B_LAYERS = DEPTH - N_A_LAYERS
EXPAND = 2
D_INNER = EXPAND * D_MODEL
SSM_HEADDIM = 64
SSM_HEADS = D_INNER // SSM_HEADDIM
SSM_GROUPS = 4
D_STATE = 128
CONV_K = 4
CONV_DIM = D_INNER + 2 * SSM_GROUPS * D_STATE
SSD_CHUNK = 128
M_IN_DIM = D_INNER + CONV_DIM + SSM_HEADS
ATT_HEAD_DIM = 64
ATT_HEADS = D_MODEL // ATT_HEAD_DIM
ATT_KV_HEADS = 4
ATT_REP = ATT_HEADS // ATT_KV_HEADS
DILATION_GROUPS = ((128, 1), (512, 4), (2048, 16))
N_DGROUPS = len(DILATION_GROUPS)
ATT_WIDTH = ATT_HEADS * ATT_HEAD_DIM
KV_DIM = 2 * N_DGROUPS * ATT_KV_HEADS * ATT_HEAD_DIM
Q_BLOCK = 128
ROPE_THETA = 10000.0
PLE_DIM = 256
EPS = 1e-6

kernel_name = 'yoco_ssd_dilated_swa_decoder_step'


def rms_norm(x, w):
    xf = x.astype(jnp.float32)
    y = xf * lax.rsqrt(jnp.mean(xf * xf, axis=-1, keepdims=True) + EPS)
    return (y * w.astype(jnp.float32)).astype(x.dtype)


def rope(x, pos):
    half = x.shape[-1] // 2
    inv = 1.0 / (ROPE_THETA ** (jnp.arange(half, dtype=jnp.float32) / half))
    ang = pos.astype(jnp.float32)[:, None] * inv[None, :]
    ang = ang.reshape((ang.shape[0],) + (1,) * (x.ndim - 3) + (half,))
    cos, sin = jnp.cos(ang), jnp.sin(ang)
    xf = x.astype(jnp.float32)
    x1, x2 = xf[..., :half], xf[..., half:]
    return jnp.concatenate([x1 * cos - x2 * sin, x2 * cos + x1 * sin], axis=-1).astype(x.dtype)


def ssd(x, dt, A, B, C, h0, chunk):
    b, L, nh, p = x.shape
    g, n = B.shape[2], B.shape[3]
    r = nh // g
    c = L // chunk
    f32 = jnp.float32
    x = x.astype(f32).reshape(b, c, chunk, g, r, p)
    dt = dt.astype(f32).reshape(b, c, chunk, g, r)
    B = B.astype(f32).reshape(b, c, chunk, g, n)
    C = C.astype(f32).reshape(b, c, chunk, g, n)
    acum = jnp.cumsum(dt * A.reshape(g, r), axis=2)
    causal = jnp.tril(jnp.ones((chunk, chunk), dtype=bool))
    seg = acum[:, :, :, None] - acum[:, :, None, :]
    decay_ls = jnp.exp(jnp.where(causal[None, None, :, :, None, None], seg, -jnp.inf))
    xdt = x * dt[..., None]
    cb = jnp.einsum('bclgn,bcsgn->bclsg', C, B)
    y_diag = jnp.einsum('bclsgr,bcsgrp->bclgrp', cb[..., None] * decay_ls, xdt)
    decay_end = jnp.exp(acum[:, :, -1:] - acum)
    states = jnp.einsum('bcsgn,bcsgrp->bcgrpn', B, xdt * decay_end[..., None])
    chunk_decay = jnp.exp(acum[:, :, -1])

    def step(h, inp):
        dec, st = inp
        return h * dec[..., None, None] + st, h

    h_final, h_in = lax.scan(step, h0.astype(f32).reshape(b, g, r, p, n),
                             (jnp.moveaxis(chunk_decay, 1, 0), jnp.moveaxis(states, 1, 0)))
    y_off = jnp.einsum('bclgn,cbgrpn->bclgrp', C, h_in) * jnp.exp(acum)[..., None]
    y = (y_diag + y_off).reshape(b, L, nh, p)
    return y, h_final.reshape(b, nh, p, n)


def mamba_mixer(u, conv_state, ssm_state, in_w, conv_w, conv_b, dt_bias, A_log, d_skip, norm_w, out_w):
    b, L, _ = u.shape
    proj = u @ in_w
    z = proj[..., :D_INNER]
    xbc = proj[..., D_INNER:D_INNER + CONV_DIM]
    dt_raw = proj[..., D_INNER + CONV_DIM:]
    xpad = jnp.concatenate([conv_state.astype(xbc.dtype), xbc], axis=1)
    new_conv = xpad[:, xpad.shape[1] - (CONV_K - 1):]
    acc = conv_b + xpad[:, 0:L] * conv_w[0]
    for k in range(1, CONV_K):
        acc = acc + xpad[:, k:k + L] * conv_w[k]
    xbc = jax.nn.silu(acc)
    xs = xbc[..., :D_INNER]
    Bm = xbc[..., D_INNER:D_INNER + SSM_GROUPS * D_STATE].reshape(b, L, SSM_GROUPS, D_STATE)
    Cm = xbc[..., D_INNER + SSM_GROUPS * D_STATE:].reshape(b, L, SSM_GROUPS, D_STATE)
    dt = jax.nn.softplus((dt_raw + dt_bias).astype(jnp.float32))
    A = -jnp.exp(A_log.astype(jnp.float32))
    xh = xs.reshape(b, L, SSM_HEADS, SSM_HEADDIM)
    y, h = ssd(xh, dt, A, Bm, Cm, ssm_state, math.gcd(L, SSD_CHUNK))
    y = y + xh.astype(jnp.float32) * d_skip.astype(jnp.float32)[:, None]
    y = y.reshape(b, L, D_INNER) * jax.nn.silu(z.astype(jnp.float32))
    yg = y.reshape(b, L, SSM_GROUPS, D_INNER // SSM_GROUPS)
    yg = yg * lax.rsqrt(jnp.mean(yg * yg, axis=-1, keepdims=True) + EPS)
    y = yg.reshape(b, L, D_INNER) * norm_w.astype(jnp.float32)
    return y.astype(u.dtype) @ out_w, new_conv, h.astype(ssm_state.dtype)


def shared_kv(h, pos, kv_norm_w, kv_w, k_norm_w):
    b, L, _ = h.shape
    kv = (rms_norm(h, kv_norm_w) @ kv_w).reshape(b, L, 2, N_DGROUPS, ATT_KV_HEADS, ATT_HEAD_DIM)
    k = rope(rms_norm(kv[:, :, 0], k_norm_w), pos)
    return k, kv[:, :, 1]


def dilated_attend(q, kv_groups, rows_groups):
    b, Lq = q.shape[:2]
    outs, lses = [], []
    for gi in range(N_DGROUPS):
        window, dil = DILATION_GROUPS[gi]
        k, v = kv_groups[gi]
        n_keys = window // dil + 1
        idx = rows_groups[gi][:, None] - dil * jnp.arange(n_keys, dtype=jnp.int32)[None, :]
        valid = idx >= 0
        idx = jnp.maximum(idx, 0)
        kg = jnp.take(k, idx, axis=1)
        vg = jnp.take(v, idx, axis=1)
        qg = q[:, :, gi].reshape(b, Lq, ATT_KV_HEADS, ATT_REP, ATT_HEAD_DIM)
        s = jnp.einsum('bqkrd,bqjkd->bqkrj', qg, kg).astype(jnp.float32)
        s = jnp.where(valid[None, :, None, None, :], s, -jnp.inf)
        lse = jax.nn.logsumexp(s, axis=-1)
        pr = jnp.exp(s - lse[..., None])
        o = jnp.einsum('bqkrj,bqjkd->bqkrd', pr.astype(vg.dtype), vg)
        outs.append(o.astype(jnp.float32))
        lses.append(lse)
    wts = jax.nn.softmax(jnp.stack(lses, axis=0), axis=0)
    o = jnp.sum(jnp.stack(outs, axis=0) * wts[..., None], axis=0)
    return o.reshape(b, Lq, ATT_HEADS, ATT_HEAD_DIM)


def prompt_attend(q, k, v):
    b, L = q.shape[:2]
    nb = L // Q_BLOCK
    kvs = [(k[:, :, g], v[:, :, g]) for g in range(N_DGROUPS)]
    qb = jnp.moveaxis(q.reshape((b, nb, Q_BLOCK) + q.shape[2:]), 1, 0)
    starts = jnp.arange(nb, dtype=jnp.int32) * Q_BLOCK

    def blk(args):
        qi, st = args
        rows = st + jnp.arange(Q_BLOCK, dtype=jnp.int32)
        return dilated_attend(qi, kvs, [rows] * N_DGROUPS)

    o = lax.map(blk, (qb, starts))
    return jnp.moveaxis(o, 0, 1).reshape(b, L, ATT_HEADS, ATT_HEAD_DIM)


def attn_mixer(u, pos, attend, in_w, q_norm_w, out_w):
    b, L, _ = u.shape
    proj = u @ in_w
    q = proj[..., :N_DGROUPS * ATT_WIDTH].reshape(b, L, N_DGROUPS, ATT_HEADS, ATT_HEAD_DIM)
    gate = proj[..., N_DGROUPS * ATT_WIDTH:]
    q = rope(rms_norm(q, q_norm_w), pos) * (ATT_HEAD_DIM ** -0.5)
    o = attend(q)
    y = o.reshape(b, L, ATT_WIDTH) * jax.nn.silu(gate.astype(jnp.float32))
    return y.astype(u.dtype) @ out_w


def ple_add(h, p_i, ple_w_i, gate_w_i, ple_norm_i):
    gate = jax.nn.sigmoid((rms_norm(h, ple_norm_i) @ gate_w_i).astype(jnp.float32))
    return h + (gate * (p_i @ ple_w_i).astype(jnp.float32)).astype(h.dtype)


def trunk(x, p, pos, conv_states, ssm_states, make_attend, W):
    h = x
    new_conv, new_ssm = [], []
    k_sh, v_sh, attend = None, None, None
    for i in range(DEPTH):
        if i < N_A_LAYERS:
            u = rms_norm(h, W['norm_w'][i])
            out, c_new, s_new = mamba_mixer(u, conv_states[i], ssm_states[i], W['m_in_w'][i], W['m_conv_w'][i],
                                            W['m_conv_b'][i], W['m_dt_bias'][i], W['m_A_log'][i], W['m_D'][i],
                                            W['m_norm_w'][i], W['m_out_w'][i])
            new_conv.append(c_new)
            new_ssm.append(s_new)
        else:
            if i == N_A_LAYERS:
                k_sh, v_sh = shared_kv(h, pos, W['kv_norm_w'], W['kv_w'], W['k_norm_w'])
                attend = make_attend(k_sh, v_sh)
            j = i - N_A_LAYERS
            u = rms_norm(h, W['norm_w'][i])
            out = attn_mixer(u, pos, attend, W['a_in_w'][j], W['a_q_norm_w'][j], W['a_out_w'][j])
        h = h + out
        h = ple_add(h, p[i], W['ple_w'][i], W['ple_gate_w'][i], W['ple_norm_w'][i])
    return h, jnp.stack(new_conv, axis=0), jnp.stack(new_ssm, axis=0), k_sh, v_sh


def setup_inputs(seed: int = 0) -> dict:
    key = jax.random.key(seed)
    ks = jax.random.split(key, 32)
    f32 = jnp.float32

    def nrm(k, shape):
        return jax.random.normal(k, shape, f32)

    dt0 = jnp.exp(jax.random.uniform(ks[0], (N_A_LAYERS, SSM_HEADS), f32) * (math.log(0.1) - math.log(0.001)) + math.log(0.001))
    dt_bias = dt0 + jnp.log(-jnp.expm1(-dt0))
    A_log = jnp.log(jax.random.uniform(ks[1], (N_A_LAYERS, SSM_HEADS), f32, 1.0, 16.0))
    win_len = [min(w, PAST_LEN) for (w, _) in DILATION_GROUPS]
    return {
        'x_prompt': nrm(ks[2], (BATCH, SEQ, D_MODEL)),
        'x_sample': nrm(ks[3], (DEC_BATCH, DEC_SEQ, D_MODEL)),
        'state_ssm': 0.1 * nrm(ks[4], (N_A_LAYERS, DEC_BATCH, SSM_HEADS, SSM_HEADDIM, D_STATE)),
        'state_conv': nrm(ks[5], (N_A_LAYERS, DEC_BATCH, CONV_K - 1, CONV_DIM)),
        'cache_kv_g1': nrm(ks[6], (DEC_BATCH, win_len[0], 2, ATT_KV_HEADS, ATT_HEAD_DIM)),
        'cache_kv_g2': nrm(ks[7], (DEC_BATCH, win_len[1], 2, ATT_KV_HEADS, ATT_HEAD_DIM)),
        'cache_kv_g3': nrm(ks[8], (DEC_BATCH, win_len[2], 2, ATT_KV_HEADS, ATT_HEAD_DIM)),
        'p_prompt': nrm(ks[9], (DEPTH, BATCH, SEQ, PLE_DIM)),
        'p_sample': nrm(ks[10], (DEPTH, DEC_BATCH, DEC_SEQ, PLE_DIM)),
        'norm_w': 1.0 + 0.02 * nrm(ks[11], (DEPTH, D_MODEL)),
        'm_in_w': nrm(ks[12], (N_A_LAYERS, D_MODEL, M_IN_DIM)) * D_MODEL ** -0.5,
        'm_conv_w': nrm(ks[13], (N_A_LAYERS, CONV_K, CONV_DIM)) * CONV_K ** -0.5,
        'm_conv_b': 0.02 * nrm(ks[14], (N_A_LAYERS, CONV_DIM)),
        'm_dt_bias': dt_bias,
        'm_A_log': A_log,
        'm_D': 1.0 + 0.02 * nrm(ks[15], (N_A_LAYERS, SSM_HEADS)),
        'm_norm_w': 1.0 + 0.02 * nrm(ks[16], (N_A_LAYERS, D_INNER)),
        'm_out_w': nrm(ks[17], (N_A_LAYERS, D_INNER, D_MODEL)) * D_INNER ** -0.5,
        'kv_norm_w': 1.0 + 0.02 * nrm(ks[18], (D_MODEL,)),
        'kv_w': nrm(ks[19], (D_MODEL, KV_DIM)) * D_MODEL ** -0.5,
        'k_norm_w': 1.0 + 0.02 * nrm(ks[20], (ATT_HEAD_DIM,)),
        'a_in_w': nrm(ks[21], (N_B_LAYERS, D_MODEL, (N_DGROUPS + 1) * ATT_WIDTH)) * D_MODEL ** -0.5,
        'a_q_norm_w': 1.0 + 0.02 * nrm(ks[22], (N_B_LAYERS, ATT_HEAD_DIM)),
        'a_out_w': nrm(ks[23], (N_B_LAYERS, ATT_WIDTH, D_MODEL)) * ATT_WIDTH ** -0.5,
        'ple_w': nrm(ks[24], (DEPTH, PLE_DIM, D_MODEL)) * PLE_DIM ** -0.5,
        'ple_gate_w': nrm(ks[25], (DEPTH, D_MODEL, D_MODEL)) * D_MODEL ** -0.5,
        'ple_norm_w': 1.0 + 0.02 * nrm(ks[26], (DEPTH, D_MODEL)),
    }


def reference(x_prompt, x_sample, state_ssm, state_conv, cache_kv_g1, cache_kv_g2, cache_kv_g3,
              p_prompt, p_sample, norm_w, m_in_w, m_conv_w, m_conv_b, m_dt_bias, m_A_log, m_D,
              m_norm_w, m_out_w, kv_norm_w, kv_w, k_norm_w, a_in_w, a_q_norm_w, a_out_w,
              ple_w, ple_gate_w, ple_norm_w):
    W = {'norm_w': norm_w, 'm_in_w': m_in_w, 'm_conv_w': m_conv_w, 'm_conv_b': m_conv_b,
         'm_dt_bias': m_dt_bias, 'm_A_log': m_A_log, 'm_D': m_D, 'm_norm_w': m_norm_w,
         'm_out_w': m_out_w, 'kv_norm_w': kv_norm_w, 'kv_w': kv_w, 'k_norm_w': k_norm_w,
         'a_in_w': a_in_w, 'a_q_norm_w': a_q_norm_w, 'a_out_w': a_out_w, 'ple_w': ple_w,
         'ple_gate_w': ple_gate_w, 'ple_norm_w': ple_norm_w}

    b_p, seq = x_prompt.shape[0], x_prompt.shape[1]
    pos_p = jnp.arange(seq, dtype=jnp.int32)
    conv0 = jnp.zeros((N_A_LAYERS, b_p, CONV_K - 1, CONV_DIM), x_prompt.dtype)
    ssm0 = jnp.zeros((N_A_LAYERS, b_p, SSM_HEADS, SSM_HEADDIM, D_STATE), x_prompt.dtype)
    y_prompt, conv_p, ssm_p, k_p, v_p = trunk(x_prompt, p_prompt, pos_p, conv0, ssm0,
                                              lambda k, v: (lambda q: prompt_attend(q, k, v)), W)
    lw = [min(w, seq) for (w, _) in DILATION_GROUPS]
    kv_p1 = jnp.stack([k_p[:, seq - lw[0]:, 0], v_p[:, seq - lw[0]:, 0]], axis=2)
    kv_p2 = jnp.stack([k_p[:, seq - lw[1]:, 1], v_p[:, seq - lw[1]:, 1]], axis=2)
    kv_p3 = jnp.stack([k_p[:, seq - lw[2]:, 2], v_p[:, seq - lw[2]:, 2]], axis=2)

    dec_seq = x_sample.shape[1]
    pos_s = PAST_LEN + jnp.arange(dec_seq, dtype=jnp.int32)
    caches = (cache_kv_g1, cache_kv_g2, cache_kv_g3)

    def sample_make_attend(k, v):
        kvs = [(jnp.concatenate([caches[g][:, :, 0].astype(k.dtype), k[:, :, g]], axis=1),
                jnp.concatenate([caches[g][:, :, 1].astype(v.dtype), v[:, :, g]], axis=1))
               for g in range(N_DGROUPS)]
        rows = [caches[g].shape[1] + jnp.arange(dec_seq, dtype=jnp.int32) for g in range(N_DGROUPS)]
        return lambda q: dilated_attend(q, kvs, rows)

    y_sample, conv_s, ssm_s, k_s, v_s = trunk(x_sample, p_sample, pos_s, state_conv, state_ssm,
                                              sample_make_attend, W)
    kv_s1 = jnp.stack([k_s[:, :, 0], v_s[:, :, 0]], axis=2)
    kv_s2 = jnp.stack([k_s[:, :, 1], v_s[:, :, 1]], axis=2)
    kv_s3 = jnp.stack([k_s[:, :, 2], v_s[:, :, 2]], axis=2)
    return (y_prompt, y_sample, ssm_p, conv_p, ssm_s, conv_s, kv_p1, kv_p2, kv_p3, kv_s1, kv_s2, kv_s3)
```

```cpp
#include <hip/hip_runtime.h>
#include <cstdio>
#include <cstdint>

#define LAS __attribute__((address_space(3)))
#define RLX_AGENT __ATOMIC_RELAXED, __HIP_MEMORY_SCOPE_AGENT
typedef unsigned short bf16;
typedef float f32x4 __attribute__((ext_vector_type(4)));
typedef float f32x2 __attribute__((ext_vector_type(2)));
typedef unsigned u32x4 __attribute__((ext_vector_type(4)));
typedef unsigned u32x2 __attribute__((ext_vector_type(2)));
typedef short bf16x8 __attribute__((ext_vector_type(8)));
typedef __bf16 bf16x2_t __attribute__((ext_vector_type(2)));

__device__ __forceinline__ unsigned pk2(float lo, float hi) { f32x2 v = {lo, hi}; bf16x2_t b = __builtin_convertvector(v, bf16x2_t); return __builtin_bit_cast(unsigned, b); }
__device__ __forceinline__ float bflo(unsigned u) { return __uint_as_float(u << 16); }
__device__ __forceinline__ float bfhi(unsigned u) { return __uint_as_float(u & 0xffff0000u); }
__device__ __forceinline__ float bf1(bf16 h) { return __uint_as_float(((unsigned)h) << 16); }
__device__ __forceinline__ void unpack8(const u32x4 v, float* f) { f[0] = bflo(v.x); f[1] = bfhi(v.x); f[2] = bflo(v.y); f[3] = bfhi(v.y); f[4] = bflo(v.z); f[5] = bfhi(v.z); f[6] = bflo(v.w); f[7] = bfhi(v.w); }
__device__ __forceinline__ u32x4 pack8(const float* f) { u32x4 v; v.x = pk2(f[0], f[1]); v.y = pk2(f[2], f[3]); v.z = pk2(f[4], f[5]); v.w = pk2(f[6], f[7]); return v; }
__device__ __forceinline__ float silu_f(float x) { return x / (1.f + __expf(-x)); }
__device__ __forceinline__ float sigmoid_f(float x) { return 1.f / (1.f + __expf(-x)); }
__device__ __forceinline__ float softplus_f(float x) { return x > 20.f ? x : log1pf(__expf(x)); }
__device__ __forceinline__ float wave_sum(float v) {
#pragma unroll
    for (int o = 1; o < 64; o <<= 1) v += __shfl_xor(v, o);
    return v;
}
__device__ __forceinline__ float wave_max(float v) {
#pragma unroll
    for (int o = 1; o < 64; o <<= 1) v = fmaxf(v, __shfl_xor(v, o));
    return v;
}

#define XB_TMO      128
#define XB_XCNT(j)  (256  + 64 * (j))
#define XB_XSUB(j)  (1280 + 64 * (j))
#define XB_XGEN(j)  (2304 + 64 * (j))
#define XB_TOP      3328
#define XB_TOPGEN   3392
#define XCD_BAR_WORDS 3456
#define XB_SPIN_CAP (1u << 18)

__device__ __forceinline__ unsigned xb_ld(unsigned* p)              { return __hip_atomic_load(p, __ATOMIC_RELAXED, __HIP_MEMORY_SCOPE_AGENT); }
__device__ __forceinline__ unsigned xb_add(unsigned* p, unsigned v) { return __hip_atomic_fetch_add(p, v, __ATOMIC_RELAXED, __HIP_MEMORY_SCOPE_AGENT); }
__device__ __forceinline__ unsigned xb_xcc_id() { return (unsigned)__builtin_amdgcn_s_getreg((3 << 11) | 20) & 0xFu; }
#define XB_SPIN(cond, bar) do { unsigned _sp = 0; while (cond) { __builtin_amdgcn_s_sleep(1); \
    if ((++_sp & 255u) == 0u) { if (xb_ld(&(bar)[XB_TMO])) break; if (_sp > XB_SPIN_CAP) { atomicAdd(&(bar)[XB_TMO], 1u); break; } } } } while (0)

struct XcdBarrier { unsigned* bar; unsigned x; volatile LAS unsigned* st; };

__device__ __forceinline__ XcdBarrier xcd_barrier_post(unsigned* bar, volatile LAS unsigned* st) {
    XcdBarrier b; b.bar = bar; b.x = xb_xcc_id(); b.st = st;
    if (threadIdx.x == 0) (void)xb_add(&bar[XB_XCNT(b.x)], 1u);
    return b;
}
__device__ __forceinline__ void xcd_barrier_complete(unsigned* bar, unsigned x, unsigned& nloc, unsigned& nx) {
    const unsigned G = gridDim.x * gridDim.y * gridDim.z;
    unsigned sum, cnt, mine, sp = 0u;
    for (;;) {
        sum = 0u; cnt = 0u; mine = 0u;
#pragma unroll
        for (unsigned j = 0; j < 16; ++j) { const unsigned c = xb_ld(&bar[XB_XCNT(j)]); sum += c; cnt += (c > 0u) ? 1u : 0u; mine = (j == x) ? c : mine; }
        if (sum == G) break;
        __builtin_amdgcn_s_sleep(1);
        if ((++sp & 255u) == 0u) { if (xb_ld(&bar[XB_TMO])) break; if (sp > XB_SPIN_CAP) { atomicAdd(&bar[XB_TMO], 1u); break; } }
    }
    nloc = mine > 0u ? mine : 1u; nx = cnt > 0u ? cnt : 1u;
}
__device__ __forceinline__ void xcd_barrier(const XcdBarrier& b) {
    asm volatile("s_waitcnt vmcnt(0)" ::: "memory");
    __syncthreads();
    if (threadIdx.x == 0) {
        unsigned* bar = b.bar;
        __builtin_amdgcn_s_waitcnt(0);
        unsigned nloc = b.st[0], nx = b.st[1];
        if (nloc == 0u) { xcd_barrier_complete(bar, b.x, nloc, nx); b.st[0] = nloc; b.st[1] = nx; }
        const unsigned old = xb_add(&bar[XB_XSUB(b.x)], 1u);
        const unsigned gen = old / nloc;
        if (old + 1u == (gen + 1u) * nloc) {
            __builtin_amdgcn_fence(__ATOMIC_RELEASE, "agent");
            asm volatile("s_waitcnt vmcnt(0)" ::: "memory");
            const unsigned og = xb_add(&bar[XB_TOP], 1u);
            const unsigned tg = og / nx;
            if (og + 1u == (tg + 1u) * nx) xb_add(&bar[XB_TOPGEN], 1u);
            else XB_SPIN(xb_ld(&bar[XB_TOPGEN]) == tg, bar);
            __builtin_amdgcn_fence(__ATOMIC_ACQUIRE, "agent");
            xb_add(&bar[XB_XGEN(b.x)], 1u);
            asm volatile("s_waitcnt vmcnt(0)" ::: "memory");
        } else {
            XB_SPIN(xb_ld(&bar[XB_XGEN(b.x)]) == gen, bar);
            __builtin_amdgcn_fence(__ATOMIC_ACQUIRE, "agent");
            asm volatile("s_waitcnt vmcnt(0)" ::: "memory");
        }
    }
    __syncthreads();
}
namespace pg8 {
#define PG8_LAS __attribute__((address_space(3)))
typedef unsigned short bf16_t;
typedef short bf16x8 __attribute__((ext_vector_type(8)));
typedef float f32x4 __attribute__((ext_vector_type(4)));
typedef unsigned u32x4 __attribute__((ext_vector_type(4)));
constexpr int BM = 256, BK = 64, HALF = 128, HTB = HALF * BK * 2  , STAGE_BYTES = 8 * HTB, NXCD = 8, WGM = 8;

__host__ __device__ __forceinline__ int lds_byte(int r, int c) { const int st = (r >> 4) * 2 + (c >> 5), rr = r & 15, cc = c & 31, ob = rr * 64 + cc * 2; return st * 1024 + (ob ^ (((ob >> 9) & 1) << 5)); }
__host__ __device__ __forceinline__ void stage_rc(int b, int& R, int& C) { const int st = b / 1024, sb = b % 1024, swz = sb ^ (((sb >> 9) & 1) << 5); R = (st >> 1) * 16 + swz / 64; C = (st & 1) * 32 + (swz % 64) / 2; }
__host__ __device__ __forceinline__ int perm32(int rho) { const int n = rho >> 4, i = rho & 15; return 8 * (i >> 2) + 4 * n + (i & 3); }

struct Unit { int pm, pn; };
struct Gemm { const bf16_t* A; const bf16_t* Bt; int M, N, K; };

struct StaticOrder {
    int nM, nN, nwg, G, c;
    __host__ __device__ void init(int M, int N, int G_, int c_) { nM = M / BM; nN = N / BM; nwg = nM * nN; G = G_; c = c_; }
    __host__ __device__ bool next(int i, Unit& u) const {
        const long L = (long)i * G + c; if (L >= nwg) return false;
        int wgid = (int)L; { const int q = nwg / NXCD, r = nwg % NXCD, xcd = wgid % NXCD, off = wgid / NXCD; wgid = (xcd < r ? xcd * (q + 1) : r * (q + 1) + (xcd - r) * q) + off; }
        const int nig = WGM * nN, gid = wgid / nig, fm = gid * WGM, gsz = (nM - fm) < WGM ? (nM - fm) : WGM;
        u.pm = fm + ((wgid % nig) % gsz); u.pn = (wgid % nig) / gsz; return true;
    }
    __device__ __forceinline__ void a_ready(const Unit&) const {}
    __device__ __forceinline__ void done(const Unit&) const {}
};

template <class Epi, class Sched, bool ALIGN_EPI = false, bool SP2 = false>
__device__ __forceinline__ void gemm_phase(PG8_LAS unsigned char* lds, const Gemm g, const Sched& S, const Epi& E) {
    int tid_l = threadIdx.x; asm volatile("" : "+v"(tid_l));
    const int tid = tid_l, wid = __builtin_amdgcn_readfirstlane(tid >> 6), lane = tid & 63, wr = wid >> 2, wc = wid & 3, fr = lane & 15, fq = lane >> 4;
    const int K = g.K, nt = K / BK;
    unsigned voffA[2], voffB[2];
#pragma unroll
    for (int i = 0; i < 2; ++i) { int R, C; stage_rc(tid * 16 + i * 8192, R, C); const int Rb = Epi::PERM ? ((R & ~31) + perm32(R & 31)) : R;
        voffA[i] = (unsigned)(R * K + C) * 2u; voffB[i] = (unsigned)(Rb * K + C) * 2u; }
    const size_t kstep = (size_t)(BK * 2);
    const size_t hstep = (size_t)HALF * K * 2;
    const size_t tstep = 2 * hstep;
    const unsigned ldsw = (unsigned)wid * 1024u;
    const int aoff = lds_byte(wr * 64 + fr, fq * 8), boff = lds_byte(wc * 32 + fr, fq * 8);
#define PG8_SA(b, h) (((b) * 2 + (h)) * HTB)
#define PG8_SB(b, h) ((4 + (b) * 2 + (h)) * HTB)
#define PG8_STAGE(bufoff, gbase, voff) do { _Pragma("unroll") for (int _i = 0; _i < 2; ++_i) \
        __builtin_amdgcn_global_load_lds((const unsigned*)((const char*)(gbase) + (voff)[_i]), (PG8_LAS unsigned*)(lds + (bufoff) + ldsw + _i * 8192), 16, 0, 0); } while (0)
#define PG8_LDA(dst, b, h) do { _Pragma("unroll") for (int m = 0; m < 4; ++m) _Pragma("unroll") for (int k = 0; k < 2; ++k) dst[m][k] = *(const PG8_LAS bf16x8*)(lds + PG8_SA(b, h) + aoff + m * 2048 + k * 1024); } while (0)
#define PG8_LDB(dst, b, h) do { _Pragma("unroll") for (int n = 0; n < 2; ++n) _Pragma("unroll") for (int k = 0; k < 2; ++k) dst[n][k] = *(const PG8_LAS bf16x8*)(lds + PG8_SB(b, h) + boff + n * 2048 + k * 1024); } while (0)
#define PG8_MMA(ai, bj, At, Bt) do { __builtin_amdgcn_s_setprio(1); _Pragma("unroll") for (int m = 0; m < 4; ++m) _Pragma("unroll") for (int n = 0; n < 2; ++n) _Pragma("unroll") for (int k = 0; k < 2; ++k) \
        acc[ai][bj][m][n] = __builtin_amdgcn_mfma_f32_16x16x32_bf16(Bt[n][k], At[m][k], acc[ai][bj][m][n], 0, 0, 0); __builtin_amdgcn_s_setprio(0); } while (0)
#define PG8_WAIT_V(n) asm volatile("s_waitcnt vmcnt(" #n ")" ::: "memory")
#define PG8_WAIT_L(n) asm volatile("s_waitcnt lgkmcnt(" #n ")" ::: "memory")
#define PG8_BAR __builtin_amdgcn_s_barrier()
#define PG8_SCHED __builtin_amdgcn_sched_barrier(0)
    Unit cur, nxt; int ui = 0;
    if (!S.next(0, cur)) return;
    f32x4 acc[2][2][4][2];
#pragma unroll
    for (int a = 0; a < 2; ++a)
#pragma unroll
        for (int b = 0; b < 2; ++b)
#pragma unroll
            for (int m = 0; m < 4; ++m)
#pragma unroll
                for (int n = 0; n < 2; ++n) acc[a][b][m][n] = (f32x4){0.f, 0.f, 0.f, 0.f};
    bf16x8 At[4][2], B0[2][2], B1[2][2];
    const char* cA = (const char*)g.A + (size_t)cur.pm * tstep; const char* cB = (const char*)g.Bt + (size_t)cur.pn * tstep;
    S.a_ready(cur);
    if constexpr (SP2) {
        PG8_STAGE(PG8_SB(0, 0), cB, voffB); PG8_STAGE(PG8_SB(0, 1), cB + hstep, voffB); PG8_STAGE(PG8_SA(0, 0), cA, voffA); PG8_STAGE(PG8_SA(0, 1), cA + hstep, voffA);
        if (wr == 1) PG8_BAR;
        PG8_WAIT_V(2); PG8_BAR;
        PG8_STAGE(PG8_SB(1, 0), cB + kstep, voffB); PG8_STAGE(PG8_SA(1, 0), cA + kstep, voffA); PG8_STAGE(PG8_SB(1, 1), cB + hstep + kstep, voffB);
        PG8_WAIT_V(6); PG8_BAR;
    } else {
        PG8_STAGE(PG8_SB(0, 0), cB, voffB); PG8_STAGE(PG8_SA(0, 0), cA, voffA); PG8_STAGE(PG8_SB(0, 1), cB + hstep, voffB); PG8_STAGE(PG8_SA(0, 1), cA + hstep, voffA);
        if (wr == 1) PG8_BAR;
        PG8_WAIT_V(4); PG8_BAR;
        PG8_STAGE(PG8_SB(1, 0), cB + kstep, voffB); PG8_STAGE(PG8_SA(1, 0), cA + kstep, voffA); PG8_STAGE(PG8_SB(1, 1), cB + hstep + kstep, voffB);
        PG8_WAIT_V(6); PG8_BAR;
    }
    for (;;) {
        const bool has_next = S.next(ui + 1, nxt);
        const char* nA = has_next ? (const char*)g.A + (size_t)nxt.pm * tstep : cA; const char* nB = has_next ? (const char*)g.Bt + (size_t)nxt.pn * tstep : cB;
        for (int t = 0; t < nt; t += 2) {
            const bool last = (t == nt - 2);
            const char* a1 = cA + (size_t)(t + 1) * kstep;
            const char* a2 = last ? nA : cA + (size_t)(t + 2) * kstep; const char* b2 = last ? nB : cB + (size_t)(t + 2) * kstep;
            const char* a3 = a2 + kstep; const char* b3 = b2 + kstep;
            if (last && has_next) S.a_ready(nxt);
            if constexpr (SP2) {
            PG8_LDB(B0, 0, 0); PG8_LDB(B1, 0, 1); PG8_SCHED; PG8_LDA(At, 0, 0); PG8_STAGE(PG8_SA(1, 1), a1 + hstep, voffA);
            PG8_WAIT_V(8); PG8_WAIT_L(0); PG8_BAR; PG8_MMA(0, 0, At, B0); PG8_MMA(0, 1, At, B1); PG8_BAR; PG8_SCHED;
            PG8_LDA(At, 0, 1); PG8_STAGE(PG8_SB(0, 0), b2, voffB); PG8_STAGE(PG8_SB(0, 1), b2 + hstep, voffB); PG8_STAGE(PG8_SA(0, 0), a2, voffA);
            PG8_WAIT_V(8); PG8_WAIT_L(0); PG8_BAR; PG8_MMA(1, 0, At, B0); PG8_MMA(1, 1, At, B1); PG8_BAR; PG8_SCHED;
            PG8_LDB(B0, 1, 0); PG8_LDB(B1, 1, 1); PG8_SCHED; PG8_LDA(At, 1, 0); PG8_STAGE(PG8_SA(0, 1), a2 + hstep, voffA);
            PG8_WAIT_V(8); PG8_WAIT_L(0); PG8_BAR; PG8_MMA(0, 0, At, B0); PG8_MMA(0, 1, At, B1); PG8_BAR; PG8_SCHED;
            PG8_LDA(At, 1, 1); PG8_STAGE(PG8_SB(1, 0), b3, voffB); PG8_STAGE(PG8_SB(1, 1), b3 + hstep, voffB); PG8_STAGE(PG8_SA(1, 0), a3, voffA);
            PG8_WAIT_V(8); PG8_WAIT_L(0); PG8_BAR; PG8_MMA(1, 0, At, B0); PG8_MMA(1, 1, At, B1); PG8_BAR; PG8_SCHED;
            } else {
            PG8_LDB(B0, 0, 0); PG8_SCHED; PG8_LDA(At, 0, 0); PG8_STAGE(PG8_SA(1, 1), a1 + hstep, voffA);
            PG8_WAIT_L(8); PG8_BAR; PG8_WAIT_L(0); PG8_MMA(0, 0, At, B0); PG8_BAR; PG8_SCHED;
            PG8_LDB(B1, 0, 1); PG8_STAGE(PG8_SB(0, 0), b2, voffB);
            PG8_BAR; PG8_WAIT_L(0); PG8_MMA(0, 1, At, B1); PG8_BAR;
            PG8_LDA(At, 0, 1); PG8_STAGE(PG8_SA(0, 0), a2, voffA);
            PG8_BAR; PG8_WAIT_L(0); PG8_MMA(1, 0, At, B0); PG8_BAR; PG8_SCHED;
            PG8_STAGE(PG8_SB(0, 1), b2 + hstep, voffB);
            PG8_WAIT_V(6); PG8_BAR; PG8_MMA(1, 1, At, B1); PG8_BAR;
            PG8_LDB(B0, 1, 0); PG8_SCHED; PG8_LDA(At, 1, 0); PG8_STAGE(PG8_SA(0, 1), a2 + hstep, voffA);
            PG8_WAIT_L(8); PG8_BAR; PG8_WAIT_L(0); PG8_MMA(0, 0, At, B0); PG8_BAR; PG8_SCHED;
            PG8_LDB(B1, 1, 1); PG8_STAGE(PG8_SB(1, 0), b3, voffB);
            PG8_BAR; PG8_WAIT_L(0); PG8_MMA(0, 1, At, B1); PG8_BAR;
            PG8_LDA(At, 1, 1); PG8_STAGE(PG8_SA(1, 0), a3, voffA);
            PG8_BAR; PG8_WAIT_L(0); PG8_MMA(1, 0, At, B0); PG8_BAR; PG8_SCHED;
            PG8_STAGE(PG8_SB(1, 1), b3 + hstep, voffB);
            PG8_WAIT_V(6); PG8_BAR; PG8_MMA(1, 1, At, B1); PG8_BAR;
            }
        }
        if constexpr (ALIGN_EPI) { if (wr == 0) PG8_BAR; }
        if constexpr (!Epi::AFTER_DRAIN) { E(acc, cur, wr, wc, fr, fq); S.done(cur); }
        if (!has_next) break;
#pragma unroll
        for (int a = 0; a < 2; ++a)
#pragma unroll
            for (int b = 0; b < 2; ++b)
#pragma unroll
                for (int m = 0; m < 4; ++m)
#pragma unroll
                    for (int n = 0; n < 2; ++n) acc[a][b][m][n] = (f32x4){0.f, 0.f, 0.f, 0.f};
        cur = nxt; cA = nA; cB = nB; ++ui;
        if constexpr (ALIGN_EPI) { if (wr == 1) PG8_BAR; }
    }
    PG8_WAIT_V(0);
    if constexpr (!ALIGN_EPI) { if (wr == 0) PG8_BAR; }
    PG8_BAR;
    if constexpr (Epi::AFTER_DRAIN) { E.fused(acc, cur, wr, wc, fr, fq, lds, wid, lane); S.done(cur); }
#undef PG8_SA
#undef PG8_SB
#undef PG8_STAGE
#undef PG8_LDA
#undef PG8_LDB
#undef PG8_MMA
#undef PG8_WAIT_V
#undef PG8_WAIT_L
#undef PG8_BAR
#undef PG8_SCHED
}
}

constexpr int DM = 1024, TP = 16384, TSM = 256, TT = 16640, SEQ = 8192;
constexpr int DIN = 2048, CONVD = 3072, NH = 32, DST = 128;
constexpr int MINW = 5152, MINP = 5376;
constexpr float EPS = 1e-6f;
constexpr size_t MiB = 1u << 20;
constexpr size_t O_Y = 0, O_SSMP = 17039360, O_CONVP = 18087936, O_SSMS = 18124800, O_CONVS = 34902016;
constexpr size_t O_KVP1 = 35491840, O_KVP2 = 35622912, O_KVP3 = 36147200, O_KVS1 = 38244352, O_KVS2 = 38375424, O_KVS3 = 38506496;
constexpr size_t WS_CTL = 0, WS_SSQ = 1 * MiB, WS_ZERO_BYTES = 2 * MiB;
constexpr size_t WS_WIN0 = 2 * MiB, WS_WIN1 = 13 * MiB, WS_WOUT0 = 24 * MiB, WS_WOUT1 = 28 * MiB, WS_WKVA = 32 * MiB, WS_WAIN1 = 43 * MiB;
constexpr size_t WS_WAOUT0 = 51 * MiB, WS_WAOUT1 = 53 * MiB, WS_WG0 = 55 * MiB, WS_WP0 = 63 * MiB;
constexpr size_t WS_ROPEC = 65 * MiB, WS_ROPES = 66 * MiB + 512 * 1024;
constexpr size_t WS_HB = 68 * MiB, WS_PBUFA = 101 * MiB, WS_PBUFB = 110 * MiB, WS_PP = 119 * MiB;
constexpr size_t WS_DTRAW = 152 * MiB, WS_DTC = 155 * MiB, WS_ACU = 157 * MiB, WS_XSS = 159 * MiB, WS_YSRAW = 162 * MiB;
constexpr size_t WS_ZB = 164 * MiB, WS_XBC = 229 * MiB, WS_XT = 327 * MiB, WS_BROW = 391 * MiB, WS_BT = 407 * MiB, WS_CROW = 423 * MiB, WS_STATES = 439 * MiB;
constexpr size_t WS_YB = WS_XBC;
constexpr size_t WS_GATE = WS_ZB, WS_Q = WS_XBC, WS_KVRAW = WS_XT, WS_KN = WS_BROW, WS_KSS = WS_CROW, WS_VSS = WS_CROW + 1 * MiB, WS_VT = WS_STATES, WS_OB = WS_STATES + 24 * MiB;
constexpr size_t WS_END = 503 * MiB;
constexpr int CW_BAR = 4096;
constexpr int ROPE_ROWS = 8200;

constexpr int RING_BYTES = 143360, MISC_OFF = RING_BYTES + 320, LDS_BYTES = 147456;

struct Args { const float* in[27]; float* out; unsigned char* ws; int ph_lo, ph_hi; };

struct Ctx {
    LAS unsigned char* lds;
    int tid, lane, wave, vcu, G;
    int gw, ngw;
    const float* const* in; float* out; unsigned char* ws;
};

template <int C1, int C2, int C3, int LD0, int LD1, int LD2, bool HAS_DT>
struct EpiSplit {
    static constexpr bool PERM = true, AFTER_DRAIN = false;
    const float* ssq; bf16* p0; bf16* p1; bf16* p2; float* dt;
    template <int LD> __device__ __forceinline__ void seg(const f32x4 (&acc)[2][2][4][2], bf16* base, unsigned row0, unsigned col0) const {
#pragma unroll
        for (int ai = 0; ai < 2; ++ai)
#pragma unroll
            for (int m = 0; m < 4; ++m) { const unsigned r = row0 + ai * 128 + m * 16; bf16* rowp = base + (r * (unsigned)LD + col0); const float s = rsqrtf(ssq[r] * (1.f / 1024.f) + EPS);
#pragma unroll
                for (int bj = 0; bj < 2; ++bj) { const f32x4 v0 = acc[ai][bj][m][0] * s, v1 = acc[ai][bj][m][1] * s;
                    u32x4 w; w.x = pk2(v0[0], v0[1]); w.y = pk2(v0[2], v0[3]); w.z = pk2(v1[0], v1[1]); w.w = pk2(v1[2], v1[3]);
                    *(u32x4*)(rowp + bj * 128) = w; } }
    }
    __device__ __forceinline__ void operator()(const f32x4 (&acc)[2][2][4][2], const pg8::Unit& u, int wr, int wc, int fr, int fq) const {
        const int colt = u.pn * 256; const unsigned row0 = u.pm * 256 + wr * 64 + fr; const unsigned cw = wc * 32 + 8 * fq;
        if (colt >= C3) {
            if (HAS_DT && wc == 0) {
#pragma unroll
                for (int ai = 0; ai < 2; ++ai)
#pragma unroll
                    for (int m = 0; m < 4; ++m) { const unsigned r = row0 + ai * 128 + m * 16; float* o = dt + (r * 32u + 8 * fq); const float s = rsqrtf(ssq[r] * (1.f / 1024.f) + EPS);
                        *(f32x4*)o = acc[ai][0][m][0] * s; *(f32x4*)(o + 4) = acc[ai][0][m][1] * s; }
            }
            return;
        }
        if (colt < C1) seg<LD0>(acc, p0, row0, colt + cw);
        else if (colt < C2) seg<LD1>(acc, p1, row0, colt - C1 + cw);
        else seg<LD2>(acc, p2, row0, colt - C2 + cw);
    }
};

template <int MODE> struct EpiRes {
    static constexpr bool PERM = true, AFTER_DRAIN = false;
    float* H; bf16* HB; float* ssq_out; const float* ssq_in; const bf16* PP;
    __device__ __forceinline__ void operator()(const f32x4 (&acc)[2][2][4][2], const pg8::Unit& u, int wr, int wc, int fr, int fq) const {
        const int row0 = u.pm * 256 + wr * 64 + fr, col0 = u.pn * 256 + wc * 32 + 8 * fq;
#pragma unroll
        for (int ai = 0; ai < 2; ++ai)
#pragma unroll
            for (int m = 0; m < 4; ++m) {
                const int r = row0 + ai * 128 + m * 16; const size_t off = (size_t)r * DM + col0;
                float rs = 1.f; if (MODE == 1) rs = rsqrtf(ssq_in[r] * (1.f / 1024.f) + EPS);
                float ss = 0.f;
#pragma unroll
                for (int bj = 0; bj < 2; ++bj) {
                    const f32x4 b0 = *(const f32x4*)(H + off + bj * 128), b1 = *(const f32x4*)(H + off + bj * 128 + 4);
                    f32x4 d0 = acc[ai][bj][m][0], d1 = acc[ai][bj][m][1];
                    if (MODE == 1) {
                        const u32x4 pv = *(const u32x4*)(PP + off + bj * 128); float pf[8]; unpack8(pv, pf);
#pragma unroll
                        for (int j = 0; j < 4; ++j) { d0[j] = sigmoid_f(d0[j] * rs) * pf[j]; d1[j] = sigmoid_f(d1[j] * rs) * pf[4 + j]; }
                    }
                    const f32x4 h0 = b0 + d0, h1 = b1 + d1;
                    *(f32x4*)(H + off + bj * 128) = h0; *(f32x4*)(H + off + bj * 128 + 4) = h1;
                    u32x4 w; w.x = pk2(h0[0], h0[1]); w.y = pk2(h0[2], h0[3]); w.z = pk2(h1[0], h1[1]); w.w = pk2(h1[2], h1[3]);
                    *(u32x4*)(HB + off + bj * 128) = w;
                    ss += (h0[0] * h0[0] + h0[1] * h0[1]) + (h0[2] * h0[2] + h0[3] * h0[3]) + (h1[0] * h1[0] + h1[1] * h1[1]) + (h1[2] * h1[2] + h1[3] * h1[3]);
                }
                ss += __shfl_xor(ss, 16); ss += __shfl_xor(ss, 32);
                if (fq == 0 && ssq_out != nullptr) atomicAdd(ssq_out + r, ss);
                if (m & 1) asm volatile("" ::: "memory");
            }
    }
};

struct EpiPlain {
    static constexpr bool PERM = true, AFTER_DRAIN = false;
    bf16* O; int ld;
    __device__ __forceinline__ void operator()(const f32x4 (&acc)[2][2][4][2], const pg8::Unit& u, int wr, int wc, int fr, int fq) const {
        const int row0 = u.pm * 256 + wr * 64 + fr, col0 = u.pn * 256 + wc * 32 + 8 * fq;
#pragma unroll
        for (int ai = 0; ai < 2; ++ai)
#pragma unroll
            for (int m = 0; m < 4; ++m) { bf16* rowp = O + (size_t)(row0 + ai * 128 + m * 16) * ld + col0;
#pragma unroll
                for (int bj = 0; bj < 2; ++bj) { const f32x4 v0 = acc[ai][bj][m][0], v1 = acc[ai][bj][m][1];
                    u32x4 w; w.x = pk2(v0[0], v0[1]); w.y = pk2(v0[2], v0[3]); w.z = pk2(v1[0], v1[1]); w.w = pk2(v1[2], v1[3]);
                    *(u32x4*)(rowp + bj * 128) = w; } }
    }
};

__device__ __forceinline__ void transpose_item(const float* __restrict__ W, int K, int Nsrc, bf16* __restrict__ WT, int row_off, const float* __restrict__ scale,
                                               LAS float* scr, int kb, int nb, int lane) {
    const int k0 = 64 * kb, n0 = 32 * nb;
    const int c = lane & 7;
    if (n0 >= Nsrc) {
#pragma unroll
        for (int j = 0; j < 4; ++j) { const int n = (lane >> 3) + 8 * j; *(u32x4*)(WT + (size_t)(row_off + n0 + n) * K + k0 + 8 * c) = (u32x4){0u, 0u, 0u, 0u}; }
        return;
    }
#pragma unroll 8
    for (int i = 0; i < 32; ++i) { const int kk = 2 * i + (lane >> 5); float v = W[(size_t)(k0 + kk) * Nsrc + n0 + (lane & 31)]; if (scale) v *= scale[k0 + kk]; scr[kk * 33 + (lane & 31)] = v; }
    asm volatile("s_waitcnt lgkmcnt(0)" ::: "memory");
#pragma unroll
    for (int j = 0; j < 4; ++j) { const int n = (lane >> 3) + 8 * j; const LAS float* s = scr + (8 * c) * 33 + n;
        u32x4 o; o.x = pk2(s[0 * 33], s[1 * 33]); o.y = pk2(s[2 * 33], s[3 * 33]); o.z = pk2(s[4 * 33], s[5 * 33]); o.w = pk2(s[6 * 33], s[7 * 33]);
        *(u32x4*)(WT + (size_t)(row_off + n0 + n) * K + k0 + 8 * c) = o; }
    asm volatile("s_waitcnt lgkmcnt(0)" ::: "memory");
}

struct WJob { const float* W; const float* scale; bf16* WT; int K, Nsrc, Ndst, row_off; };

__device__ __forceinline__ void p0_prologue(const Ctx& C) {
    LAS float* scr = (LAS float*)(C.lds + C.wave * 16384);
    unsigned char* ws = C.ws;
#pragma unroll 1
    for (int job = 0; job < 20; ++job) {
        WJob J;
        if (job < 2)       { J = {C.in[10] + (size_t)job * 1024 * MINW, C.in[9] + job * 1024, (bf16*)(ws + (job ? WS_WIN1 : WS_WIN0)), 1024, MINW, MINP, 0}; }
        else if (job < 4)  { const int i = job - 2; J = {C.in[17] + (size_t)i * 2048 * 1024, C.in[16] + i * 2048, (bf16*)(ws + (i ? WS_WOUT1 : WS_WOUT0)), 2048, 1024, 1024, 0}; }
        else if (job == 4) { J = {C.in[19], C.in[18], (bf16*)(ws + WS_WKVA), 1024, 1536, 1536, 0}; }
        else if (job == 5) { J = {C.in[21], C.in[9] + 2 * 1024, (bf16*)(ws + WS_WKVA), 1024, 4096, 4096, 1536}; }
        else if (job == 6) { J = {C.in[21] + (size_t)1024 * 4096, C.in[9] + 3 * 1024, (bf16*)(ws + WS_WAIN1), 1024, 4096, 4096, 0}; }
        else if (job < 9)  { const int i = job - 7; J = {C.in[23] + (size_t)i * 1024 * 1024, nullptr, (bf16*)(ws + (i ? WS_WAOUT1 : WS_WAOUT0)), 1024, 1024, 1024, 0}; }
        else if (job < 13) { const int i = job - 9; J = {C.in[25] + (size_t)i * 1024 * 1024, C.in[26] + i * 1024, (bf16*)(ws + WS_WG0 + (size_t)i * 2 * MiB), 1024, 1024, 1024, 0}; }
        else if (job < 17) { const int i = job - 13; J = {C.in[24] + (size_t)i * 256 * 1024, nullptr, (bf16*)(ws + WS_WP0 + (size_t)i * 512 * 1024), 256, 1024, 1024, 0}; }
        else break;
        const int nblk = J.Ndst / 32, nitems = (J.K / 64) * nblk;
        for (int it = C.gw; it < nitems; it += C.ngw) transpose_item(J.W, J.K, J.Nsrc, J.WT, J.row_off, J.scale, scr, it / nblk, it % nblk, C.lane);
    }
    {
        float* H = C.out; bf16* HB = (bf16*)(ws + WS_OB); float* ssq = (float*)(ws + WS_SSQ);
        for (int m = C.gw; m < TT; m += C.ngw) {
            const float* xrow = (m < TP) ? C.in[0] + (size_t)m * DM : C.in[1] + (size_t)(m - TP) * DM;
            const f32x4* xr = (const f32x4*)xrow + C.lane;
            f32x4 v[4]; float s = 0.f;
#pragma unroll
            for (int j = 0; j < 4; ++j) { v[j] = xr[64 * j]; s += (v[j][0] * v[j][0] + v[j][1] * v[j][1]) + (v[j][2] * v[j][2] + v[j][3] * v[j][3]); }
            s = wave_sum(s);
            f32x4* ho = (f32x4*)(H + (size_t)m * DM) + C.lane; u32x2* bo = (u32x2*)(HB + (size_t)m * DM) + C.lane;
#pragma unroll
            for (int j = 0; j < 4; ++j) { ho[64 * j] = v[j]; u32x2 w; w.x = pk2(v[j][0], v[j][1]); w.y = pk2(v[j][2], v[j][3]); bo[64 * j] = w; }
            if (C.lane == 0) ssq[m] = s;
        }
    }
    {
        float* rc = (float*)(ws + WS_ROPEC); float* rsn = (float*)(ws + WS_ROPES);
        const int gt = C.gw * 64 + C.lane, ngt = C.ngw * 64;
        for (int e = gt; e < ROPE_ROWS * 32; e += ngt) {
            const int pos = e >> 5, i = e & 31;
            const float inv = 1.0f / powf(10000.0f, (float)i / 32.0f);
            const float ang = (float)pos * inv;
            rc[e] = cosf(ang); rsn[e] = sinf(ang);
        }
    }
}

__device__ __forceinline__ void convert_p(const Ctx& C, int layer, bf16* dst) {
    const float* pp = C.in[7] + (size_t)layer * TP * 256; const float* ps = C.in[8] + (size_t)layer * TSM * 256;
    const int gt = C.gw * 64 + C.lane, ngt = C.ngw * 64;
    for (int e = gt; e < TT * 32; e += ngt) {
        const int row = e >> 5, c = (e & 31) * 8;
        const float* src = (row < TP) ? pp + (size_t)row * 256 + c : ps + (size_t)(row - TP) * 256 + c;
        const f32x4 a = *(const f32x4*)src, b = *(const f32x4*)(src + 4);
        u32x4 w; w.x = pk2(a[0], a[1]); w.y = pk2(a[2], a[3]); w.z = pk2(b[0], b[1]); w.w = pk2(b[2], b[3]);
        *(u32x4*)(dst + (size_t)row * 256 + c) = w;
    }
}

__device__ __forceinline__ void p2_conv(const Ctx& C, int layer) {
    unsigned char* ws = C.ws;
    const bf16* XBC = (const bf16*)(ws + WS_XBC);
    bf16* XT = (bf16*)(ws + WS_XT); bf16* BROW = (bf16*)(ws + WS_BROW); bf16* BT = (bf16*)(ws + WS_BT); bf16* CROW = (bf16*)(ws + WS_CROW);
    const float* cw = C.in[11] + (size_t)layer * 4 * CONVD; const float* cbias = C.in[12] + (size_t)layer * CONVD;
    for (int unit = blockIdx.x; unit < 128 * 12; unit += C.G) {
        const int cidx = unit / 12, cb = unit % 12;
        const int c8 = cb * 32 + (C.tid >> 4), run = C.tid & 15, ch = c8 * 8;
        const int tok0 = cidx * 128 + run * 8, sseq0 = (cidx & 63) * 128 + run * 8;
        float w[4][8], o[8][8];
#pragma unroll
        for (int k = 0; k < 4; ++k) { const f32x4 a = *(const f32x4*)(cw + k * CONVD + ch), b = *(const f32x4*)(cw + k * CONVD + ch + 4);
#pragma unroll
            for (int i = 0; i < 4; ++i) { w[k][i] = a[i]; w[k][4 + i] = b[i]; } }
        { const f32x4 a = *(const f32x4*)(cbias + ch), b = *(const f32x4*)(cbias + ch + 4);
#pragma unroll
            for (int j = 0; j < 8; ++j)
#pragma unroll
                for (int i = 0; i < 4; ++i) { o[j][i] = a[i]; o[j][4 + i] = b[i]; } }
        u32x4 raw[11];
#pragma unroll
        for (int r = 0; r < 11; ++r) { raw[r] = (u32x4){0u, 0u, 0u, 0u}; if (sseq0 + r - 3 >= 0) raw[r] = *(const u32x4*)(XBC + (size_t)(tok0 + r - 3) * CONVD + ch); }
#pragma unroll
        for (int r = 0; r < 11; ++r) { float x[8]; unpack8(raw[r], x);
#pragma unroll
            for (int j = 0; j < 8; ++j) { const int k = r - j; if (k >= 0 && k < 4) {
#pragma unroll
                for (int i = 0; i < 8; ++i) o[j][i] += w[k][i] * x[i]; } } }
#pragma unroll
        for (int j = 0; j < 8; ++j)
#pragma unroll
            for (int i = 0; i < 8; ++i) o[j][i] = silu_f(o[j][i]);
        if (ch < DIN) {
            const int head = ch >> 6, p0 = ch & 63;
#pragma unroll
            for (int i = 0; i < 8; ++i) { float t[8];
#pragma unroll
                for (int j = 0; j < 8; ++j) t[j] = o[j][i];
                *(u32x4*)(XT + ((size_t)(cidx * 32 + head) * 64 + p0 + i) * 128 + run * 8) = pack8(t); }
        } else if (ch < DIN + 512) {
            const int g = (ch - DIN) >> 7, n0 = (ch - DIN) & 127;
#pragma unroll
            for (int j = 0; j < 8; ++j) *(u32x4*)(BROW + ((size_t)(cidx * 4 + g) * 128 + run * 8 + j) * 128 + n0) = pack8(o[j]);
#pragma unroll
            for (int i = 0; i < 8; ++i) { float t[8];
#pragma unroll
                for (int j = 0; j < 8; ++j) t[j] = o[j][i];
                *(u32x4*)(BT + ((size_t)(cidx * 4 + g) * 128 + n0 + i) * 128 + run * 8) = pack8(t); }
        } else {
            const int g = (ch - DIN - 512) >> 7, n0 = (ch - DIN - 512) & 127;
#pragma unroll
            for (int j = 0; j < 8; ++j) *(u32x4*)(CROW + ((size_t)(cidx * 4 + g) * 128 + run * 8 + j) * 128 + n0) = pack8(o[j]);
        }
        if ((cidx & 63) == 63 && run == 15) {
            const int b = cidx >> 6;
#pragma unroll
            for (int j = 0; j < 3; ++j) { float x[8]; unpack8(raw[8 + j], x); float* dst = C.out + O_CONVP + ((size_t)(layer * 2 + b) * 3 + j) * CONVD + ch;
                *(f32x4*)dst = (f32x4){x[0], x[1], x[2], x[3]}; *(f32x4*)(dst + 4) = (f32x4){x[4], x[5], x[6], x[7]}; }
        }
    }
    {
        const float* cst = C.in[3] + (size_t)layer * 32 * 3 * CONVD; float* XSS = (float*)(ws + WS_XSS);
        const int gt = C.gw * 64 + C.lane, ngt = C.ngw * 64;
        for (int e = gt; e < 32 * 384; e += ngt) {
            const int sb = e / 384, ch = (e % 384) * 8;
            float w[4][8], xin[11][8];
#pragma unroll
            for (int k = 0; k < 4; ++k) { const f32x4 a = *(const f32x4*)(cw + k * CONVD + ch), b = *(const f32x4*)(cw + k * CONVD + ch + 4);
#pragma unroll
                for (int i = 0; i < 4; ++i) { w[k][i] = a[i]; w[k][4 + i] = b[i]; } }
            float bs[8]; { const f32x4 a = *(const f32x4*)(cbias + ch), b = *(const f32x4*)(cbias + ch + 4);
#pragma unroll
                for (int i = 0; i < 4; ++i) { bs[i] = a[i]; bs[4 + i] = b[i]; } }
#pragma unroll
            for (int r = 0; r < 3; ++r) { const float* s = cst + ((size_t)sb * 3 + r) * CONVD + ch; const f32x4 a = *(const f32x4*)s, b = *(const f32x4*)(s + 4);
#pragma unroll
                for (int i = 0; i < 4; ++i) { xin[r][i] = a[i]; xin[r][4 + i] = b[i]; } }
#pragma unroll
            for (int r = 0; r < 8; ++r) { const u32x4 v = *(const u32x4*)(XBC + (size_t)(TP + sb * 8 + r) * CONVD + ch); unpack8(v, xin[3 + r]); }
#pragma unroll
            for (int j = 0; j < 8; ++j) { float o[8];
#pragma unroll
                for (int i = 0; i < 8; ++i) { float a = bs[i];
#pragma unroll
                    for (int k = 0; k < 4; ++k) a += w[k][i] * xin[j + k][i];
                    o[i] = silu_f(a); }
                float* dst = XSS + (size_t)(sb * 8 + j) * CONVD + ch;
                *(f32x4*)dst = (f32x4){o[0], o[1], o[2], o[3]}; *(f32x4*)(dst + 4) = (f32x4){o[4], o[5], o[6], o[7]}; }
#pragma unroll
            for (int j = 0; j < 3; ++j) { float* dst = C.out + O_CONVS + ((size_t)(layer * 32 + sb) * 3 + j) * CONVD + ch;
                *(f32x4*)dst = (f32x4){xin[8 + j][0], xin[8 + j][1], xin[8 + j][2], xin[8 + j][3]}; *(f32x4*)(dst + 4) = (f32x4){xin[8 + j][4], xin[8 + j][5], xin[8 + j][6], xin[8 + j][7]}; }
        }
    }
    {
        const float* DTRAW = (const float*)(ws + WS_DTRAW); float* DTC = (float*)(ws + WS_DTC); float* ACU = (float*)(ws + WS_ACU);
        const float* dtb = C.in[13] + layer * 32; const float* alog = C.in[14] + layer * 32;
        for (int task = C.gw; task < 128 * 32; task += C.ngw) {
            const int cidx = task >> 5, head = task & 31;
            const int t = cidx * 128 + 2 * C.lane;
            const float A = -__expf(alog[head]), bsv = dtb[head];
            const float d0 = softplus_f(DTRAW[(size_t)t * 32 + head] + bsv), d1 = softplus_f(DTRAW[(size_t)(t + 1) * 32 + head] + bsv);
            const float a0 = d0 * A, a1 = d1 * A;
            float x = a0 + a1;
#pragma unroll
            for (int o = 1; o < 64; o <<= 1) { const float v = __shfl_up(x, o); if (C.lane >= o) x += v; }
            *(f32x2*)(DTC + (size_t)task * 128 + 2 * C.lane) = (f32x2){d0, d1};
            *(f32x2*)(ACU + (size_t)task * 128 + 2 * C.lane) = (f32x2){x - a1, x};
        }
    }
}

#define MFMA16(a, b, c) __builtin_amdgcn_mfma_f32_16x16x32_bf16((a), (b), (c), 0, 0, 0)

__device__ __forceinline__ void s1_task(const Ctx& C, int cidx, int head) {
    unsigned char* ws = C.ws;
    const bf16* xt = (const bf16*)(ws + WS_XT) + (size_t)(cidx * 32 + head) * 64 * 128;
    const bf16* bt = (const bf16*)(ws + WS_BT) + (size_t)(cidx * 4 + (head >> 3)) * 128 * 128;
    const float* dtc = (const float*)(ws + WS_DTC) + (size_t)(cidx * 32 + head) * 128;
    const float* acu = (const float*)(ws + WS_ACU) + (size_t)(cidx * 32 + head) * 128;
    bf16* st = (bf16*)(ws + WS_STATES) + (size_t)(cidx * 32 + head) * 64 * 128;
    const int fr = C.lane & 15, fq = C.lane >> 4;
    const float aend = acu[127];
    f32x4 acc[8][4];
#pragma unroll
    for (int a = 0; a < 8; ++a)
#pragma unroll
        for (int b = 0; b < 4; ++b) acc[a][b] = (f32x4){0.f, 0.f, 0.f, 0.f};
#pragma unroll 1
    for (int ks = 0; ks < 4; ++ks) {
        const int s0 = ks * 32 + 8 * fq;
        float wv[8];
        { const f32x4 d0 = *(const f32x4*)(dtc + s0), d1 = *(const f32x4*)(dtc + s0 + 4), a0 = *(const f32x4*)(acu + s0), a1 = *(const f32x4*)(acu + s0 + 4);
#pragma unroll
          for (int j = 0; j < 4; ++j) { wv[j] = d0[j] * __expf(aend - a0[j]); wv[4 + j] = d1[j] * __expf(aend - a1[j]); } }
        bf16x8 bfr[8];
#pragma unroll
        for (int nt = 0; nt < 8; ++nt) bfr[nt] = *(const bf16x8*)(bt + (size_t)(nt * 16 + fr) * 128 + s0);
#pragma unroll
        for (int pt = 0; pt < 4; ++pt) {
            const u32x4 raw = *(const u32x4*)(xt + (size_t)(pt * 16 + fr) * 128 + s0);
            float x[8]; unpack8(raw, x);
#pragma unroll
            for (int j = 0; j < 8; ++j) x[j] *= wv[j];
            const bf16x8 afr = __builtin_bit_cast(bf16x8, pack8(x));
#pragma unroll
            for (int nt = 0; nt < 8; ++nt) acc[nt][pt] = MFMA16(bfr[nt], afr, acc[nt][pt]);
        }
    }
#pragma unroll
    for (int nt = 0; nt < 8; ++nt)
#pragma unroll
        for (int pt = 0; pt < 4; ++pt) { u32x2 w; w.x = pk2(acc[nt][pt][0], acc[nt][pt][1]); w.y = pk2(acc[nt][pt][2], acc[nt][pt][3]);
            *(u32x2*)(st + (size_t)(pt * 16 + fr) * 128 + nt * 16 + 4 * fq) = w; }
}

__device__ __forceinline__ void ssd_sample_task(const Ctx& C, int layer, int sb, int head, LAS float* wl) {
    unsigned char* ws = C.ws;
    const float* XSS = (const float*)(ws + WS_XSS); const float* DTRAW = (const float*)(ws + WS_DTRAW); const bf16* ZB = (const bf16*)(ws + WS_ZB);
    float* YSRAW = (float*)(ws + WS_YSRAW);
    const float* h0 = C.in[2] + ((size_t)(layer * 32 + sb) * 32 + head) * 64 * 128;
    float* hout = C.out + O_SSMS + ((size_t)(layer * 32 + sb) * 32 + head) * 64 * 128;
    const int g = head >> 3, lane = C.lane, tok0 = sb * 8;
    LAS float* Bl = wl;
    LAS float* Cl = wl + 1024;
    LAS float* Xl = wl + 2048;
    LAS float* XWl = wl + 2560;
    LAS float* Gl = wl + 3072;
    LAS float* Sc = wl + 3136;
    const float A = -__expf(C.in[14][layer * 32 + head]), dtb = C.in[13][layer * 32 + head], Dh = C.in[15][layer * 32 + head];
    float dtv[8], ac[8];
    { float run = 0.f;
#pragma unroll
      for (int s = 0; s < 8; ++s) { dtv[s] = softplus_f(DTRAW[(size_t)(TP + tok0 + s) * 32 + head] + dtb); run += dtv[s] * A; ac[s] = run; } }
    const float ac7 = ac[7];
    if (lane == 0) {
#pragma unroll
        for (int s = 0; s < 8; ++s) { Sc[s] = dtv[s]; Sc[8 + s] = ac[s]; }
    }
#pragma unroll
    for (int s = 0; s < 8; ++s) {
        const float* row = XSS + (size_t)(tok0 + s) * CONVD;
        *(LAS f32x2*)(Bl + s * 128 + 2 * lane) = *(const f32x2*)(row + DIN + g * 128 + 2 * lane);
        *(LAS f32x2*)(Cl + s * 128 + 2 * lane) = *(const f32x2*)(row + DIN + 512 + g * 128 + 2 * lane);
        const float xv = row[head * 64 + lane];
        Xl[s * 64 + lane] = xv; XWl[s * 64 + lane] = xv * dtv[s] * __expf(ac7 - ac[s]);
    }
    asm volatile("s_waitcnt lgkmcnt(0)" ::: "memory");
#pragma unroll 1
    for (int l = 0; l < 8; ++l) {
        const f32x2 cv = *(LAS f32x2*)(Cl + l * 128 + 2 * lane); const float acl = Sc[8 + l];
#pragma unroll 1
        for (int s = 0; s <= l; ++s) {
            const f32x2 bv = *(LAS f32x2*)(Bl + s * 128 + 2 * lane);
            float d = wave_sum(cv[0] * bv[0] + cv[1] * bv[1]);
            d = d * __expf(acl - Sc[8 + s]) * Sc[s] + ((s == l) ? Dh : 0.f);
            if (lane == 0) Gl[l * 8 + s] = d;
        }
    }
    asm volatile("s_waitcnt lgkmcnt(0)" ::: "memory");
    const int pi = lane >> 3, nj = lane & 7;
    const float cd = __expf(ac7);
    const float eal = __expf(Sc[8 + nj]);
#pragma unroll 1
    for (int pb = 0; pb < 8; ++pb) {
        const int p = pb * 8 + pi;
        float xw[8], yo[8];
#pragma unroll
        for (int s = 0; s < 8; ++s) { xw[s] = XWl[s * 64 + p]; yo[s] = 0.f; }
#pragma unroll 1
        for (int nb = 0; nb < 4; ++nb) {
            const int n = nb * 32 + nj * 4;
            const f32x4 h4 = *(const f32x4*)(h0 + (size_t)p * 128 + n);
            f32x4 hn = h4 * cd;
#pragma unroll
            for (int s = 0; s < 8; ++s) { const f32x4 b4 = *(LAS f32x4*)(Bl + s * 128 + n), c4 = *(LAS f32x4*)(Cl + s * 128 + n);
                hn += b4 * xw[s];
                yo[s] += (c4[0] * h4[0] + c4[1] * h4[1]) + (c4[2] * h4[2] + c4[3] * h4[3]); }
            *(f32x4*)(hout + (size_t)p * 128 + n) = hn;
        }
        float mine = 0.f;
#pragma unroll
        for (int l = 0; l < 8; ++l) { float v = yo[l]; v += __shfl_xor(v, 1); v += __shfl_xor(v, 2); v += __shfl_xor(v, 4); if (nj == l) mine = v; }
        const int l = nj;
        float y = mine * eal;
#pragma unroll 1
        for (int s = 0; s <= l; ++s) y += Gl[l * 8 + s] * Xl[s * 64 + p];
        const float z = bf1(ZB[(size_t)(TP + tok0 + l) * DIN + head * 64 + p]);
        YSRAW[(size_t)(tok0 + l) * DIN + head * 64 + p] = y * silu_f(z);
    }
    asm volatile("s_waitcnt lgkmcnt(0)" ::: "memory");
}

__device__ __forceinline__ void s2_scan(const Ctx& C, int layer) {
    unsigned char* ws = C.ws;
    bf16* ST = (bf16*)(ws + WS_STATES); const float* ACU = (const float*)(ws + WS_ACU);
    for (int e = blockIdx.x * 512 + C.tid; e < 2 * 32 * 64 * 32; e += C.G * 512) {
        const int n4 = e & 31, p = (e >> 5) & 63, head = (e >> 11) & 31, b = e >> 16;
        f32x4 h = (f32x4){0.f, 0.f, 0.f, 0.f};
#pragma unroll 1
        for (int c0 = 0; c0 < 64; c0 += 8) {
            u32x2 raw[8]; float cdv[8];
#pragma unroll
            for (int k = 0; k < 8; ++k) { const int cidx = b * 64 + c0 + k;
                raw[k] = *(const u32x2*)(ST + ((size_t)(cidx * 32 + head) * 64 + p) * 128 + n4 * 4);
                cdv[k] = ACU[(size_t)(cidx * 32 + head) * 128 + 127]; }
#pragma unroll
            for (int k = 0; k < 8; ++k) { const int cidx = b * 64 + c0 + k;
                u32x2 w; w.x = pk2(h[0], h[1]); w.y = pk2(h[2], h[3]);
                *(u32x2*)(ST + ((size_t)(cidx * 32 + head) * 64 + p) * 128 + n4 * 4) = w;
                const f32x4 s = (f32x4){bflo(raw[k].x), bfhi(raw[k].x), bflo(raw[k].y), bfhi(raw[k].y)};
                h = h * __expf(cdv[k]) + s; }
        }
        *(f32x4*)(C.out + O_SSMP + (((size_t)(layer * 2 + b) * 32 + head) * 64 + p) * 128 + n4 * 4) = h;
    }
}
__device__ __forceinline__ void sample_norm(const Ctx& C) {
    unsigned char* ws = C.ws; const float* YSRAW = (const float*)(ws + WS_YSRAW); bf16* YB = (bf16*)(ws + WS_YB);
    for (int task = C.gw; task < 256 * 4; task += C.ngw) {
        const int row = task >> 2, g = task & 3;
        const float* src = YSRAW + (size_t)row * DIN + g * 512 + C.lane * 8;
        const f32x4 a = *(const f32x4*)src, b = *(const f32x4*)(src + 4);
        float ss = (a[0] * a[0] + a[1] * a[1]) + (a[2] * a[2] + a[3] * a[3]) + (b[0] * b[0] + b[1] * b[1]) + (b[2] * b[2] + b[3] * b[3]);
        ss = wave_sum(ss);
        const float rs = rsqrtf(ss * (1.f / 512.f) + EPS);
        u32x4 w; w.x = pk2(a[0] * rs, a[1] * rs); w.y = pk2(a[2] * rs, a[3] * rs); w.z = pk2(b[0] * rs, b[1] * rs); w.w = pk2(b[2] * rs, b[3] * rs);
        *(u32x4*)(YB + (size_t)(TP + row) * DIN + g * 512 + C.lane * 8) = w;
    }
}

constexpr int S3_LD = 136;
constexpr int S3_CS = 0, S3_CB = 128 * S3_LD * 2, S3_BS = 2 * 128 * S3_LD * 2;
constexpr int S3_YLD = 520;
__device__ __forceinline__ void s3_unit(const Ctx& C, int layer, int cidx, int g) {
    unsigned char* ws = C.ws;
    const bf16* CROW = (const bf16*)(ws + WS_CROW) + (size_t)(cidx * 4 + g) * 128 * 128;
    const bf16* BROW = (const bf16*)(ws + WS_BROW) + (size_t)(cidx * 4 + g) * 128 * 128;
    LAS bf16* Cs = (LAS bf16*)(C.lds + S3_CS); LAS bf16* Bs = (LAS bf16*)(C.lds + S3_BS); LAS bf16* CBs = (LAS bf16*)(C.lds + S3_CB);
    LAS bf16* Ys = (LAS bf16*)(C.lds + S3_BS);
    const int tid = C.tid, lane = C.lane, w = C.wave, fr = lane & 15, fq = lane >> 4;
#pragma unroll
    for (int i = 0; i < 4; ++i) { const int idx = tid + 512 * i, row = idx >> 4, chk = idx & 15;
        *(LAS u32x4*)(Cs + row * S3_LD + chk * 8) = *(const u32x4*)(CROW + row * 128 + chk * 8);
        *(LAS u32x4*)(Bs + row * S3_LD + chk * 8) = *(const u32x4*)(BROW + row * 128 + chk * 8); }
    __syncthreads();
    {
        f32x4 cb[8];
#pragma unroll
        for (int st = 0; st < 8; ++st) cb[st] = (f32x4){0.f, 0.f, 0.f, 0.f};
#pragma unroll
        for (int ks = 0; ks < 4; ++ks) {
            const bf16x8 cf = *(LAS bf16x8*)(Cs + (w * 16 + fr) * S3_LD + ks * 32 + 8 * fq);
#pragma unroll
            for (int st = 0; st < 8; ++st) if (st <= w) { const bf16x8 bf = *(LAS bf16x8*)(Bs + (st * 16 + fr) * S3_LD + ks * 32 + 8 * fq); cb[st] = MFMA16(bf, cf, cb[st]); }
        }
#pragma unroll
        for (int st = 0; st < 8; ++st) { u32x2 v; v.x = pk2(cb[st][0], cb[st][1]); v.y = pk2(cb[st][2], cb[st][3]);
            *(LAS u32x2*)(CBs + (w * 16 + fr) * S3_LD + st * 16 + 4 * fq) = v; }
    }
    __syncthreads();
    const int head = g * 8 + w;
    const bf16* xt = (const bf16*)(ws + WS_XT) + (size_t)(cidx * 32 + head) * 64 * 128;
    const bf16* hin = (const bf16*)(ws + WS_STATES) + (size_t)(cidx * 32 + head) * 64 * 128;
    const float* dtc = (const float*)(ws + WS_DTC) + (size_t)(cidx * 32 + head) * 128;
    const float* acu = (const float*)(ws + WS_ACU) + (size_t)(cidx * 32 + head) * 128;
    const float Dh = C.in[15][layer * 32 + head];
#pragma unroll 1
    for (int half = 0; half < 2; ++half) {
        f32x4 acc[4][4];
#pragma unroll
        for (int a = 0; a < 4; ++a)
#pragma unroll
            for (int b = 0; b < 4; ++b) acc[a][b] = (f32x4){0.f, 0.f, 0.f, 0.f};
#pragma unroll 1
        for (int ks = 0; ks < 4; ++ks) {
            bf16x8 hf[4];
#pragma unroll
            for (int pt = 0; pt < 4; ++pt) hf[pt] = *(const bf16x8*)(hin + (size_t)(pt * 16 + fr) * 128 + ks * 32 + 8 * fq);
#pragma unroll
            for (int lt = 0; lt < 4; ++lt) { const bf16x8 cf = *(LAS bf16x8*)(Cs + ((4 * half + lt) * 16 + fr) * S3_LD + ks * 32 + 8 * fq);
#pragma unroll
                for (int pt = 0; pt < 4; ++pt) acc[lt][pt] = MFMA16(hf[pt], cf, acc[lt][pt]); }
        }
        float al[4];
#pragma unroll
        for (int lt = 0; lt < 4; ++lt) { al[lt] = acu[(4 * half + lt) * 16 + fr]; const float e = __expf(al[lt]);
#pragma unroll
            for (int pt = 0; pt < 4; ++pt) acc[lt][pt] *= e; }
#pragma unroll 1
        for (int ks = 0; ks < 2 * half + 2; ++ks) {
            const int s0 = ks * 32 + 8 * fq;
            bf16x8 xf[4];
#pragma unroll
            for (int pt = 0; pt < 4; ++pt) xf[pt] = *(const bf16x8*)(xt + (size_t)(pt * 16 + fr) * 128 + s0);
            float ds[8], as[8];
            { const f32x4 d0 = *(const f32x4*)(dtc + s0), d1 = *(const f32x4*)(dtc + s0 + 4), a0 = *(const f32x4*)(acu + s0), a1 = *(const f32x4*)(acu + s0 + 4);
#pragma unroll
              for (int j = 0; j < 4; ++j) { ds[j] = d0[j]; ds[4 + j] = d1[j]; as[j] = a0[j]; as[4 + j] = a1[j]; } }
#pragma unroll
            for (int lt = 0; lt < 4; ++lt) if (4 * half + lt >= 2 * ks) {
                const int l = (4 * half + lt) * 16 + fr;
                const u32x4 raw = *(LAS u32x4*)(CBs + l * S3_LD + s0);
                float gv[8]; unpack8(raw, gv);
#pragma unroll
                for (int j = 0; j < 8; ++j) { const int s = s0 + j; float v = gv[j] * __expf(al[lt] - as[j]) * ds[j]; v = (s <= l) ? v : 0.f; gv[j] = (s == l) ? v + Dh : v; }
                const bf16x8 gf = __builtin_bit_cast(bf16x8, pack8(gv));
#pragma unroll
                for (int pt = 0; pt < 4; ++pt) acc[lt][pt] = MFMA16(xf[pt], gf, acc[lt][pt]);
            }
        }
#pragma unroll
        for (int lt = 0; lt < 4; ++lt)
#pragma unroll
            for (int pt = 0; pt < 4; ++pt) { u32x2 v; v.x = pk2(acc[lt][pt][0], acc[lt][pt][1]); v.y = pk2(acc[lt][pt][2], acc[lt][pt][3]);
                *(LAS u32x2*)(Ys + (lt * 16 + fr) * S3_YLD + w * 64 + pt * 16 + 4 * fq) = v; }
        __syncthreads();
        {
            const int lr = tid >> 3, oc = tid & 7; const size_t tok = (size_t)cidx * 128 + half * 64 + lr;
            const bf16* zrow = (const bf16*)(ws + WS_ZB) + tok * DIN + g * 512 + oc * 64;
            bf16* yrow = (bf16*)(ws + WS_YB) + tok * DIN + g * 512 + oc * 64;
            float v[8][8]; float ss = 0.f;
#pragma unroll
            for (int c = 0; c < 8; ++c) { const u32x4 yr = *(LAS u32x4*)(Ys + lr * S3_YLD + oc * 64 + c * 8); const u32x4 zr = *(const u32x4*)(zrow + c * 8);
                float zf[8]; unpack8(yr, v[c]); unpack8(zr, zf);
#pragma unroll
                for (int j = 0; j < 8; ++j) { v[c][j] *= silu_f(zf[j]); ss += v[c][j] * v[c][j]; } }
            ss += __shfl_xor(ss, 1); ss += __shfl_xor(ss, 2); ss += __shfl_xor(ss, 4);
            const float rs = rsqrtf(ss * (1.f / 512.f) + EPS);
#pragma unroll
            for (int c = 0; c < 8; ++c) {
#pragma unroll
                for (int j = 0; j < 8; ++j) v[c][j] *= rs;
                *(u32x4*)(yrow + c * 8) = pack8(v[c]); }
        }
        __syncthreads();
    }
}

__device__ __forceinline__ void p9_kvpass(const Ctx& C) {
    unsigned char* ws = C.ws;
    const bf16* KVRAW = (const bf16*)(ws + WS_KVRAW); bf16* KN = (bf16*)(ws + WS_KN); bf16* VT = (bf16*)(ws + WS_VT);
    float* KSS = (float*)(ws + WS_KSS); float* VSS = (float*)(ws + WS_VSS);
    const float* ropec = (const float*)(ws + WS_ROPEC); const float* ropes = (const float*)(ws + WS_ROPES);
    const float* knw = C.in[20];
    const int lane = C.lane, q4 = lane & 3;
    float wk[16];
#pragma unroll
    for (int j = 0; j < 8; ++j) { wk[j] = knw[8 * q4 + j]; wk[8 + j] = knw[32 + 8 * q4 + j]; }
    for (int pass = C.gw; pass < TT * 12 / 16; pass += C.ngw) {
        const int hr = pass * 16 + (lane >> 2), row = hr / 12, gk = hr % 12, gi = gk >> 2, kh = gk & 3;
        const bf16* src = KVRAW + (size_t)row * 1536 + gk * 64 + 8 * q4;
        float k[16], v[16];
        unpack8(*(const u32x4*)src, k); unpack8(*(const u32x4*)(src + 32), k + 8);
        unpack8(*(const u32x4*)(src + 768), v); unpack8(*(const u32x4*)(src + 768 + 32), v + 8);
        float ss = 0.f;
#pragma unroll
        for (int j = 0; j < 16; ++j) ss += k[j] * k[j];
        ss += __shfl_xor(ss, 1); ss += __shfl_xor(ss, 2);
        const float rs = rsqrtf(ss * (1.f / 64.f) + EPS);
        const int pos = (row < TP) ? (row & 8191) : 8192 + ((row - TP) & 7);
        float ko[16];
#pragma unroll
        for (int j = 0; j < 8; ++j) { const float x1 = k[j] * rs * wk[j], x2 = k[8 + j] * rs * wk[8 + j];
            const float c = ropec[pos * 32 + 8 * q4 + j], s = ropes[pos * 32 + 8 * q4 + j];
            ko[j] = x1 * c - x2 * s; ko[8 + j] = x2 * c + x1 * s; }
        bf16* kd = KN + (size_t)row * 768 + gk * 64 + 8 * q4;
        *(u32x4*)kd = pack8(ko); *(u32x4*)(kd + 32) = pack8(ko + 8);
        float* ok = nullptr; float* ov = nullptr;
        if (row < TP) {
            const int b = row >> 13, W = (gi == 0) ? 128 : (gi == 1) ? 512 : 2048;
            const size_t obase = (gi == 0) ? O_KVP1 : (gi == 1) ? O_KVP2 : O_KVP3;
            if (pos >= 8192 - W) { const int jw = pos - (8192 - W); ok = C.out + obase + ((size_t)(b * W + jw) * 2) * 256 + kh * 64 + 8 * q4; ov = ok + 256; }
        } else {
            const int rs_ = row - TP;
            const size_t obase = (gi == 0) ? O_KVS1 : (gi == 1) ? O_KVS2 : O_KVS3;
            ok = C.out + obase + ((size_t)rs_ * 2) * 256 + kh * 64 + 8 * q4; ov = ok + 256;
            float* k2 = KSS + (size_t)rs_ * 768 + gk * 64 + 8 * q4; float* v2 = VSS + (size_t)rs_ * 768 + gk * 64 + 8 * q4;
#pragma unroll
            for (int h2 = 0; h2 < 2; ++h2) {
                *(f32x4*)(k2 + 32 * h2) = (f32x4){ko[8 * h2], ko[8 * h2 + 1], ko[8 * h2 + 2], ko[8 * h2 + 3]}; *(f32x4*)(k2 + 32 * h2 + 4) = (f32x4){ko[8 * h2 + 4], ko[8 * h2 + 5], ko[8 * h2 + 6], ko[8 * h2 + 7]};
                *(f32x4*)(v2 + 32 * h2) = (f32x4){v[8 * h2], v[8 * h2 + 1], v[8 * h2 + 2], v[8 * h2 + 3]}; *(f32x4*)(v2 + 32 * h2 + 4) = (f32x4){v[8 * h2 + 4], v[8 * h2 + 5], v[8 * h2 + 6], v[8 * h2 + 7]}; }
        }
        if (ok != nullptr) {
#pragma unroll
            for (int h2 = 0; h2 < 2; ++h2) {
                *(f32x4*)(ok + 32 * h2) = (f32x4){ko[8 * h2], ko[8 * h2 + 1], ko[8 * h2 + 2], ko[8 * h2 + 3]}; *(f32x4*)(ok + 32 * h2 + 4) = (f32x4){ko[8 * h2 + 4], ko[8 * h2 + 5], ko[8 * h2 + 6], ko[8 * h2 + 7]};
                *(f32x4*)(ov + 32 * h2) = (f32x4){v[8 * h2], v[8 * h2 + 1], v[8 * h2 + 2], v[8 * h2 + 3]}; *(f32x4*)(ov + 32 * h2 + 4) = (f32x4){v[8 * h2 + 4], v[8 * h2 + 5], v[8 * h2 + 6], v[8 * h2 + 7]}; }
        }
    }
    {
        const int gt = C.gw * 64 + lane, ngt = C.ngw * 64;
        for (int e = gt; e < 2 * 12 * 8 * 1024; e += ngt) {
            const int ddc = e & 7, run = (e >> 3) & 1023, bg = e >> 13, gk = bg % 12, b = bg / 12, gi = gk >> 2;
            const int dsh = 2 * gi, d = 1 << dsh, Ld = 8192 >> dsh;
            const int pi0 = run * 8, r = pi0 / Ld, m0 = pi0 % Ld;
            float vv[8][8];
#pragma unroll
            for (int j = 0; j < 8; ++j) { const int tok = r + d * (m0 + j); unpack8(*(const u32x4*)(KVRAW + (size_t)(b * 8192 + tok) * 1536 + 768 + gk * 64 + ddc * 8), vv[j]); }
#pragma unroll
            for (int i = 0; i < 8; ++i) { float t[8];
#pragma unroll
                for (int j = 0; j < 8; ++j) t[j] = vv[j][i];
                *(u32x4*)(VT + ((size_t)(b * 12 + gk) * 64 + ddc * 8 + i) * 8192 + pi0) = pack8(t); }
        }
    }
}

struct AttnCtx { const bf16* Q; const bf16* KN; const bf16* VT; const float* ropec; const float* ropes; const float* qnw; int b, kh, t0, w, fr, fq; float cshift; };

template <int QT0, int QTS, int NQ>
__device__ __forceinline__ void attn_group(const AttnCtx& A, f32x4 (&O)[4][4], float (&lsum)[4], int gi, int dsh, int rres, int kb, int nkk, const int (&mqv)[NQ]) {
    int fr_l = A.fr, fq_l = A.fq; asm volatile("" : "+v"(fr_l), "+v"(fq_l) :: "memory");
    const int fr = fr_l, fq = fq_l, d = 1 << dsh, Ld = 8192 >> dsh;
    const float* ropec = A.ropec; const float* ropes = A.ropes; const float* qnw = A.qnw;
    asm volatile("" : "+s"(ropec), "+s"(ropes), "+s"(qnw));
    bf16x8 qf[NQ][2];
#pragma unroll
    for (int k = 0; k < NQ; ++k) {
        const int qt = QT0 + QTS * k, rep = 2 * (qt >> 1) + (fr >> 3), i = 2 * (fr & 7) + (qt & 1), t = A.t0 + A.w + 8 * i, head = A.kh * 4 + rep;
        const bf16* src = A.Q + (size_t)(A.b * 8192 + t) * 3072 + gi * 1024 + head * 64 + 8 * fq;
        float x[16]; unpack8(*(const u32x4*)src, x); unpack8(*(const u32x4*)(src + 32), x + 8);
        float ss = 0.f;
#pragma unroll
        for (int j = 0; j < 16; ++j) ss += x[j] * x[j];
        ss += __shfl_xor(ss, 16); ss += __shfl_xor(ss, 32);
        const float rs = rsqrtf(ss * (1.f / 64.f) + EPS) ;
        float o1[8], o2[8];
#pragma unroll
        for (int j = 0; j < 8; ++j) { const float x1 = x[j] * rs * qnw[8 * fq + j], x2 = x[8 + j] * rs * qnw[32 + 8 * fq + j];
            const float c = ropec[t * 32 + 8 * fq + j], s = ropes[t * 32 + 8 * fq + j];
            o1[j] = (x1 * c - x2 * s) * 0.125f; o2[j] = (x2 * c + x1 * s) * 0.125f; }
        qf[k][0] = __builtin_bit_cast(bf16x8, pack8(o1)); qf[k][1] = __builtin_bit_cast(bf16x8, pack8(o2));
        __builtin_amdgcn_sched_barrier(0);
    }
    const bf16* kbase = A.KN + (size_t)A.b * 8192 * 768 + gi * 256 + A.kh * 64 + 8 * fq;
    const bf16* vbase = A.VT + ((size_t)(A.b * 12 + gi * 4 + A.kh) * 64 + fr) * 8192 + rres * Ld;
#pragma unroll 1
    for (int kk = 0; kk < nkk; ++kk) {
        bf16x8 kf[2][2];
#pragma unroll
        for (int h2 = 0; h2 < 2; ++h2) { int m = kb + kk * 32 + h2 * 16 + fr; m = m < 0 ? 0 : m; const bf16* p = kbase + (size_t)(rres + d * m) * 768;
            kf[h2][0] = *(const bf16x8*)p; kf[h2][1] = *(const bf16x8*)(p + 32); }
        bf16x8 vf[4];
        { int ma = kb + kk * 32 + 4 * fq, mb = ma + 16; ma = ma < 0 ? 0 : ma; mb = mb < 0 ? 0 : mb;
#pragma unroll
          for (int dt = 0; dt < 4; ++dt) { const bf16* vp = vbase + (size_t)dt * 16 * 8192; const u32x2 lo = *(const u32x2*)(vp + ma), hi = *(const u32x2*)(vp + mb);
              vf[dt] = __builtin_bit_cast(bf16x8, (u32x4){lo.x, lo.y, hi.x, hi.y}); } }
#pragma unroll
        for (int k = 0; k < NQ; ++k) {
            const int qt = QT0 + QTS * k;
            f32x4 s0 = (f32x4){0.f, 0.f, 0.f, 0.f}, s1 = s0;
            s0 = MFMA16(kf[0][0], qf[k][0], s0); s0 = MFMA16(kf[0][1], qf[k][1], s0);
            s1 = MFMA16(kf[1][0], qf[k][0], s1); s1 = MFMA16(kf[1][1], qf[k][1], s1);
            const int mk0 = kb + kk * 32 + 4 * fq, mq = mqv[k];
            float p0[4], p1[4]; float ps = 0.f;
#pragma unroll
            for (int r = 0; r < 4; ++r) {
                const int ka = mk0 + r, kc = mk0 + 16 + r;
                const bool va = (ka >= 0) && (ka <= mq) && (ka >= mq - 128), vc = (kc >= 0) && (kc <= mq) && (kc >= mq - 128);
                p0[r] = va ? exp2f((s0[r] - A.cshift) * 1.4426950408889634f) : 0.f;
                p1[r] = vc ? exp2f((s1[r] - A.cshift) * 1.4426950408889634f) : 0.f;
                ps += p0[r] + p1[r];
            }
            lsum[qt] += ps;
            const bf16x8 pf = __builtin_bit_cast(bf16x8, (u32x4){pk2(p0[0], p0[1]), pk2(p0[2], p0[3]), pk2(p1[0], p1[1]), pk2(p1[2], p1[3])});
#pragma unroll
            for (int dt = 0; dt < 4; ++dt) O[qt][dt] = MFMA16(vf[dt], pf, O[qt][dt]);
        }
    }
}

__device__ __forceinline__ void attn_prompt_task(const Ctx& C, int j, int task) {
    unsigned char* ws = C.ws;
    AttnCtx A;
    A.Q = (const bf16*)(ws + WS_Q); A.KN = (const bf16*)(ws + WS_KN); A.VT = (const bf16*)(ws + WS_VT);
    A.ropec = (const float*)(ws + WS_ROPEC); A.ropes = (const float*)(ws + WS_ROPES); A.qnw = C.in[22] + j * 64;
    A.w = task & 7; const int blk = (task >> 3) & 63; A.kh = (task >> 9) & 3; A.b = task >> 11; A.t0 = blk * 128;
    A.fr = C.lane & 15; A.fq = C.lane >> 4;
    { const float mq = wave_max(fabsf(A.qnw[C.lane])), mk = wave_max(fabsf(C.in[20][C.lane])); A.cshift = 8.f * mq * mk; }
    f32x4 O[4][4]; float lsum[4];
#pragma unroll
    for (int a = 0; a < 4; ++a) { lsum[a] = 0.f;
#pragma unroll
        for (int b = 0; b < 4; ++b) O[a][b] = (f32x4){0.f, 0.f, 0.f, 0.f}; }
    const int fr = A.fr, w = A.w, t0 = A.t0;
    {
        int mq[2];
#pragma unroll
        for (int qt = 0; qt < 2; ++qt) mq[qt] = t0 + w + 8 * (2 * (fr & 7) + (qt & 1));
        attn_group<0, 1, 2>(A, O, lsum, 0, 0, 0, t0 - 128, 8, mq);
        asm volatile("" ::: "memory"); __builtin_amdgcn_sched_barrier(0);
        attn_group<2, 1, 2>(A, O, lsum, 0, 0, 0, t0 - 128, 8, mq);
    }
    asm volatile("" ::: "memory"); __builtin_amdgcn_sched_barrier(0);
    {
        int mq[2];
#pragma unroll
        for (int qt = 0; qt < 2; ++qt) mq[qt] = t0 / 4 + (w >> 2) + 2 * (2 * (fr & 7) + (qt & 1));
        attn_group<0, 1, 2>(A, O, lsum, 1, 2, w & 3, t0 / 4 - 128, 5, mq);
        asm volatile("" ::: "memory"); __builtin_amdgcn_sched_barrier(0);
        attn_group<2, 1, 2>(A, O, lsum, 1, 2, w & 3, t0 / 4 - 128, 5, mq);
    }
    asm volatile("" ::: "memory"); __builtin_amdgcn_sched_barrier(0);
    {
        int mq[2]; mq[0] = t0 / 16 + (fr & 7); mq[1] = mq[0];
        attn_group<0, 2, 2>(A, O, lsum, 2, 4, w, t0 / 16 - 152, 5, mq);
        asm volatile("" ::: "memory"); __builtin_amdgcn_sched_barrier(0);
        attn_group<1, 2, 2>(A, O, lsum, 2, 4, w + 8, t0 / 16 - 152, 5, mq);
    }
    asm volatile("" ::: "memory"); __builtin_amdgcn_sched_barrier(0);
    const bf16* GATE = (const bf16*)(ws + WS_GATE); bf16* OB = (bf16*)(ws + WS_OB);
    int fr_o = A.fr, fq_o = A.fq; asm volatile("" : "+v"(fr_o), "+v"(fq_o) :: "memory");
#pragma unroll
    for (int qt = 0; qt < 4; ++qt) {
        float l = lsum[qt]; l += __shfl_xor(l, 16); l += __shfl_xor(l, 32);
        const float li = 1.f / l;
        const int rep = 2 * (qt >> 1) + (fr_o >> 3), i = 2 * (fr_o & 7) + (qt & 1), t = t0 + w + 8 * i, head = A.kh * 4 + rep;
        const size_t off = (size_t)(A.b * 8192 + t) * 1024 + head * 64 + 4 * fq_o;
#pragma unroll
        for (int dt = 0; dt < 4; ++dt) {
            const u32x2 gr = *(const u32x2*)(GATE + off + dt * 16);
            const float g0 = bflo(gr.x), g1 = bfhi(gr.x), g2 = bflo(gr.y), g3 = bfhi(gr.y);
            u32x2 o; o.x = pk2(O[qt][dt][0] * li * silu_f(g0), O[qt][dt][1] * li * silu_f(g1)); o.y = pk2(O[qt][dt][2] * li * silu_f(g2), O[qt][dt][3] * li * silu_f(g3));
            *(u32x2*)(OB + off + dt * 16) = o;
        }
    }
}

__device__ __forceinline__ void attn_sample_task(const Ctx& C, int j, int task, LAS float* wl) {
    unsigned char* ws = C.ws;
    const int t = task & 7, kh = (task >> 3) & 3, sb = task >> 5, lane = C.lane;
    const int row = TP + sb * 8 + t, pos = 8192 + t;
    const bf16* Q = (const bf16*)(ws + WS_Q); const bf16* GATE = (const bf16*)(ws + WS_GATE); bf16* OB = (bf16*)(ws + WS_OB);
    const float* KSS = (const float*)(ws + WS_KSS); const float* VSS = (const float*)(ws + WS_VSS);
    const float* ropec = (const float*)(ws + WS_ROPEC); const float* ropes = (const float*)(ws + WS_ROPES);
    const float* qnw = C.in[22] + j * 64;
    LAS float* qs = wl;
    LAS float* sc = wl + 768;
    const float cr = ropec[pos * 32 + (lane & 31)], sr = ropes[pos * 32 + (lane & 31)], wq = qnw[lane];
#pragma unroll
    for (int gi = 0; gi < 3; ++gi)
#pragma unroll
        for (int rep = 0; rep < 4; ++rep) {
            const float q = bf1(Q[(size_t)row * 3072 + gi * 1024 + (kh * 4 + rep) * 64 + lane]);
            const float ss = wave_sum(q * q);
            const float qn = q * rsqrtf(ss * (1.f / 64.f) + EPS) * wq;
            const float pr = __shfl_xor(qn, 32);
            const float o = (lane < 32) ? qn * cr - pr * sr : qn * cr + pr * sr;
            qs[(gi * 4 + rep) * 64 + lane] = o * 0.125f;
        }
    asm volatile("s_waitcnt lgkmcnt(0)" ::: "memory");
    const int kq = lane >> 4, c16 = lane & 15;
#pragma unroll 1
    for (int gi = 0; gi < 3; ++gi) {
        const int W = (gi == 0) ? 128 : (gi == 1) ? 512 : 2048, d = 1 << (2 * gi);
        const float* cache = C.in[4 + gi];
        f32x4 q4[4];
#pragma unroll
        for (int rep = 0; rep < 4; ++rep) q4[rep] = *(LAS f32x4*)(qs + (gi * 4 + rep) * 64 + 4 * c16);
#pragma unroll 1
        for (int it = 0; it < 33; ++it) {
            int jj = it * 4 + kq; const bool ok = jj <= 128; jj = ok ? jj : 128;
            const int idx = W + t - jj * d;
            const float* src = (idx >= W) ? KSS + (size_t)(sb * 8 + idx - W) * 768 + gi * 256 + kh * 64 : cache + ((size_t)(sb * W + idx) * 2) * 256 + kh * 64;
            const f32x4 k4 = *(const f32x4*)(src + 4 * c16);
            float mine = 0.f;
#pragma unroll
            for (int rep = 0; rep < 4; ++rep) {
                float s = (k4[0] * q4[rep][0] + k4[1] * q4[rep][1]) + (k4[2] * q4[rep][2] + k4[3] * q4[rep][3]);
                s += __shfl_xor(s, 1); s += __shfl_xor(s, 2); s += __shfl_xor(s, 4); s += __shfl_xor(s, 8);
                if (c16 == rep) mine = s;
            }
            if (c16 < 4 && ok) sc[(gi * 4 + c16) * 132 + jj] = mine;
        }
    }
    asm volatile("s_waitcnt lgkmcnt(0)" ::: "memory");
    float linv[4];
#pragma unroll
    for (int rep = 0; rep < 4; ++rep) {
        float m = -3.0e38f;
#pragma unroll
        for (int gi = 0; gi < 3; ++gi)
            for (int jj = lane; jj <= 128; jj += 64) m = fmaxf(m, sc[(gi * 4 + rep) * 132 + jj]);
        m = wave_max(m);
        float sum = 0.f;
#pragma unroll
        for (int gi = 0; gi < 3; ++gi)
            for (int jj = lane; jj <= 128; jj += 64) { const float p = __expf(sc[(gi * 4 + rep) * 132 + jj] - m); sc[(gi * 4 + rep) * 132 + jj] = p; sum += p; }
        sum = wave_sum(sum);
        linv[rep] = 1.f / sum;
    }
    asm volatile("s_waitcnt lgkmcnt(0)" ::: "memory");
    f32x4 o[4];
#pragma unroll
    for (int rep = 0; rep < 4; ++rep) o[rep] = (f32x4){0.f, 0.f, 0.f, 0.f};
#pragma unroll 1
    for (int gi = 0; gi < 3; ++gi) {
        const int W = (gi == 0) ? 128 : (gi == 1) ? 512 : 2048, d = 1 << (2 * gi);
        const float* cache = C.in[4 + gi];
#pragma unroll 1
        for (int it = 0; it < 33; ++it) {
            int jj = it * 4 + kq; const bool ok = jj <= 128; jj = ok ? jj : 128;
            const int idx = W + t - jj * d;
            const float* src = (idx >= W) ? VSS + (size_t)(sb * 8 + idx - W) * 768 + gi * 256 + kh * 64 : cache + ((size_t)(sb * W + idx) * 2 + 1) * 256 + kh * 64;
            const f32x4 v4 = *(const f32x4*)(src + 4 * c16);
#pragma unroll
            for (int rep = 0; rep < 4; ++rep) { const float p = ok ? sc[(gi * 4 + rep) * 132 + jj] : 0.f; o[rep] += v4 * p; }
        }
    }
#pragma unroll
    for (int rep = 0; rep < 4; ++rep)
#pragma unroll
        for (int e = 0; e < 4; ++e) { float v = o[rep][e]; v += __shfl_xor(v, 16); v += __shfl_xor(v, 32); o[rep][e] = v; }
    {
        f32x4 mine = o[0]; float li = linv[0];
#pragma unroll
        for (int rep = 1; rep < 4; ++rep) if (kq == rep) { mine = o[rep]; li = linv[rep]; }
        const size_t off = (size_t)row * 1024 + (kh * 4 + kq) * 64 + 4 * c16;
        const u32x2 gr = *(const u32x2*)(GATE + off);
        u32x2 w; w.x = pk2(mine[0] * li * silu_f(bflo(gr.x)), mine[1] * li * silu_f(bfhi(gr.x))); w.y = pk2(mine[2] * li * silu_f(bflo(gr.y)), mine[3] * li * silu_f(bfhi(gr.y)));
        *(u32x2*)(OB + off) = w;
    }
    asm volatile("s_waitcnt lgkmcnt(0)" ::: "memory");
}

constexpr int N_PHASES = 33;
#ifndef PH_MASK
#define PH_MASK 0xFFFFFFu
#endif
#define PHK(k) (((PH_MASK) >> (k)) & 1u)
#ifndef MK_LAUNCH_PER_PHASE
#define MK_LAUNCH_PER_PHASE 0
#endif

__device__ __forceinline__ Ctx make_ctx(const Args& args, LAS unsigned char* lds) {
    Ctx C; int t = threadIdx.x; asm volatile("" : "+v"(t));
    int bx = blockIdx.x, G = gridDim.x; asm volatile("" : "+s"(bx), "+s"(G));
    C.lds = lds; C.tid = t; C.lane = t & 63; C.wave = __builtin_amdgcn_readfirstlane(t >> 6);
    C.G = G; C.vcu = (G % 8 == 0) ? (bx % 8) * (G / 8) + bx / 8 : bx;
    C.gw = C.vcu * 8 + C.wave; C.ngw = G * 8;
    C.in = args.in; C.out = args.out; C.ws = args.ws;
    return C;
}
template <class Epi> __device__ __forceinline__ void run_gemm(const Ctx& C, const bf16* A, const bf16* Bt, int N, int K, const Epi& E) {
    asm volatile("" : "+s"(K), "+s"(N));
    pg8::Gemm g{A, Bt, TT, N, K}; pg8::StaticOrder S; S.init(TT, N, C.G, (int)blockIdx.x);
    pg8::gemm_phase<Epi, pg8::StaticOrder, true, true>(C.lds, g, S, E);
}

__global__ void __launch_bounds__(512, 2) mk_fwd(Args args) {
    extern __shared__ __attribute__((aligned(16))) unsigned char lds_raw[];
    LAS unsigned char* const ldsb = (LAS unsigned char*)lds_raw;
    for (int u = threadIdx.x; u < (LDS_BYTES - RING_BYTES) / 4; u += 512) ((LAS unsigned*)(ldsb + RING_BYTES))[u] = 0u;
    __syncthreads();
    const int lo = args.ph_lo, hi = args.ph_hi;
    if (hi - lo > 1) (void)xcd_barrier_post((unsigned*)(args.ws + WS_CTL) + CW_BAR, (volatile LAS unsigned*)(ldsb + MISC_OFF) + 8);
    for (int ph = lo; ph < hi; ++ph) {
        bool need_bar = true;
        const Ctx C = make_ctx(args, ldsb);
        unsigned char* ws = C.ws;
        float* H = C.out; float* SSQ = (float*)(ws + WS_SSQ);
        bf16* HB0 = (bf16*)(ws + WS_HB); bf16* HB1 = (bf16*)(ws + WS_OB);
        bf16* PBUF[2] = {(bf16*)(ws + WS_PBUFA), (bf16*)(ws + WS_PBUFB)};
        bf16* PP = (bf16*)(ws + WS_PP);
        if (ph == 0) { if (PHK(0)) {
            const Ctx& Cp = C; p0_prologue(Cp);
            convert_p(Cp, 0, PBUF[0]); }
        } else if (ph < 19) {
            const int i = (ph - 1) / 9, sub = (ph - 1) % 9;
            if (sub == 0) { if (PHK(1)) {
                EpiSplit<2048, 5120, 5120, 2048, 3072, 3072, true> E{SSQ + (size_t)(2 * i) * TT, (bf16*)(ws + WS_ZB), (bf16*)(ws + WS_XBC), nullptr, (float*)(ws + WS_DTRAW)};
                run_gemm(C, HB1, (const bf16*)(ws + (i ? WS_WIN1 : WS_WIN0)), MINP, 1024, E); }
            } else if (sub == 1) { if (PHK(2)) {
                const Ctx& Cp = C; p2_conv(Cp, i);
                convert_p(Cp, i + 1, PBUF[(i + 1) & 1]); }
            } else if (sub == 2) { need_bar = false; if (PHK(3)) {
                const Ctx& Cp = C; LAS float* wl = (LAS float*)(Cp.lds + Cp.wave * 16384);
                for (int task = Cp.gw; task < 1024; task += Cp.ngw) ssd_sample_task(Cp, i, task >> 5, task & 31, wl); }
            } else if (sub == 3) { if (PHK(14)) {
                const Ctx& Cp = C; for (int task = Cp.ngw - 1 - Cp.gw; task < 4096; task += Cp.ngw) s1_task(Cp, task >> 5, task & 31); }
            } else if (sub == 4) { if (PHK(4)) {
                const Ctx& Cp = C; s2_scan(Cp, i);
                sample_norm(Cp); }
            } else if (sub == 5) { if (PHK(5)) {
                const Ctx& Cp = C; for (int unit = Cp.vcu; unit < 512; unit += Cp.G) s3_unit(Cp, i, unit >> 2, unit & 3); }
            } else if (sub == 6) { need_bar = false; if (PHK(6)) {
                EpiRes<0> E{H, HB0, SSQ + (size_t)(2 * i + 1) * TT, nullptr, nullptr};
                run_gemm(C, (const bf16*)(ws + WS_YB), (const bf16*)(ws + (i ? WS_WOUT1 : WS_WOUT0)), 1024, 2048, E); }
            } else if (sub == 7) { if (PHK(15)) {
                EpiPlain E2{PP, 1024};
                run_gemm(C, PBUF[i & 1], (const bf16*)(ws + WS_WP0 + (size_t)i * 512 * 1024), 1024, 256, E2); }
            } else { if (PHK(7)) {
                EpiRes<1> E{H, HB1, SSQ + (size_t)(2 * i + 2) * TT, SSQ + (size_t)(2 * i + 1) * TT, PP};
                run_gemm(C, HB0, (const bf16*)(ws + WS_WG0 + (size_t)i * 2 * MiB), 1024, 1024, E); }
            }
        } else {
            const int j = (ph - 19) / 7, sub = (ph - 19) % 7, l = 2 + j;
            if (sub == 0) {
                if (j == 0) { if (PHK(8)) {
                    EpiSplit<1536, 4608, 5632, 1536, 3072, 1024, false> E{SSQ + (size_t)4 * TT, (bf16*)(ws + WS_KVRAW), (bf16*)(ws + WS_Q), (bf16*)(ws + WS_GATE), nullptr};
                    run_gemm(C, HB1, (const bf16*)(ws + WS_WKVA), 5632, 1024, E); }
                } else { if (PHK(9)) {
                    EpiSplit<3072, 4096, 4096, 3072, 1024, 1024, false> E{SSQ + (size_t)6 * TT, (bf16*)(ws + WS_Q), (bf16*)(ws + WS_GATE), nullptr, nullptr};
                    run_gemm(C, HB1, (const bf16*)(ws + WS_WAIN1), 4096, 1024, E); }
                }
            } else if (sub == 1) {
                if (j == 0) { if (PHK(10)) { const Ctx& Cp = C; p9_kvpass(Cp); convert_p(Cp, 3, PBUF[1]); } } else need_bar = false;
            } else if (sub == 2) { need_bar = false; if (PHK(11)) {
                const Ctx& Cp = C; LAS float* wl = (LAS float*)(Cp.lds + Cp.wave * 16384);
                for (int task = Cp.gw; task < 1024; task += Cp.ngw) attn_sample_task(Cp, j, task, wl); }
            } else if (sub == 3) { if (PHK(16)) {
                const Ctx& Cp = C; for (int task = Cp.ngw * 2 - 1 - Cp.gw; task >= 0 && task < 4096; task -= Cp.ngw) attn_prompt_task(Cp, j, task); }
            } else if (sub == 4) { need_bar = false; if (PHK(12)) {
                EpiRes<0> E{H, HB0, SSQ + (size_t)(2 * l + 1) * TT, nullptr, nullptr};
                run_gemm(C, (const bf16*)(ws + WS_OB), (const bf16*)(ws + (j ? WS_WAOUT1 : WS_WAOUT0)), 1024, 1024, E); }
            } else if (sub == 5) { if (PHK(15)) {
                EpiPlain E2{PP, 1024};
                run_gemm(C, PBUF[l & 1], (const bf16*)(ws + WS_WP0 + (size_t)l * 512 * 1024), 1024, 256, E2); }
            } else { if (PHK(13)) {
                EpiRes<1> E{H, HB1, (l < 3) ? SSQ + (size_t)(2 * l + 2) * TT : nullptr, SSQ + (size_t)(2 * l + 1) * TT, PP};
                run_gemm(C, HB0, (const bf16*)(ws + WS_WG0 + (size_t)l * 2 * MiB), 1024, 1024, E); }
            }
        }
        if (ph + 1 < hi && need_bar) { XcdBarrier bar; bar.bar = (unsigned*)(ws + WS_CTL) + CW_BAR; bar.x = xb_xcc_id(); bar.st = (volatile LAS unsigned*)(ldsb + MISC_OFF) + 8; xcd_barrier(bar); }
    }
}

extern "C" void kernel_launch(void* const* d_in, const int* in_sizes, int n_in, void* d_out, int out_size, void* d_ws, size_t ws_size, hipStream_t stream) {
    static int grid = 0;
    if (grid == 0) {
        int dev = 0, cus = 0;
        if (n_in != 27 || ws_size < WS_END) { fprintf(stderr, "kernel_launch: unexpected n_in %d or ws_size %zu\n", n_in, ws_size); grid = -1; return; }
        if (hipGetDevice(&dev) != hipSuccess || hipDeviceGetAttribute(&cus, hipDeviceAttributeMultiprocessorCount, dev) != hipSuccess) { grid = -1; return; }
        if (hipFuncSetAttribute((const void*)mk_fwd, hipFuncAttributeMaxDynamicSharedMemorySize, LDS_BYTES) != hipSuccess) { grid = -1; return; }
        grid = cus;
    }
    if (grid < 0) return;
    (void)hipMemsetAsync((char*)d_ws + WS_CTL, 0, WS_ZERO_BYTES, stream);
    Args a{};
    for (int i = 0; i < 27; ++i) a.in[i] = (const float*)d_in[i];
    a.out = (float*)d_out; a.ws = (unsigned char*)d_ws;
#if MK_LAUNCH_PER_PHASE
    for (int ph = 0; ph < N_PHASES; ++ph) { a.ph_lo = ph; a.ph_hi = ph + 1; hipLaunchKernelGGL(mk_fwd, dim3(grid), dim3(512), LDS_BYTES, stream, a); }
#else
    a.ph_lo = 0; a.ph_hi = N_PHASES;
    hipLaunchKernelGGL(mk_fwd, dim3(grid), dim3(512), LDS_BYTES, stream, a);
#endif
}
```

```cpp
#include <hip/hip_runtime.h>
#include <cstdio>
#include <cstdint>

#define LAS __attribute__((address_space(3)))
#define RLX_AGENT __ATOMIC_RELAXED, __HIP_MEMORY_SCOPE_AGENT
typedef unsigned short bf16;
typedef float f32x4 __attribute__((ext_vector_type(4)));
typedef float f32x2 __attribute__((ext_vector_type(2)));
typedef unsigned u32x4 __attribute__((ext_vector_type(4)));
typedef unsigned u32x2 __attribute__((ext_vector_type(2)));
typedef short bf16x8 __attribute__((ext_vector_type(8)));
typedef __bf16 bf16x2_t __attribute__((ext_vector_type(2)));

__device__ __forceinline__ unsigned pk2(float lo, float hi) { f32x2 v = {lo, hi}; bf16x2_t b = __builtin_convertvector(v, bf16x2_t); return __builtin_bit_cast(unsigned, b); }
__device__ __forceinline__ float bflo(unsigned u) { return __uint_as_float(u << 16); }
__device__ __forceinline__ float bfhi(unsigned u) { return __uint_as_float(u & 0xffff0000u); }
__device__ __forceinline__ float bf1(bf16 h) { return __uint_as_float(((unsigned)h) << 16); }
__device__ __forceinline__ void unpack8(const u32x4 v, float* f) { f[0] = bflo(v.x); f[1] = bfhi(v.x); f[2] = bflo(v.y); f[3] = bfhi(v.y); f[4] = bflo(v.z); f[5] = bfhi(v.z); f[6] = bflo(v.w); f[7] = bfhi(v.w); }
__device__ __forceinline__ u32x4 pack8(const float* f) { u32x4 v; v.x = pk2(f[0], f[1]); v.y = pk2(f[2], f[3]); v.z = pk2(f[4], f[5]); v.w = pk2(f[6], f[7]); return v; }
__device__ __forceinline__ float silu_f(float x) { return x / (1.f + __expf(-x)); }
__device__ __forceinline__ float sigmoid_f(float x) { return 1.f / (1.f + __expf(-x)); }
__device__ __forceinline__ float softplus_f(float x) { return x > 20.f ? x : log1pf(__expf(x)); }
__device__ __forceinline__ float wave_sum(float v) {
#pragma unroll
    for (int o = 1; o < 64; o <<= 1) v += __shfl_xor(v, o);
    return v;
}
__device__ __forceinline__ float wave_max(float v) {
#pragma unroll
    for (int o = 1; o < 64; o <<= 1) v = fmaxf(v, __shfl_xor(v, o));
    return v;
}

#define XB_TMO      128
#define XB_XCNT(j)  (256  + 64 * (j))
#define XB_XSUB(j)  (1280 + 64 * (j))
#define XB_XGEN(j)  (2304 + 64 * (j))
#define XB_TOP      3328
#define XB_TOPGEN   3392
#define XCD_BAR_WORDS 3456
#define XB_SPIN_CAP (1u << 18)

__device__ __forceinline__ unsigned xb_ld(unsigned* p)              { return __hip_atomic_load(p, __ATOMIC_RELAXED, __HIP_MEMORY_SCOPE_AGENT); }
__device__ __forceinline__ unsigned xb_add(unsigned* p, unsigned v) { return __hip_atomic_fetch_add(p, v, __ATOMIC_RELAXED, __HIP_MEMORY_SCOPE_AGENT); }
__device__ __forceinline__ unsigned xb_xcc_id() { return (unsigned)__builtin_amdgcn_s_getreg((3 << 11) | 20) & 0xFu; }
#define XB_SPIN(cond, bar) do { unsigned _sp = 0; while (cond) { __builtin_amdgcn_s_sleep(1); \
    if ((++_sp & 255u) == 0u) { if (xb_ld(&(bar)[XB_TMO])) break; if (_sp > XB_SPIN_CAP) { atomicAdd(&(bar)[XB_TMO], 1u); break; } } } } while (0)

struct XcdBarrier { unsigned* bar; unsigned x; volatile LAS unsigned* st; };

__device__ __forceinline__ XcdBarrier xcd_barrier_post(unsigned* bar, volatile LAS unsigned* st) {
    XcdBarrier b; b.bar = bar; b.x = xb_xcc_id(); b.st = st;
    if (threadIdx.x == 0) (void)xb_add(&bar[XB_XCNT(b.x)], 1u);
    return b;
}
__device__ __forceinline__ void xcd_barrier_complete(unsigned* bar, unsigned x, unsigned& nloc, unsigned& nx) {
    const unsigned G = gridDim.x * gridDim.y * gridDim.z;
    unsigned sum, cnt, mine, sp = 0u;
    for (;;) {
        sum = 0u; cnt = 0u; mine = 0u;
#pragma unroll
        for (unsigned j = 0; j < 16; ++j) { const unsigned c = xb_ld(&bar[XB_XCNT(j)]); sum += c; cnt += (c > 0u) ? 1u : 0u; mine = (j == x) ? c : mine; }
        if (sum == G) break;
        __builtin_amdgcn_s_sleep(1);
        if ((++sp & 255u) == 0u) { if (xb_ld(&bar[XB_TMO])) break; if (sp > XB_SPIN_CAP) { atomicAdd(&bar[XB_TMO], 1u); break; } }
    }
    nloc = mine > 0u ? mine : 1u; nx = cnt > 0u ? cnt : 1u;
}
__device__ __forceinline__ void xcd_barrier(const XcdBarrier& b) {
    asm volatile("s_waitcnt vmcnt(0)" ::: "memory");
    __syncthreads();
    if (threadIdx.x == 0) {
        unsigned* bar = b.bar;
        __builtin_amdgcn_s_waitcnt(0);
        unsigned nloc = b.st[0], nx = b.st[1];
        if (nloc == 0u) { xcd_barrier_complete(bar, b.x, nloc, nx); b.st[0] = nloc; b.st[1] = nx; }
        const unsigned old = xb_add(&bar[XB_XSUB(b.x)], 1u);
        const unsigned gen = old / nloc;
        if (old + 1u == (gen + 1u) * nloc) {
            __builtin_amdgcn_fence(__ATOMIC_RELEASE, "agent");
            asm volatile("s_waitcnt vmcnt(0)" ::: "memory");
            const unsigned og = xb_add(&bar[XB_TOP], 1u);
            const unsigned tg = og / nx;
            if (og + 1u == (tg + 1u) * nx) xb_add(&bar[XB_TOPGEN], 1u);
            else XB_SPIN(xb_ld(&bar[XB_TOPGEN]) == tg, bar);
            __builtin_amdgcn_fence(__ATOMIC_ACQUIRE, "agent");
            xb_add(&bar[XB_XGEN(b.x)], 1u);
            asm volatile("s_waitcnt vmcnt(0)" ::: "memory");
        } else {
            XB_SPIN(xb_ld(&bar[XB_XGEN(b.x)]) == gen, bar);
            __builtin_amdgcn_fence(__ATOMIC_ACQUIRE, "agent");
            asm volatile("s_waitcnt vmcnt(0)" ::: "memory");
        }
    }
    __syncthreads();
}
namespace pg8 {
#define PG8_LAS __attribute__((address_space(3)))
typedef unsigned short bf16_t;
typedef short bf16x8 __attribute__((ext_vector_type(8)));
typedef float f32x4 __attribute__((ext_vector_type(4)));
typedef unsigned u32x4 __attribute__((ext_vector_type(4)));
constexpr int BM = 256, BK = 64, HALF = 128, HTB = HALF * BK * 2  , STAGE_BYTES = 8 * HTB, NXCD = 8, WGM = 8;

__host__ __device__ __forceinline__ int lds_byte(int r, int c) { const int st = (r >> 4) * 2 + (c >> 5), rr = r & 15, cc = c & 31, ob = rr * 64 + cc * 2; return st * 1024 + (ob ^ (((ob >> 9) & 1) << 5)); }
__host__ __device__ __forceinline__ void stage_rc(int b, int& R, int& C) { const int st = b / 1024, sb = b % 1024, swz = sb ^ (((sb >> 9) & 1) << 5); R = (st >> 1) * 16 + swz / 64; C = (st & 1) * 32 + (swz % 64) / 2; }
__host__ __device__ __forceinline__ int perm32(int rho) { const int n = rho >> 4, i = rho & 15; return 8 * (i >> 2) + 4 * n + (i & 3); }

struct Unit { int pm, pn; };
struct Gemm { const bf16_t* A; const bf16_t* Bt; int M, N, K; };

struct StaticOrder {
    int nM, nN, nwg, G, c;
    __host__ __device__ void init(int M, int N, int G_, int c_) { nM = M / BM; nN = N / BM; nwg = nM * nN; G = G_; c = c_; }
    __host__ __device__ bool next(int i, Unit& u) const {
        const long L = (long)i * G + c; if (L >= nwg) return false;
        int wgid = (int)L; { const int q = nwg / NXCD, r = nwg % NXCD, xcd = wgid % NXCD, off = wgid / NXCD; wgid = (xcd < r ? xcd * (q + 1) : r * (q + 1) + (xcd - r) * q) + off; }
        const int nig = WGM * nN, gid = wgid / nig, fm = gid * WGM, gsz = (nM - fm) < WGM ? (nM - fm) : WGM;
        u.pm = fm + ((wgid % nig) % gsz); u.pn = (wgid % nig) / gsz; return true;
    }
    __device__ __forceinline__ void a_ready(const Unit&) const {}
    __device__ __forceinline__ void done(const Unit&) const {}
};

template <class Epi, class Sched, bool ALIGN_EPI = false, bool SP2 = false>
__device__ __forceinline__ void gemm_phase(PG8_LAS unsigned char* lds, const Gemm g, const Sched& S, const Epi& E) {
    int tid_l = threadIdx.x; asm volatile("" : "+v"(tid_l));
    const int tid = tid_l, wid = __builtin_amdgcn_readfirstlane(tid >> 6), lane = tid & 63, wr = wid >> 2, wc = wid & 3, fr = lane & 15, fq = lane >> 4;
    const int K = g.K, nt = K / BK;
    unsigned voffA[2], voffB[2];
#pragma unroll
    for (int i = 0; i < 2; ++i) { int R, C; stage_rc(tid * 16 + i * 8192, R, C); const int Rb = Epi::PERM ? ((R & ~31) + perm32(R & 31)) : R;
        voffA[i] = (unsigned)(R * K + C) * 2u; voffB[i] = (unsigned)(Rb * K + C) * 2u; }
    const size_t kstep = (size_t)(BK * 2);
    const size_t hstep = (size_t)HALF * K * 2;
    const size_t tstep = 2 * hstep;
    const unsigned ldsw = (unsigned)wid * 1024u;
    const int aoff = lds_byte(wr * 64 + fr, fq * 8), boff = lds_byte(wc * 32 + fr, fq * 8);
#define PG8_SA(b, h) (((b) * 2 + (h)) * HTB)
#define PG8_SB(b, h) ((4 + (b) * 2 + (h)) * HTB)
#define PG8_STAGE(bufoff, gbase, voff) do { _Pragma("unroll") for (int _i = 0; _i < 2; ++_i) \
        __builtin_amdgcn_global_load_lds((const unsigned*)((const char*)(gbase) + (voff)[_i]), (PG8_LAS unsigned*)(lds + (bufoff) + ldsw + _i * 8192), 16, 0, 0); } while (0)
#define PG8_LDA(dst, b, h) do { _Pragma("unroll") for (int m = 0; m < 4; ++m) _Pragma("unroll") for (int k = 0; k < 2; ++k) dst[m][k] = *(const PG8_LAS bf16x8*)(lds + PG8_SA(b, h) + aoff + m * 2048 + k * 1024); } while (0)
#define PG8_LDB(dst, b, h) do { _Pragma("unroll") for (int n = 0; n < 2; ++n) _Pragma("unroll") for (int k = 0; k < 2; ++k) dst[n][k] = *(const PG8_LAS bf16x8*)(lds + PG8_SB(b, h) + boff + n * 2048 + k * 1024); } while (0)
#define PG8_MMA(ai, bj, At, Bt) do { __builtin_amdgcn_s_setprio(1); _Pragma("unroll") for (int m = 0; m < 4; ++m) _Pragma("unroll") for (int n = 0; n < 2; ++n) _Pragma("unroll") for (int k = 0; k < 2; ++k) \
        acc[ai][bj][m][n] = __builtin_amdgcn_mfma_f32_16x16x32_bf16(Bt[n][k], At[m][k], acc[ai][bj][m][n], 0, 0, 0); __builtin_amdgcn_s_setprio(0); } while (0)
#define PG8_WAIT_V(n) asm volatile("s_waitcnt vmcnt(" #n ")" ::: "memory")
#define PG8_WAIT_L(n) asm volatile("s_waitcnt lgkmcnt(" #n ")" ::: "memory")
#define PG8_BAR __builtin_amdgcn_s_barrier()
#define PG8_SCHED __builtin_amdgcn_sched_barrier(0)
    Unit cur, nxt; int ui = 0;
    if (!S.next(0, cur)) return;
    f32x4 acc[2][2][4][2];
#pragma unroll
    for (int a = 0; a < 2; ++a)
#pragma unroll
        for (int b = 0; b < 2; ++b)
#pragma unroll
            for (int m = 0; m < 4; ++m)
#pragma unroll
                for (int n = 0; n < 2; ++n) acc[a][b][m][n] = (f32x4){0.f, 0.f, 0.f, 0.f};
    bf16x8 At[4][2], B0[2][2], B1[2][2];
    const char* cA = (const char*)g.A + (size_t)cur.pm * tstep; const char* cB = (const char*)g.Bt + (size_t)cur.pn * tstep;
    S.a_ready(cur);
    if constexpr (SP2) {
        PG8_STAGE(PG8_SB(0, 0), cB, voffB); PG8_STAGE(PG8_SB(0, 1), cB + hstep, voffB); PG8_STAGE(PG8_SA(0, 0), cA, voffA); PG8_STAGE(PG8_SA(0, 1), cA + hstep, voffA);
        if (wr == 1) PG8_BAR;
        PG8_WAIT_V(2); PG8_BAR;
        PG8_STAGE(PG8_SB(1, 0), cB + kstep, voffB); PG8_STAGE(PG8_SA(1, 0), cA + kstep, voffA); PG8_STAGE(PG8_SB(1, 1), cB + hstep + kstep, voffB);
        PG8_WAIT_V(6); PG8_BAR;
    } else {
        PG8_STAGE(PG8_SB(0, 0), cB, voffB); PG8_STAGE(PG8_SA(0, 0), cA, voffA); PG8_STAGE(PG8_SB(0, 1), cB + hstep, voffB); PG8_STAGE(PG8_SA(0, 1), cA + hstep, voffA);
        if (wr == 1) PG8_BAR;
        PG8_WAIT_V(4); PG8_BAR;
        PG8_STAGE(PG8_SB(1, 0), cB + kstep, voffB); PG8_STAGE(PG8_SA(1, 0), cA + kstep, voffA); PG8_STAGE(PG8_SB(1, 1), cB + hstep + kstep, voffB);
        PG8_WAIT_V(6); PG8_BAR;
    }
    for (;;) {
        const bool has_next = S.next(ui + 1, nxt);
        const char* nA = has_next ? (const char*)g.A + (size_t)nxt.pm * tstep : cA; const char* nB = has_next ? (const char*)g.Bt + (size_t)nxt.pn * tstep : cB;
        for (int t = 0; t < nt; t += 2) {
            const bool last = (t == nt - 2);
            const char* a1 = cA + (size_t)(t + 1) * kstep;
            const char* a2 = last ? nA : cA + (size_t)(t + 2) * kstep; const char* b2 = last ? nB : cB + (size_t)(t + 2) * kstep;
            const char* a3 = a2 + kstep; const char* b3 = b2 + kstep;
            if (last && has_next) S.a_ready(nxt);
            if constexpr (SP2) {
            PG8_LDB(B0, 0, 0); PG8_LDB(B1, 0, 1); PG8_SCHED; PG8_LDA(At, 0, 0); PG8_STAGE(PG8_SA(1, 1), a1 + hstep, voffA);
            PG8_WAIT_V(8); PG8_WAIT_L(0); PG8_BAR; PG8_MMA(0, 0, At, B0); PG8_MMA(0, 1, At, B1); PG8_BAR; PG8_SCHED;
            PG8_LDA(At, 0, 1); PG8_STAGE(PG8_SB(0, 0), b2, voffB); PG8_STAGE(PG8_SB(0, 1), b2 + hstep, voffB); PG8_STAGE(PG8_SA(0, 0), a2, voffA);
            PG8_WAIT_V(8); PG8_WAIT_L(0); PG8_BAR; PG8_MMA(1, 0, At, B0); PG8_MMA(1, 1, At, B1); PG8_BAR; PG8_SCHED;
            PG8_LDB(B0, 1, 0); PG8_LDB(B1, 1, 1); PG8_SCHED; PG8_LDA(At, 1, 0); PG8_STAGE(PG8_SA(0, 1), a2 + hstep, voffA);
            PG8_WAIT_V(8); PG8_WAIT_L(0); PG8_BAR; PG8_MMA(0, 0, At, B0); PG8_MMA(0, 1, At, B1); PG8_BAR; PG8_SCHED;
            PG8_LDA(At, 1, 1); PG8_STAGE(PG8_SB(1, 0), b3, voffB); PG8_STAGE(PG8_SB(1, 1), b3 + hstep, voffB); PG8_STAGE(PG8_SA(1, 0), a3, voffA);
            PG8_WAIT_V(8); PG8_WAIT_L(0); PG8_BAR; PG8_MMA(1, 0, At, B0); PG8_MMA(1, 1, At, B1); PG8_BAR; PG8_SCHED;
            } else {
            PG8_LDB(B0, 0, 0); PG8_SCHED; PG8_LDA(At, 0, 0); PG8_STAGE(PG8_SA(1, 1), a1 + hstep, voffA);
            PG8_WAIT_L(8); PG8_BAR; PG8_WAIT_L(0); PG8_MMA(0, 0, At, B0); PG8_BAR; PG8_SCHED;
            PG8_LDB(B1, 0, 1); PG8_STAGE(PG8_SB(0, 0), b2, voffB);
            PG8_BAR; PG8_WAIT_L(0); PG8_MMA(0, 1, At, B1); PG8_BAR;
            PG8_LDA(At, 0, 1); PG8_STAGE(PG8_SA(0, 0), a2, voffA);
            PG8_BAR; PG8_WAIT_L(0); PG8_MMA(1, 0, At, B0); PG8_BAR; PG8_SCHED;
            PG8_STAGE(PG8_SB(0, 1), b2 + hstep, voffB);
            PG8_WAIT_V(6); PG8_BAR; PG8_MMA(1, 1, At, B1); PG8_BAR;
            PG8_LDB(B0, 1, 0); PG8_SCHED; PG8_LDA(At, 1, 0); PG8_STAGE(PG8_SA(0, 1), a2 + hstep, voffA);
            PG8_WAIT_L(8); PG8_BAR; PG8_WAIT_L(0); PG8_MMA(0, 0, At, B0); PG8_BAR; PG8_SCHED;
            PG8_LDB(B1, 1, 1); PG8_STAGE(PG8_SB(1, 0), b3, voffB);
            PG8_BAR; PG8_WAIT_L(0); PG8_MMA(0, 1, At, B1); PG8_BAR;
            PG8_LDA(At, 1, 1); PG8_STAGE(PG8_SA(1, 0), a3, voffA);
            PG8_BAR; PG8_WAIT_L(0); PG8_MMA(1, 0, At, B0); PG8_BAR; PG8_SCHED;
            PG8_STAGE(PG8_SB(1, 1), b3 + hstep, voffB);
            PG8_WAIT_V(6); PG8_BAR; PG8_MMA(1, 1, At, B1); PG8_BAR;
            }
        }
        if constexpr (ALIGN_EPI) { if (wr == 0) PG8_BAR; }
        if constexpr (!Epi::AFTER_DRAIN) { E(acc, cur, wr, wc, fr, fq); S.done(cur); }
        if (!has_next) break;
#pragma unroll
        for (int a = 0; a < 2; ++a)
#pragma unroll
            for (int b = 0; b < 2; ++b)
#pragma unroll
                for (int m = 0; m < 4; ++m)
#pragma unroll
                    for (int n = 0; n < 2; ++n) acc[a][b][m][n] = (f32x4){0.f, 0.f, 0.f, 0.f};
        cur = nxt; cA = nA; cB = nB; ++ui;
        if constexpr (ALIGN_EPI) { if (wr == 1) PG8_BAR; }
    }
    PG8_WAIT_V(0);
    if constexpr (!ALIGN_EPI) { if (wr == 0) PG8_BAR; }
    PG8_BAR;
    if constexpr (Epi::AFTER_DRAIN) { E.fused(acc, cur, wr, wc, fr, fq, lds, wid, lane); S.done(cur); }
#undef PG8_SA
#undef PG8_SB
#undef PG8_STAGE
#undef PG8_LDA
#undef PG8_LDB
#undef PG8_MMA
#undef PG8_WAIT_V
#undef PG8_WAIT_L
#undef PG8_BAR
#undef PG8_SCHED
}
}

constexpr int DM = 1024, TP = 16384, TSM = 256, TT = 16640, SEQ = 8192;
constexpr int DIN = 2048, CONVD = 3072, NH = 32, DST = 128;
constexpr int MINW = 5152, MINP = 5376;
constexpr float EPS = 1e-6f;
constexpr size_t MiB = 1u << 20;
constexpr size_t O_Y = 0, O_SSMP = 17039360, O_CONVP = 18087936, O_SSMS = 18124800, O_CONVS = 34902016;
constexpr size_t O_KVP1 = 35491840, O_KVP2 = 35622912, O_KVP3 = 36147200, O_KVS1 = 38244352, O_KVS2 = 38375424, O_KVS3 = 38506496;
constexpr size_t WS_CTL = 0, WS_SSQ = 1 * MiB, WS_ZERO_BYTES = 2 * MiB;
constexpr size_t WS_WIN0 = 2 * MiB, WS_WIN1 = 13 * MiB, WS_WOUT0 = 24 * MiB, WS_WOUT1 = 28 * MiB, WS_WKVA = 32 * MiB, WS_WAIN1 = 43 * MiB;
constexpr size_t WS_WAOUT0 = 51 * MiB, WS_WAOUT1 = 53 * MiB, WS_WG0 = 55 * MiB, WS_WP0 = 63 * MiB;
constexpr size_t WS_ROPEC = 65 * MiB, WS_ROPES = 66 * MiB + 512 * 1024;
constexpr size_t WS_HB = 68 * MiB, WS_PBUFA = 101 * MiB, WS_PBUFB = 110 * MiB, WS_PP = 119 * MiB;
constexpr size_t WS_DTRAW = 152 * MiB, WS_DTC = 155 * MiB, WS_ACU = 157 * MiB, WS_XSS = 159 * MiB, WS_YSRAW = 162 * MiB;
constexpr size_t WS_ZB = 164 * MiB, WS_XBC = 229 * MiB, WS_XT = 327 * MiB, WS_BROW = 391 * MiB, WS_BT = 407 * MiB, WS_CROW = 423 * MiB, WS_STATES = 439 * MiB;
constexpr size_t WS_YB = WS_XBC;
constexpr size_t WS_GATE = WS_ZB, WS_Q = WS_XBC, WS_KVRAW = WS_XT, WS_KN = WS_BROW, WS_KSS = WS_CROW, WS_VSS = WS_CROW + 1 * MiB, WS_VT = WS_STATES, WS_OB = WS_STATES + 24 * MiB;
constexpr size_t WS_END = 503 * MiB;
constexpr int CW_BAR = 4096;
constexpr int ROPE_ROWS = 8200;

constexpr int RING_BYTES = 143360, MISC_OFF = RING_BYTES + 320, LDS_BYTES = 147456;

struct Args { const float* in[27]; float* out; unsigned char* ws; unsigned long long dup; int ph_lo, ph_hi; };

struct Ctx {
    LAS unsigned char* lds;
    int tid, lane, wave, vcu, G;
    int gw, ngw;
    const float* const* in; float* out; unsigned char* ws;
};

template <int C1, int C2, int C3, int LD0, int LD1, int LD2, bool HAS_DT>
struct EpiSplit {
    static constexpr bool PERM = true, AFTER_DRAIN = false;
    const float* ssq; bf16* p0; bf16* p1; bf16* p2; float* dt;
    template <int LD> __device__ __forceinline__ void seg(const f32x4 (&acc)[2][2][4][2], bf16* base, unsigned row0, unsigned col0) const {
#pragma unroll
        for (int ai = 0; ai < 2; ++ai)
#pragma unroll
            for (int m = 0; m < 4; ++m) { const unsigned r = row0 + ai * 128 + m * 16; bf16* rowp = base + (r * (unsigned)LD + col0); const float s = rsqrtf(ssq[r] * (1.f / 1024.f) + EPS);
#pragma unroll
                for (int bj = 0; bj < 2; ++bj) { const f32x4 v0 = acc[ai][bj][m][0] * s, v1 = acc[ai][bj][m][1] * s;
                    u32x4 w; w.x = pk2(v0[0], v0[1]); w.y = pk2(v0[2], v0[3]); w.z = pk2(v1[0], v1[1]); w.w = pk2(v1[2], v1[3]);
                    *(u32x4*)(rowp + bj * 128) = w; } }
    }
    __device__ __forceinline__ void operator()(const f32x4 (&acc)[2][2][4][2], const pg8::Unit& u, int wr, int wc, int fr, int fq) const {
        const int colt = u.pn * 256; const unsigned row0 = u.pm * 256 + wr * 64 + fr; const unsigned cw = wc * 32 + 8 * fq;
        if (colt >= C3) {
            if (HAS_DT && wc == 0) {
#pragma unroll
                for (int ai = 0; ai < 2; ++ai)
#pragma unroll
                    for (int m = 0; m < 4; ++m) { const unsigned r = row0 + ai * 128 + m * 16; float* o = dt + (r * 32u + 8 * fq); const float s = rsqrtf(ssq[r] * (1.f / 1024.f) + EPS);
                        *(f32x4*)o = acc[ai][0][m][0] * s; *(f32x4*)(o + 4) = acc[ai][0][m][1] * s; }
            }
            return;
        }
        if (colt < C1) seg<LD0>(acc, p0, row0, colt + cw);
        else if (colt < C2) seg<LD1>(acc, p1, row0, colt - C1 + cw);
        else seg<LD2>(acc, p2, row0, colt - C2 + cw);
    }
};

template <int MODE> struct EpiRes {
    static constexpr bool PERM = true, AFTER_DRAIN = false;
    float* H; bf16* HB; float* ssq_out; const float* ssq_in; const bf16* PP; float* Hout;
    __device__ __forceinline__ void operator()(const f32x4 (&acc)[2][2][4][2], const pg8::Unit& u, int wr, int wc, int fr, int fq) const {
        const int row0 = u.pm * 256 + wr * 64 + fr, col0 = u.pn * 256 + wc * 32 + 8 * fq;
#pragma unroll
        for (int ai = 0; ai < 2; ++ai)
#pragma unroll
            for (int m = 0; m < 4; ++m) {
                const int r = row0 + ai * 128 + m * 16; const size_t off = (size_t)r * DM + col0;
                float rs = 1.f; if (MODE == 1) rs = rsqrtf(ssq_in[r] * (1.f / 1024.f) + EPS);
                float ss = 0.f;
#pragma unroll
                for (int bj = 0; bj < 2; ++bj) {
                    const f32x4 b0 = *(const f32x4*)(H + off + bj * 128), b1 = *(const f32x4*)(H + off + bj * 128 + 4);
                    f32x4 d0 = acc[ai][bj][m][0], d1 = acc[ai][bj][m][1];
                    if (MODE == 1) {
                        const u32x4 pv = *(const u32x4*)(PP + off + bj * 128); float pf[8]; unpack8(pv, pf);
#pragma unroll
                        for (int j = 0; j < 4; ++j) { d0[j] = sigmoid_f(d0[j] * rs) * pf[j]; d1[j] = sigmoid_f(d1[j] * rs) * pf[4 + j]; }
                    }
                    const f32x4 h0 = b0 + d0, h1 = b1 + d1;
                    *(f32x4*)(Hout + off + bj * 128) = h0; *(f32x4*)(Hout + off + bj * 128 + 4) = h1;
                    u32x4 w; w.x = pk2(h0[0], h0[1]); w.y = pk2(h0[2], h0[3]); w.z = pk2(h1[0], h1[1]); w.w = pk2(h1[2], h1[3]);
                    *(u32x4*)(HB + off + bj * 128) = w;
                    ss += (h0[0] * h0[0] + h0[1] * h0[1]) + (h0[2] * h0[2] + h0[3] * h0[3]) + (h1[0] * h1[0] + h1[1] * h1[1]) + (h1[2] * h1[2] + h1[3] * h1[3]);
                }
                ss += __shfl_xor(ss, 16); ss += __shfl_xor(ss, 32);
                if (fq == 0 && ssq_out != nullptr) atomicAdd(ssq_out + r, ss);
                if (m & 1) asm volatile("" ::: "memory");
            }
    }
};

struct EpiPlain {
    static constexpr bool PERM = true, AFTER_DRAIN = false;
    bf16* O; int ld;
    __device__ __forceinline__ void operator()(const f32x4 (&acc)[2][2][4][2], const pg8::Unit& u, int wr, int wc, int fr, int fq) const {
        const int row0 = u.pm * 256 + wr * 64 + fr, col0 = u.pn * 256 + wc * 32 + 8 * fq;
#pragma unroll
        for (int ai = 0; ai < 2; ++ai)
#pragma unroll
            for (int m = 0; m < 4; ++m) { bf16* rowp = O + (size_t)(row0 + ai * 128 + m * 16) * ld + col0;
#pragma unroll
                for (int bj = 0; bj < 2; ++bj) { const f32x4 v0 = acc[ai][bj][m][0], v1 = acc[ai][bj][m][1];
                    u32x4 w; w.x = pk2(v0[0], v0[1]); w.y = pk2(v0[2], v0[3]); w.z = pk2(v1[0], v1[1]); w.w = pk2(v1[2], v1[3]);
                    *(u32x4*)(rowp + bj * 128) = w; } }
    }
};

__device__ __forceinline__ void transpose_item(const float* __restrict__ W, int K, int Nsrc, bf16* __restrict__ WT, int row_off, const float* __restrict__ scale,
                                               LAS float* scr, int kb, int nb, int lane) {
    const int k0 = 64 * kb, n0 = 32 * nb;
    const int c = lane & 7;
    if (n0 >= Nsrc) {
#pragma unroll
        for (int j = 0; j < 4; ++j) { const int n = (lane >> 3) + 8 * j; *(u32x4*)(WT + (size_t)(row_off + n0 + n) * K + k0 + 8 * c) = (u32x4){0u, 0u, 0u, 0u}; }
        return;
    }
#pragma unroll 8
    for (int i = 0; i < 32; ++i) { const int kk = 2 * i + (lane >> 5); float v = W[(size_t)(k0 + kk) * Nsrc + n0 + (lane & 31)]; if (scale) v *= scale[k0 + kk]; scr[kk * 33 + (lane & 31)] = v; }
    asm volatile("s_waitcnt lgkmcnt(0)" ::: "memory");
#pragma unroll
    for (int j = 0; j < 4; ++j) { const int n = (lane >> 3) + 8 * j; const LAS float* s = scr + (8 * c) * 33 + n;
        u32x4 o; o.x = pk2(s[0 * 33], s[1 * 33]); o.y = pk2(s[2 * 33], s[3 * 33]); o.z = pk2(s[4 * 33], s[5 * 33]); o.w = pk2(s[6 * 33], s[7 * 33]);
        *(u32x4*)(WT + (size_t)(row_off + n0 + n) * K + k0 + 8 * c) = o; }
    asm volatile("s_waitcnt lgkmcnt(0)" ::: "memory");
}

struct WJob { const float* W; const float* scale; bf16* WT; int K, Nsrc, Ndst, row_off; };

__device__ __forceinline__ void p0_prologue(const Ctx& C) {
    LAS float* scr = (LAS float*)(C.lds + C.wave * 16384);
    unsigned char* ws = C.ws;
#pragma unroll 1
    for (int job = 0; job < 20; ++job) {
        WJob J;
        if (job < 2)       { J = {C.in[10] + (size_t)job * 1024 * MINW, C.in[9] + job * 1024, (bf16*)(ws + (job ? WS_WIN1 : WS_WIN0)), 1024, MINW, MINP, 0}; }
        else if (job < 4)  { const int i = job - 2; J = {C.in[17] + (size_t)i * 2048 * 1024, C.in[16] + i * 2048, (bf16*)(ws + (i ? WS_WOUT1 : WS_WOUT0)), 2048, 1024, 1024, 0}; }
        else if (job == 4) { J = {C.in[19], C.in[18], (bf16*)(ws + WS_WKVA), 1024, 1536, 1536, 0}; }
        else if (job == 5) { J = {C.in[21], C.in[9] + 2 * 1024, (bf16*)(ws + WS_WKVA), 1024, 4096, 4096, 1536}; }
        else if (job == 6) { J = {C.in[21] + (size_t)1024 * 4096, C.in[9] + 3 * 1024, (bf16*)(ws + WS_WAIN1), 1024, 4096, 4096, 0}; }
        else if (job < 9)  { const int i = job - 7; J = {C.in[23] + (size_t)i * 1024 * 1024, nullptr, (bf16*)(ws + (i ? WS_WAOUT1 : WS_WAOUT0)), 1024, 1024, 1024, 0}; }
        else if (job < 13) { const int i = job - 9; J = {C.in[25] + (size_t)i * 1024 * 1024, C.in[26] + i * 1024, (bf16*)(ws + WS_WG0 + (size_t)i * 2 * MiB), 1024, 1024, 1024, 0}; }
        else if (job < 17) { const int i = job - 13; J = {C.in[24] + (size_t)i * 256 * 1024, nullptr, (bf16*)(ws + WS_WP0 + (size_t)i * 512 * 1024), 256, 1024, 1024, 0}; }
        else break;
        const int nblk = J.Ndst / 32, nitems = (J.K / 64) * nblk;
        for (int it = C.gw; it < nitems; it += C.ngw) transpose_item(J.W, J.K, J.Nsrc, J.WT, J.row_off, J.scale, scr, it / nblk, it % nblk, C.lane);
    }
    {
        float* H = C.out; bf16* HB = (bf16*)(ws + WS_OB); float* ssq = (float*)(ws + WS_SSQ);
        for (int m = C.gw; m < TT; m += C.ngw) {
            const float* xrow = (m < TP) ? C.in[0] + (size_t)m * DM : C.in[1] + (size_t)(m - TP) * DM;
            const f32x4* xr = (const f32x4*)xrow + C.lane;
            f32x4 v[4]; float s = 0.f;
#pragma unroll
            for (int j = 0; j < 4; ++j) { v[j] = xr[64 * j]; s += (v[j][0] * v[j][0] + v[j][1] * v[j][1]) + (v[j][2] * v[j][2] + v[j][3] * v[j][3]); }
            s = wave_sum(s);
            f32x4* ho = (f32x4*)(H + (size_t)m * DM) + C.lane; u32x2* bo = (u32x2*)(HB + (size_t)m * DM) + C.lane;
#pragma unroll
            for (int j = 0; j < 4; ++j) { ho[64 * j] = v[j]; u32x2 w; w.x = pk2(v[j][0], v[j][1]); w.y = pk2(v[j][2], v[j][3]); bo[64 * j] = w; }
            if (C.lane == 0) ssq[m] = s;
        }
    }
    {
        float* rc = (float*)(ws + WS_ROPEC); float* rsn = (float*)(ws + WS_ROPES);
        const int gt = C.gw * 64 + C.lane, ngt = C.ngw * 64;
        for (int e = gt; e < ROPE_ROWS * 32; e += ngt) {
            const int pos = e >> 5, i = e & 31;
            const float inv = 1.0f / powf(10000.0f, (float)i / 32.0f);
            const float ang = (float)pos * inv;
            rc[e] = cosf(ang); rsn[e] = sinf(ang);
        }
    }
}

__device__ __forceinline__ void convert_p(const Ctx& C, int layer, bf16* dst) {
    const float* pp = C.in[7] + (size_t)layer * TP * 256; const float* ps = C.in[8] + (size_t)layer * TSM * 256;
    const int gt = C.gw * 64 + C.lane, ngt = C.ngw * 64;
    for (int e = gt; e < TT * 32; e += ngt) {
        const int row = e >> 5, c = (e & 31) * 8;
        const float* src = (row < TP) ? pp + (size_t)row * 256 + c : ps + (size_t)(row - TP) * 256 + c;
        const f32x4 a = *(const f32x4*)src, b = *(const f32x4*)(src + 4);
        u32x4 w; w.x = pk2(a[0], a[1]); w.y = pk2(a[2], a[3]); w.z = pk2(b[0], b[1]); w.w = pk2(b[2], b[3]);
        *(u32x4*)(dst + (size_t)row * 256 + c) = w;
    }
}

__device__ __forceinline__ void p2_conv(const Ctx& C, int layer) {
    unsigned char* ws = C.ws;
    const bf16* XBC = (const bf16*)(ws + WS_XBC);
    bf16* XT = (bf16*)(ws + WS_XT); bf16* BROW = (bf16*)(ws + WS_BROW); bf16* BT = (bf16*)(ws + WS_BT); bf16* CROW = (bf16*)(ws + WS_CROW);
    const float* cw = C.in[11] + (size_t)layer * 4 * CONVD; const float* cbias = C.in[12] + (size_t)layer * CONVD;
    for (int unit = blockIdx.x; unit < 128 * 12; unit += C.G) {
        const int cidx = unit / 12, cb = unit % 12;
        const int c8 = cb * 32 + (C.tid >> 4), run = C.tid & 15, ch = c8 * 8;
        const int tok0 = cidx * 128 + run * 8, sseq0 = (cidx & 63) * 128 + run * 8;
        float w[4][8], o[8][8];
#pragma unroll
        for (int k = 0; k < 4; ++k) { const f32x4 a = *(const f32x4*)(cw + k * CONVD + ch), b = *(const f32x4*)(cw + k * CONVD + ch + 4);
#pragma unroll
            for (int i = 0; i < 4; ++i) { w[k][i] = a[i]; w[k][4 + i] = b[i]; } }
        { const f32x4 a = *(const f32x4*)(cbias + ch), b = *(const f32x4*)(cbias + ch + 4);
#pragma unroll
            for (int j = 0; j < 8; ++j)
#pragma unroll
                for (int i = 0; i < 4; ++i) { o[j][i] = a[i]; o[j][4 + i] = b[i]; } }
        u32x4 raw[11];
#pragma unroll
        for (int r = 0; r < 11; ++r) { raw[r] = (u32x4){0u, 0u, 0u, 0u}; if (sseq0 + r - 3 >= 0) raw[r] = *(const u32x4*)(XBC + (size_t)(tok0 + r - 3) * CONVD + ch); }
#pragma unroll
        for (int r = 0; r < 11; ++r) { float x[8]; unpack8(raw[r], x);
#pragma unroll
            for (int j = 0; j < 8; ++j) { const int k = r - j; if (k >= 0 && k < 4) {
#pragma unroll
                for (int i = 0; i < 8; ++i) o[j][i] += w[k][i] * x[i]; } } }
#pragma unroll
        for (int j = 0; j < 8; ++j)
#pragma unroll
            for (int i = 0; i < 8; ++i) o[j][i] = silu_f(o[j][i]);
        if (ch < DIN) {
            const int head = ch >> 6, p0 = ch & 63;
#pragma unroll
            for (int i = 0; i < 8; ++i) { float t[8];
#pragma unroll
                for (int j = 0; j < 8; ++j) t[j] = o[j][i];
                *(u32x4*)(XT + ((size_t)(cidx * 32 + head) * 64 + p0 + i) * 128 + run * 8) = pack8(t); }
        } else if (ch < DIN + 512) {
            const int g = (ch - DIN) >> 7, n0 = (ch - DIN) & 127;
#pragma unroll
            for (int j = 0; j < 8; ++j) *(u32x4*)(BROW + ((size_t)(cidx * 4 + g) * 128 + run * 8 + j) * 128 + n0) = pack8(o[j]);
#pragma unroll
            for (int i = 0; i < 8; ++i) { float t[8];
#pragma unroll
                for (int j = 0; j < 8; ++j) t[j] = o[j][i];
                *(u32x4*)(BT + ((size_t)(cidx * 4 + g) * 128 + n0 + i) * 128 + run * 8) = pack8(t); }
        } else {
            const int g = (ch - DIN - 512) >> 7, n0 = (ch - DIN - 512) & 127;
#pragma unroll
            for (int j = 0; j < 8; ++j) *(u32x4*)(CROW + ((size_t)(cidx * 4 + g) * 128 + run * 8 + j) * 128 + n0) = pack8(o[j]);
        }
        if ((cidx & 63) == 63 && run == 15) {
            const int b = cidx >> 6;
#pragma unroll
            for (int j = 0; j < 3; ++j) { float x[8]; unpack8(raw[8 + j], x); float* dst = C.out + O_CONVP + ((size_t)(layer * 2 + b) * 3 + j) * CONVD + ch;
                *(f32x4*)dst = (f32x4){x[0], x[1], x[2], x[3]}; *(f32x4*)(dst + 4) = (f32x4){x[4], x[5], x[6], x[7]}; }
        }
    }
    {
        const float* cst = C.in[3] + (size_t)layer * 32 * 3 * CONVD; float* XSS = (float*)(ws + WS_XSS);
        const int gt = C.gw * 64 + C.lane, ngt = C.ngw * 64;
        for (int e = gt; e < 32 * 384; e += ngt) {
            const int sb = e / 384, ch = (e % 384) * 8;
            float w[4][8], xin[11][8];
#pragma unroll
            for (int k = 0; k < 4; ++k) { const f32x4 a = *(const f32x4*)(cw + k * CONVD + ch), b = *(const f32x4*)(cw + k * CONVD + ch + 4);
#pragma unroll
                for (int i = 0; i < 4; ++i) { w[k][i] = a[i]; w[k][4 + i] = b[i]; } }
            float bs[8]; { const f32x4 a = *(const f32x4*)(cbias + ch), b = *(const f32x4*)(cbias + ch + 4);
#pragma unroll
                for (int i = 0; i < 4; ++i) { bs[i] = a[i]; bs[4 + i] = b[i]; } }
#pragma unroll
            for (int r = 0; r < 3; ++r) { const float* s = cst + ((size_t)sb * 3 + r) * CONVD + ch; const f32x4 a = *(const f32x4*)s, b = *(const f32x4*)(s + 4);
#pragma unroll
                for (int i = 0; i < 4; ++i) { xin[r][i] = a[i]; xin[r][4 + i] = b[i]; } }
#pragma unroll
            for (int r = 0; r < 8; ++r) { const u32x4 v = *(const u32x4*)(XBC + (size_t)(TP + sb * 8 + r) * CONVD + ch); unpack8(v, xin[3 + r]); }
#pragma unroll
            for (int j = 0; j < 8; ++j) { float o[8];
#pragma unroll
                for (int i = 0; i < 8; ++i) { float a = bs[i];
#pragma unroll
                    for (int k = 0; k < 4; ++k) a += w[k][i] * xin[j + k][i];
                    o[i] = silu_f(a); }
                float* dst = XSS + (size_t)(sb * 8 + j) * CONVD + ch;
                *(f32x4*)dst = (f32x4){o[0], o[1], o[2], o[3]}; *(f32x4*)(dst + 4) = (f32x4){o[4], o[5], o[6], o[7]}; }
#pragma unroll
            for (int j = 0; j < 3; ++j) { float* dst = C.out + O_CONVS + ((size_t)(layer * 32 + sb) * 3 + j) * CONVD + ch;
                *(f32x4*)dst = (f32x4){xin[8 + j][0], xin[8 + j][1], xin[8 + j][2], xin[8 + j][3]}; *(f32x4*)(dst + 4) = (f32x4){xin[8 + j][4], xin[8 + j][5], xin[8 + j][6], xin[8 + j][7]}; }
        }
    }
    {
        const float* DTRAW = (const float*)(ws + WS_DTRAW); float* DTC = (float*)(ws + WS_DTC); float* ACU = (float*)(ws + WS_ACU);
        const float* dtb = C.in[13] + layer * 32; const float* alog = C.in[14] + layer * 32;
        for (int task = C.gw; task < 128 * 32; task += C.ngw) {
            const int cidx = task >> 5, head = task & 31;
            const int t = cidx * 128 + 2 * C.lane;
            const float A = -__expf(alog[head]), bsv = dtb[head];
            const float d0 = softplus_f(DTRAW[(size_t)t * 32 + head] + bsv), d1 = softplus_f(DTRAW[(size_t)(t + 1) * 32 + head] + bsv);
            const float a0 = d0 * A, a1 = d1 * A;
            float x = a0 + a1;
#pragma unroll
            for (int o = 1; o < 64; o <<= 1) { const float v = __shfl_up(x, o); if (C.lane >= o) x += v; }
            *(f32x2*)(DTC + (size_t)task * 128 + 2 * C.lane) = (f32x2){d0, d1};
            *(f32x2*)(ACU + (size_t)task * 128 + 2 * C.lane) = (f32x2){x - a1, x};
        }
    }
}

#define MFMA16(a, b, c) __builtin_amdgcn_mfma_f32_16x16x32_bf16((a), (b), (c), 0, 0, 0)

__device__ __forceinline__ void s1_task(const Ctx& C, int cidx, int head) {
    unsigned char* ws = C.ws;
    const bf16* xt = (const bf16*)(ws + WS_XT) + (size_t)(cidx * 32 + head) * 64 * 128;
    const bf16* bt = (const bf16*)(ws + WS_BT) + (size_t)(cidx * 4 + (head >> 3)) * 128 * 128;
    const float* dtc = (const float*)(ws + WS_DTC) + (size_t)(cidx * 32 + head) * 128;
    const float* acu = (const float*)(ws + WS_ACU) + (size_t)(cidx * 32 + head) * 128;
    bf16* st = (bf16*)(ws + WS_STATES) + (size_t)(cidx * 32 + head) * 64 * 128;
    const int fr = C.lane & 15, fq = C.lane >> 4;
    const float aend = acu[127];
    f32x4 acc[8][4];
#pragma unroll
    for (int a = 0; a < 8; ++a)
#pragma unroll
        for (int b = 0; b < 4; ++b) acc[a][b] = (f32x4){0.f, 0.f, 0.f, 0.f};
#pragma unroll 1
    for (int ks = 0; ks < 4; ++ks) {
        const int s0 = ks * 32 + 8 * fq;
        float wv[8];
        { const f32x4 d0 = *(const f32x4*)(dtc + s0), d1 = *(const f32x4*)(dtc + s0 + 4), a0 = *(const f32x4*)(acu + s0), a1 = *(const f32x4*)(acu + s0 + 4);
#pragma unroll
          for (int j = 0; j < 4; ++j) { wv[j] = d0[j] * __expf(aend - a0[j]); wv[4 + j] = d1[j] * __expf(aend - a1[j]); } }
        bf16x8 bfr[8];
#pragma unroll
        for (int nt = 0; nt < 8; ++nt) bfr[nt] = *(const bf16x8*)(bt + (size_t)(nt * 16 + fr) * 128 + s0);
#pragma unroll
        for (int pt = 0; pt < 4; ++pt) {
            const u32x4 raw = *(const u32x4*)(xt + (size_t)(pt * 16 + fr) * 128 + s0);
            float x[8]; unpack8(raw, x);
#pragma unroll
            for (int j = 0; j < 8; ++j) x[j] *= wv[j];
            const bf16x8 afr = __builtin_bit_cast(bf16x8, pack8(x));
#pragma unroll
            for (int nt = 0; nt < 8; ++nt) acc[nt][pt] = MFMA16(bfr[nt], afr, acc[nt][pt]);
        }
    }
#pragma unroll
    for (int nt = 0; nt < 8; ++nt)
#pragma unroll
        for (int pt = 0; pt < 4; ++pt) { u32x2 w; w.x = pk2(acc[nt][pt][0], acc[nt][pt][1]); w.y = pk2(acc[nt][pt][2], acc[nt][pt][3]);
            *(u32x2*)(st + (size_t)(pt * 16 + fr) * 128 + nt * 16 + 4 * fq) = w; }
}

__device__ __forceinline__ void ssd_sample_task(const Ctx& C, int layer, int sb, int head, LAS float* wl) {
    unsigned char* ws = C.ws;
    const float* XSS = (const float*)(ws + WS_XSS); const float* DTRAW = (const float*)(ws + WS_DTRAW); const bf16* ZB = (const bf16*)(ws + WS_ZB);
    float* YSRAW = (float*)(ws + WS_YSRAW);
    const float* h0 = C.in[2] + ((size_t)(layer * 32 + sb) * 32 + head) * 64 * 128;
    float* hout = C.out + O_SSMS + ((size_t)(layer * 32 + sb) * 32 + head) * 64 * 128;
    const int g = head >> 3, lane = C.lane, tok0 = sb * 8;
    LAS float* Bl = wl;
    LAS float* Cl = wl + 1024;
    LAS float* Xl = wl + 2048;
    LAS float* XWl = wl + 2560;
    LAS float* Gl = wl + 3072;
    LAS float* Sc = wl + 3136;
    const float A = -__expf(C.in[14][layer * 32 + head]), dtb = C.in[13][layer * 32 + head], Dh = C.in[15][layer * 32 + head];
    float dtv[8], ac[8];
    { float run = 0.f;
#pragma unroll
      for (int s = 0; s < 8; ++s) { dtv[s] = softplus_f(DTRAW[(size_t)(TP + tok0 + s) * 32 + head] + dtb); run += dtv[s] * A; ac[s] = run; } }
    const float ac7 = ac[7];
    if (lane == 0) {
#pragma unroll
        for (int s = 0; s < 8; ++s) { Sc[s] = dtv[s]; Sc[8 + s] = ac[s]; }
    }
#pragma unroll
    for (int s = 0; s < 8; ++s) {
        const float* row = XSS + (size_t)(tok0 + s) * CONVD;
        *(LAS f32x2*)(Bl + s * 128 + 2 * lane) = *(const f32x2*)(row + DIN + g * 128 + 2 * lane);
        *(LAS f32x2*)(Cl + s * 128 + 2 * lane) = *(const f32x2*)(row + DIN + 512 + g * 128 + 2 * lane);
        const float xv = row[head * 64 + lane];
        Xl[s * 64 + lane] = xv; XWl[s * 64 + lane] = xv * dtv[s] * __expf(ac7 - ac[s]);
    }
    asm volatile("s_waitcnt lgkmcnt(0)" ::: "memory");
#pragma unroll 1
    for (int l = 0; l < 8; ++l) {
        const f32x2 cv = *(LAS f32x2*)(Cl + l * 128 + 2 * lane); const float acl = Sc[8 + l];
#pragma unroll 1
        for (int s = 0; s <= l; ++s) {
            const f32x2 bv = *(LAS f32x2*)(Bl + s * 128 + 2 * lane);
            float d = wave_sum(cv[0] * bv[0] + cv[1] * bv[1]);
            d = d * __expf(acl - Sc[8 + s]) * Sc[s] + ((s == l) ? Dh : 0.f);
            if (lane == 0) Gl[l * 8 + s] = d;
        }
    }
    asm volatile("s_waitcnt lgkmcnt(0)" ::: "memory");
    const int pi = lane >> 3, nj = lane & 7;
    const float cd = __expf(ac7);
    const float eal = __expf(Sc[8 + nj]);
#pragma unroll 1
    for (int pb = 0; pb < 8; ++pb) {
        const int p = pb * 8 + pi;
        float xw[8], yo[8];
#pragma unroll
        for (int s = 0; s < 8; ++s) { xw[s] = XWl[s * 64 + p]; yo[s] = 0.f; }
        f32x4 hv[4];
#pragma unroll
        for (int nb = 0; nb < 4; ++nb) hv[nb] = *(const f32x4*)(h0 + (size_t)p * 128 + nb * 32 + nj * 4);
#pragma unroll
        for (int nb = 0; nb < 4; ++nb) {
            const int n = nb * 32 + nj * 4;
            const f32x4 h4 = hv[nb];
            f32x4 hn = h4 * cd;
#pragma unroll
            for (int s = 0; s < 8; ++s) { const f32x4 b4 = *(LAS f32x4*)(Bl + s * 128 + n), c4 = *(LAS f32x4*)(Cl + s * 128 + n);
                hn += b4 * xw[s];
                yo[s] += (c4[0] * h4[0] + c4[1] * h4[1]) + (c4[2] * h4[2] + c4[3] * h4[3]); }
            *(f32x4*)(hout + (size_t)p * 128 + n) = hn;
            __builtin_amdgcn_sched_barrier(0);
        }
        float mine = 0.f;
#pragma unroll
        for (int l = 0; l < 8; ++l) { float v = yo[l]; v += __shfl_xor(v, 1); v += __shfl_xor(v, 2); v += __shfl_xor(v, 4); if (nj == l) mine = v; }
        const int l = nj;
        float y = mine * eal;
#pragma unroll 1
        for (int s = 0; s <= l; ++s) y += Gl[l * 8 + s] * Xl[s * 64 + p];
        const float z = bf1(ZB[(size_t)(TP + tok0 + l) * DIN + head * 64 + p]);
        YSRAW[(size_t)(tok0 + l) * DIN + head * 64 + p] = y * silu_f(z);
    }
    asm volatile("s_waitcnt lgkmcnt(0)" ::: "memory");
}

__device__ __forceinline__ void s2_scan(const Ctx& C, int layer, int rep) {
    unsigned char* ws = C.ws;
    bf16* ST = (bf16*)(ws + WS_STATES); const float* ACU = (const float*)(ws + WS_ACU);
    bf16* STw = rep ? (bf16*)(ws + WS_XBC) : ST; float* fin = rep ? (float*)(ws + WS_XBC + 70 * MiB) : C.out + O_SSMP;
    for (int e = blockIdx.x * 512 + C.tid; e < 2 * 32 * 64 * 32; e += C.G * 512) {
        const int n4 = e & 31, p = (e >> 5) & 63, head = (e >> 11) & 31, b = e >> 16;
        f32x4 h = (f32x4){0.f, 0.f, 0.f, 0.f};
#pragma unroll 1
        for (int c0 = 0; c0 < 64; c0 += 8) {
            u32x2 raw[8]; float cdv[8];
#pragma unroll
            for (int k = 0; k < 8; ++k) { const int cidx = b * 64 + c0 + k;
                raw[k] = *(const u32x2*)(ST + ((size_t)(cidx * 32 + head) * 64 + p) * 128 + n4 * 4);
                cdv[k] = ACU[(size_t)(cidx * 32 + head) * 128 + 127]; }
#pragma unroll
            for (int k = 0; k < 8; ++k) { const int cidx = b * 64 + c0 + k;
                u32x2 w; w.x = pk2(h[0], h[1]); w.y = pk2(h[2], h[3]);
                *(u32x2*)(STw + ((size_t)(cidx * 32 + head) * 64 + p) * 128 + n4 * 4) = w;
                const f32x4 s = (f32x4){bflo(raw[k].x), bfhi(raw[k].x), bflo(raw[k].y), bfhi(raw[k].y)};
                h = h * __expf(cdv[k]) + s; }
        }
        *(f32x4*)(fin + (((size_t)(layer * 2 + b) * 32 + head) * 64 + p) * 128 + n4 * 4) = h;
    }
}
__device__ __forceinline__ void sample_norm(const Ctx& C) {
    unsigned char* ws = C.ws; const float* YSRAW = (const float*)(ws + WS_YSRAW); bf16* YB = (bf16*)(ws + WS_YB);
    for (int task = C.gw; task < 256 * 4; task += C.ngw) {
        const int row = task >> 2, g = task & 3;
        const float* src = YSRAW + (size_t)row * DIN + g * 512 + C.lane * 8;
        const f32x4 a = *(const f32x4*)src, b = *(const f32x4*)(src + 4);
        float ss = (a[0] * a[0] + a[1] * a[1]) + (a[2] * a[2] + a[3] * a[3]) + (b[0] * b[0] + b[1] * b[1]) + (b[2] * b[2] + b[3] * b[3]);
        ss = wave_sum(ss);
        const float rs = rsqrtf(ss * (1.f / 512.f) + EPS);
        u32x4 w; w.x = pk2(a[0] * rs, a[1] * rs); w.y = pk2(a[2] * rs, a[3] * rs); w.z = pk2(b[0] * rs, b[1] * rs); w.w = pk2(b[2] * rs, b[3] * rs);
        *(u32x4*)(YB + (size_t)(TP + row) * DIN + g * 512 + C.lane * 8) = w;
    }
}

constexpr int S3_LD = 136;
constexpr int S3_CS = 0, S3_CB = 128 * S3_LD * 2, S3_BS = 2 * 128 * S3_LD * 2;
constexpr int S3_YLD = 520;
__device__ __forceinline__ void s3_unit(const Ctx& C, int layer, int cidx, int g) {
    unsigned char* ws = C.ws;
    const bf16* CROW = (const bf16*)(ws + WS_CROW) + (size_t)(cidx * 4 + g) * 128 * 128;
    const bf16* BROW = (const bf16*)(ws + WS_BROW) + (size_t)(cidx * 4 + g) * 128 * 128;
    LAS bf16* Cs = (LAS bf16*)(C.lds + S3_CS); LAS bf16* Bs = (LAS bf16*)(C.lds + S3_BS); LAS bf16* CBs = (LAS bf16*)(C.lds + S3_CB);
    LAS bf16* Ys = (LAS bf16*)(C.lds + S3_BS);
    const int tid = C.tid, lane = C.lane, w = C.wave, fr = lane & 15, fq = lane >> 4;
#pragma unroll
    for (int i = 0; i < 4; ++i) { const int idx = tid + 512 * i, row = idx >> 4, chk = idx & 15;
        *(LAS u32x4*)(Cs + row * S3_LD + chk * 8) = *(const u32x4*)(CROW + row * 128 + chk * 8);
        *(LAS u32x4*)(Bs + row * S3_LD + chk * 8) = *(const u32x4*)(BROW + row * 128 + chk * 8); }
    __syncthreads();
    {
        f32x4 cb[8];
#pragma unroll
        for (int st = 0; st < 8; ++st) cb[st] = (f32x4){0.f, 0.f, 0.f, 0.f};
#pragma unroll
        for (int ks = 0; ks < 4; ++ks) {
            const bf16x8 cf = *(LAS bf16x8*)(Cs + (w * 16 + fr) * S3_LD + ks * 32 + 8 * fq);
#pragma unroll
            for (int st = 0; st < 8; ++st) if (st <= w) { const bf16x8 bf = *(LAS bf16x8*)(Bs + (st * 16 + fr) * S3_LD + ks * 32 + 8 * fq); cb[st] = MFMA16(bf, cf, cb[st]); }
        }
#pragma unroll
        for (int st = 0; st < 8; ++st) { u32x2 v; v.x = pk2(cb[st][0], cb[st][1]); v.y = pk2(cb[st][2], cb[st][3]);
            *(LAS u32x2*)(CBs + (w * 16 + fr) * S3_LD + st * 16 + 4 * fq) = v; }
    }
    __syncthreads();
    const int head = g * 8 + w;
    const bf16* xt = (const bf16*)(ws + WS_XT) + (size_t)(cidx * 32 + head) * 64 * 128;
    const bf16* hin = (const bf16*)(ws + WS_STATES) + (size_t)(cidx * 32 + head) * 64 * 128;
    const float* dtc = (const float*)(ws + WS_DTC) + (size_t)(cidx * 32 + head) * 128;
    const float* acu = (const float*)(ws + WS_ACU) + (size_t)(cidx * 32 + head) * 128;
    const float Dh = C.in[15][layer * 32 + head];
#pragma unroll 1
    for (int half = 0; half < 2; ++half) {
        f32x4 acc[4][4];
#pragma unroll
        for (int a = 0; a < 4; ++a)
#pragma unroll
            for (int b = 0; b < 4; ++b) acc[a][b] = (f32x4){0.f, 0.f, 0.f, 0.f};
#pragma unroll 1
        for (int ks = 0; ks < 4; ++ks) {
            bf16x8 hf[4];
#pragma unroll
            for (int pt = 0; pt < 4; ++pt) hf[pt] = *(const bf16x8*)(hin + (size_t)(pt * 16 + fr) * 128 + ks * 32 + 8 * fq);
#pragma unroll
            for (int lt = 0; lt < 4; ++lt) { const bf16x8 cf = *(LAS bf16x8*)(Cs + ((4 * half + lt) * 16 + fr) * S3_LD + ks * 32 + 8 * fq);
#pragma unroll
                for (int pt = 0; pt < 4; ++pt) acc[lt][pt] = MFMA16(hf[pt], cf, acc[lt][pt]); }
        }
        float al[4];
#pragma unroll
        for (int lt = 0; lt < 4; ++lt) { al[lt] = acu[(4 * half + lt) * 16 + fr]; const float e = __expf(al[lt]);
#pragma unroll
            for (int pt = 0; pt < 4; ++pt) acc[lt][pt] *= e; }
#pragma unroll 1
        for (int ks = 0; ks < 2 * half + 2; ++ks) {
            const int s0 = ks * 32 + 8 * fq;
            bf16x8 xf[4];
#pragma unroll
            for (int pt = 0; pt < 4; ++pt) xf[pt] = *(const bf16x8*)(xt + (size_t)(pt * 16 + fr) * 128 + s0);
            float ds[8], as[8];
            { const f32x4 d0 = *(const f32x4*)(dtc + s0), d1 = *(const f32x4*)(dtc + s0 + 4), a0 = *(const f32x4*)(acu + s0), a1 = *(const f32x4*)(acu + s0 + 4);
#pragma unroll
              for (int j = 0; j < 4; ++j) { ds[j] = d0[j]; ds[4 + j] = d1[j]; as[j] = a0[j]; as[4 + j] = a1[j]; } }
#pragma unroll
            for (int lt = 0; lt < 4; ++lt) if (4 * half + lt >= 2 * ks) {
                const int l = (4 * half + lt) * 16 + fr;
                const u32x4 raw = *(LAS u32x4*)(CBs + l * S3_LD + s0);
                float gv[8]; unpack8(raw, gv);
#pragma unroll
                for (int j = 0; j < 8; ++j) { const int s = s0 + j; float v = gv[j] * __expf(al[lt] - as[j]) * ds[j]; v = (s <= l) ? v : 0.f; gv[j] = (s == l) ? v + Dh : v; }
                const bf16x8 gf = __builtin_bit_cast(bf16x8, pack8(gv));
#pragma unroll
                for (int pt = 0; pt < 4; ++pt) acc[lt][pt] = MFMA16(xf[pt], gf, acc[lt][pt]);
            }
        }
#pragma unroll
        for (int lt = 0; lt < 4; ++lt)
#pragma unroll
            for (int pt = 0; pt < 4; ++pt) { u32x2 v; v.x = pk2(acc[lt][pt][0], acc[lt][pt][1]); v.y = pk2(acc[lt][pt][2], acc[lt][pt][3]);
                *(LAS u32x2*)(Ys + (lt * 16 + fr) * S3_YLD + w * 64 + pt * 16 + 4 * fq) = v; }
        __syncthreads();
        {
            const int lr = tid >> 3, oc = tid & 7; const size_t tok = (size_t)cidx * 128 + half * 64 + lr;
            const bf16* zrow = (const bf16*)(ws + WS_ZB) + tok * DIN + g * 512 + oc * 64;
            bf16* yrow = (bf16*)(ws + WS_YB) + tok * DIN + g * 512 + oc * 64;
            float v[8][8]; float ss = 0.f;
#pragma unroll
            for (int c = 0; c < 8; ++c) { const u32x4 yr = *(LAS u32x4*)(Ys + lr * S3_YLD + oc * 64 + c * 8); const u32x4 zr = *(const u32x4*)(zrow + c * 8);
                float zf[8]; unpack8(yr, v[c]); unpack8(zr, zf);
#pragma unroll
                for (int j = 0; j < 8; ++j) { v[c][j] *= silu_f(zf[j]); ss += v[c][j] * v[c][j]; } }
            ss += __shfl_xor(ss, 1); ss += __shfl_xor(ss, 2); ss += __shfl_xor(ss, 4);
            const float rs = rsqrtf(ss * (1.f / 512.f) + EPS);
#pragma unroll
            for (int c = 0; c < 8; ++c) {
#pragma unroll
                for (int j = 0; j < 8; ++j) v[c][j] *= rs;
                *(u32x4*)(yrow + c * 8) = pack8(v[c]); }
        }
        __syncthreads();
    }
}

template <int MODE>
__device__ __forceinline__ void side_gemm(const Ctx& C, const bf16* __restrict__ A, const bf16* __restrict__ Wt, int K,
                                          float* H, float* Hout, bf16* HB, float* ssq_out, const float* ssq_in, const bf16* PP, bf16* OUT) {
    const int lane = C.lane, w = C.wave, fr = lane & 15, fq = lane >> 4, tid = C.tid;
    LAS float* red = (LAS float*)C.lds;
    const int kper = K >> 3;
    for (int tile = C.vcu; tile < 256; tile += C.G) {
        const int rg = tile >> 4, cg = tile & 15;
        const bf16* ap = A + (size_t)(TP + rg * 16 + fr) * K + w * kper + 8 * fq;
        const bf16* wp = Wt + (size_t)(cg * 64 + fr) * K + w * kper + 8 * fq;
        f32x4 acc[4];
#pragma unroll
        for (int ct = 0; ct < 4; ++ct) acc[ct] = (f32x4){0.f, 0.f, 0.f, 0.f};
#pragma unroll 1
        for (int k0 = 0; k0 < kper; k0 += 128) {
            bf16x8 af[4], wf[4][4];
#pragma unroll
            for (int s = 0; s < 4; ++s) if (k0 + 32 * s < kper) {
                af[s] = *(const bf16x8*)(ap + k0 + 32 * s);
#pragma unroll
                for (int ct = 0; ct < 4; ++ct) wf[s][ct] = *(const bf16x8*)(wp + (size_t)ct * 16 * K + k0 + 32 * s);
            }
#pragma unroll
            for (int s = 0; s < 4; ++s) if (k0 + 32 * s < kper) {
#pragma unroll
                for (int ct = 0; ct < 4; ++ct) acc[ct] = MFMA16(wf[s][ct], af[s], acc[ct]);
            }
        }
#pragma unroll
        for (int ct = 0; ct < 4; ++ct) *(LAS f32x4*)(red + (w * 16 + fr) * 64 + ct * 16 + 4 * fq) = acc[ct];
        __syncthreads();
        if (tid < 256) {
            const int m = tid >> 4, c4 = (tid & 15) * 4;
            f32x4 v = (f32x4){0.f, 0.f, 0.f, 0.f};
#pragma unroll
            for (int ww = 0; ww < 8; ++ww) v += *(LAS f32x4*)(red + (ww * 16 + m) * 64 + c4);
            const int row = TP + rg * 16 + m; const size_t off = (size_t)row * DM + cg * 64 + c4;
            if (MODE == 2) {
                u32x2 o; o.x = pk2(v[0], v[1]); o.y = pk2(v[2], v[3]); *(u32x2*)(OUT + off) = o;
            } else {
                if (MODE == 1) {
                    const float rs = rsqrtf(ssq_in[row] * (1.f / 1024.f) + EPS);
                    const u32x2 pr = *(const u32x2*)(PP + off);
                    v[0] = sigmoid_f(v[0] * rs) * bflo(pr.x); v[1] = sigmoid_f(v[1] * rs) * bfhi(pr.x); v[2] = sigmoid_f(v[2] * rs) * bflo(pr.y); v[3] = sigmoid_f(v[3] * rs) * bfhi(pr.y);
                }
                const f32x4 h = *(const f32x4*)(H + off) + v;
                *(f32x4*)(Hout + off) = h;
                u32x2 o; o.x = pk2(h[0], h[1]); o.y = pk2(h[2], h[3]); *(u32x2*)(HB + off) = o;
                float ss = (h[0] * h[0] + h[1] * h[1]) + (h[2] * h[2] + h[3] * h[3]);
                ss += __shfl_xor(ss, 1); ss += __shfl_xor(ss, 2); ss += __shfl_xor(ss, 4); ss += __shfl_xor(ss, 8);
                if ((tid & 15) == 0 && ssq_out != nullptr) atomicAdd(ssq_out + row, ss);
            }
        }
        __syncthreads();
    }
}

__device__ __forceinline__ void p9_kvpass(const Ctx& C) {
    unsigned char* ws = C.ws;
    const bf16* KVRAW = (const bf16*)(ws + WS_KVRAW); bf16* KN = (bf16*)(ws + WS_KN); bf16* VT = (bf16*)(ws + WS_VT);
    float* KSS = (float*)(ws + WS_KSS); float* VSS = (float*)(ws + WS_VSS);
    const float* ropec = (const float*)(ws + WS_ROPEC); const float* ropes = (const float*)(ws + WS_ROPES);
    const float* knw = C.in[20];
    const int lane = C.lane, q4 = lane & 3;
    float wk[16];
#pragma unroll
    for (int j = 0; j < 8; ++j) { wk[j] = knw[8 * q4 + j]; wk[8 + j] = knw[32 + 8 * q4 + j]; }
    for (int pass = C.gw; pass < TT * 12 / 16; pass += C.ngw) {
        const int hr = pass * 16 + (lane >> 2), row = hr / 12, gk = hr % 12, gi = gk >> 2, kh = gk & 3;
        const bf16* src = KVRAW + (size_t)row * 1536 + gk * 64 + 8 * q4;
        float k[16], v[16];
        unpack8(*(const u32x4*)src, k); unpack8(*(const u32x4*)(src + 32), k + 8);
        unpack8(*(const u32x4*)(src + 768), v); unpack8(*(const u32x4*)(src + 768 + 32), v + 8);
        float ss = 0.f;
#pragma unroll
        for (int j = 0; j < 16; ++j) ss += k[j] * k[j];
        ss += __shfl_xor(ss, 1); ss += __shfl_xor(ss, 2);
        const float rs = rsqrtf(ss * (1.f / 64.f) + EPS);
        const int pos = (row < TP) ? (row & 8191) : 8192 + ((row - TP) & 7);
        float ko[16];
#pragma unroll
        for (int j = 0; j < 8; ++j) { const float x1 = k[j] * rs * wk[j], x2 = k[8 + j] * rs * wk[8 + j];
            const float c = ropec[pos * 32 + 8 * q4 + j], s = ropes[pos * 32 + 8 * q4 + j];
            ko[j] = x1 * c - x2 * s; ko[8 + j] = x2 * c + x1 * s; }
        bf16* kd = KN + (size_t)row * 768 + gk * 64 + 8 * q4;
        *(u32x4*)kd = pack8(ko); *(u32x4*)(kd + 32) = pack8(ko + 8);
        float* ok = nullptr; float* ov = nullptr;
        if (row < TP) {
            const int b = row >> 13, W = (gi == 0) ? 128 : (gi == 1) ? 512 : 2048;
            const size_t obase = (gi == 0) ? O_KVP1 : (gi == 1) ? O_KVP2 : O_KVP3;
            if (pos >= 8192 - W) { const int jw = pos - (8192 - W); ok = C.out + obase + ((size_t)(b * W + jw) * 2) * 256 + kh * 64 + 8 * q4; ov = ok + 256; }
        } else {
            const int rs_ = row - TP;
            const size_t obase = (gi == 0) ? O_KVS1 : (gi == 1) ? O_KVS2 : O_KVS3;
            ok = C.out + obase + ((size_t)rs_ * 2) * 256 + kh * 64 + 8 * q4; ov = ok + 256;
            float* k2 = KSS + (size_t)rs_ * 768 + gk * 64 + 8 * q4; float* v2 = VSS + (size_t)rs_ * 768 + gk * 64 + 8 * q4;
#pragma unroll
            for (int h2 = 0; h2 < 2; ++h2) {
                *(f32x4*)(k2 + 32 * h2) = (f32x4){ko[8 * h2], ko[8 * h2 + 1], ko[8 * h2 + 2], ko[8 * h2 + 3]}; *(f32x4*)(k2 + 32 * h2 + 4) = (f32x4){ko[8 * h2 + 4], ko[8 * h2 + 5], ko[8 * h2 + 6], ko[8 * h2 + 7]};
                *(f32x4*)(v2 + 32 * h2) = (f32x4){v[8 * h2], v[8 * h2 + 1], v[8 * h2 + 2], v[8 * h2 + 3]}; *(f32x4*)(v2 + 32 * h2 + 4) = (f32x4){v[8 * h2 + 4], v[8 * h2 + 5], v[8 * h2 + 6], v[8 * h2 + 7]}; }
        }
        if (ok != nullptr) {
#pragma unroll
            for (int h2 = 0; h2 < 2; ++h2) {
                *(f32x4*)(ok + 32 * h2) = (f32x4){ko[8 * h2], ko[8 * h2 + 1], ko[8 * h2 + 2], ko[8 * h2 + 3]}; *(f32x4*)(ok + 32 * h2 + 4) = (f32x4){ko[8 * h2 + 4], ko[8 * h2 + 5], ko[8 * h2 + 6], ko[8 * h2 + 7]};
                *(f32x4*)(ov + 32 * h2) = (f32x4){v[8 * h2], v[8 * h2 + 1], v[8 * h2 + 2], v[8 * h2 + 3]}; *(f32x4*)(ov + 32 * h2 + 4) = (f32x4){v[8 * h2 + 4], v[8 * h2 + 5], v[8 * h2 + 6], v[8 * h2 + 7]}; }
        }
    }
    {
        const int gt = C.gw * 64 + lane, ngt = C.ngw * 64;
        for (int e = gt; e < 2 * 12 * 8 * 1024; e += ngt) {
            const int ddc = e & 7, run = (e >> 3) & 1023, bg = e >> 13, gk = bg % 12, b = bg / 12, gi = gk >> 2;
            const int dsh = 2 * gi, d = 1 << dsh, Ld = 8192 >> dsh;
            const int pi0 = run * 8, r = pi0 / Ld, m0 = pi0 % Ld;
            float vv[8][8];
#pragma unroll
            for (int j = 0; j < 8; ++j) { const int tok = r + d * (m0 + j); unpack8(*(const u32x4*)(KVRAW + (size_t)(b * 8192 + tok) * 1536 + 768 + gk * 64 + ddc * 8), vv[j]); }
#pragma unroll
            for (int i = 0; i < 8; ++i) { float t[8];
#pragma unroll
                for (int j = 0; j < 8; ++j) t[j] = vv[j][i];
                *(u32x4*)(VT + ((size_t)(b * 12 + gk) * 64 + ddc * 8 + i) * 8192 + pi0) = pack8(t); }
        }
    }
}

struct AttnCtx { const bf16* Q; const bf16* KN; const bf16* VT; const float* ropec; const float* ropes; const float* qnw; int b, kh, t0, w, fr, fq; float cshift; };

template <int QT0, int QTS, int NQ>
__device__ __forceinline__ void attn_group(const AttnCtx& A, f32x4 (&O)[4][4], float (&lsum)[4], int gi, int dsh, int rres, int kb, int nkk, const int (&mqv)[NQ]) {
    int fr_l = A.fr, fq_l = A.fq; asm volatile("" : "+v"(fr_l), "+v"(fq_l) :: "memory");
    const int fr = fr_l, fq = fq_l, d = 1 << dsh, Ld = 8192 >> dsh;
    const float* ropec = A.ropec; const float* ropes = A.ropes; const float* qnw = A.qnw;
    asm volatile("" : "+s"(ropec), "+s"(ropes), "+s"(qnw));
    bf16x8 qf[NQ][2];
#pragma unroll
    for (int k = 0; k < NQ; ++k) {
        const int qt = QT0 + QTS * k, rep = 2 * (qt >> 1) + (fr >> 3), i = 2 * (fr & 7) + (qt & 1), t = A.t0 + A.w + 8 * i, head = A.kh * 4 + rep;
        const bf16* src = A.Q + (size_t)(A.b * 8192 + t) * 3072 + gi * 1024 + head * 64 + 8 * fq;
        float x[16]; unpack8(*(const u32x4*)src, x); unpack8(*(const u32x4*)(src + 32), x + 8);
        float ss = 0.f;
#pragma unroll
        for (int j = 0; j < 16; ++j) ss += x[j] * x[j];
        ss += __shfl_xor(ss, 16); ss += __shfl_xor(ss, 32);
        const float rs = rsqrtf(ss * (1.f / 64.f) + EPS) ;
        float o1[8], o2[8];
#pragma unroll
        for (int j = 0; j < 8; ++j) { const float x1 = x[j] * rs * qnw[8 * fq + j], x2 = x[8 + j] * rs * qnw[32 + 8 * fq + j];
            const float c = ropec[t * 32 + 8 * fq + j], s = ropes[t * 32 + 8 * fq + j];
            o1[j] = (x1 * c - x2 * s) * 0.125f; o2[j] = (x2 * c + x1 * s) * 0.125f; }
        qf[k][0] = __builtin_bit_cast(bf16x8, pack8(o1)); qf[k][1] = __builtin_bit_cast(bf16x8, pack8(o2));
        __builtin_amdgcn_sched_barrier(0);
    }
    const bf16* kbase = A.KN + (size_t)A.b * 8192 * 768 + gi * 256 + A.kh * 64 + 8 * fq;
    const bf16* vbase = A.VT + ((size_t)(A.b * 12 + gi * 4 + A.kh) * 64 + fr) * 8192 + rres * Ld;
#pragma unroll 1
    for (int kk = 0; kk < nkk; ++kk) {
        bf16x8 kf[2][2];
#pragma unroll
        for (int h2 = 0; h2 < 2; ++h2) { int m = kb + kk * 32 + h2 * 16 + fr; m = m < 0 ? 0 : m; const bf16* p = kbase + (size_t)(rres + d * m) * 768;
            kf[h2][0] = *(const bf16x8*)p; kf[h2][1] = *(const bf16x8*)(p + 32); }
        bf16x8 vf[4];
        { int ma = kb + kk * 32 + 4 * fq, mb = ma + 16; ma = ma < 0 ? 0 : ma; mb = mb < 0 ? 0 : mb;
#pragma unroll
          for (int dt = 0; dt < 4; ++dt) { const bf16* vp = vbase + (size_t)dt * 16 * 8192; const u32x2 lo = *(const u32x2*)(vp + ma), hi = *(const u32x2*)(vp + mb);
              vf[dt] = __builtin_bit_cast(bf16x8, (u32x4){lo.x, lo.y, hi.x, hi.y}); } }
#pragma unroll
        for (int k = 0; k < NQ; ++k) {
            const int qt = QT0 + QTS * k;
            f32x4 s0 = (f32x4){0.f, 0.f, 0.f, 0.f}, s1 = s0;
            s0 = MFMA16(kf[0][0], qf[k][0], s0); s0 = MFMA16(kf[0][1], qf[k][1], s0);
            s1 = MFMA16(kf[1][0], qf[k][0], s1); s1 = MFMA16(kf[1][1], qf[k][1], s1);
            const int mk0 = kb + kk * 32 + 4 * fq, mq = mqv[k];
            float p0[4], p1[4]; float ps = 0.f;
#pragma unroll
            for (int r = 0; r < 4; ++r) {
                const int ka = mk0 + r, kc = mk0 + 16 + r;
                const bool va = (ka >= 0) && (ka <= mq) && (ka >= mq - 128), vc = (kc >= 0) && (kc <= mq) && (kc >= mq - 128);
                p0[r] = va ? exp2f((s0[r] - A.cshift) * 1.4426950408889634f) : 0.f;
                p1[r] = vc ? exp2f((s1[r] - A.cshift) * 1.4426950408889634f) : 0.f;
                ps += p0[r] + p1[r];
            }
            lsum[qt] += ps;
            const bf16x8 pf = __builtin_bit_cast(bf16x8, (u32x4){pk2(p0[0], p0[1]), pk2(p0[2], p0[3]), pk2(p1[0], p1[1]), pk2(p1[2], p1[3])});
#pragma unroll
            for (int dt = 0; dt < 4; ++dt) O[qt][dt] = MFMA16(vf[dt], pf, O[qt][dt]);
        }
    }
}

__device__ __forceinline__ void attn_prompt_task(const Ctx& C, int j, int task) {
    unsigned char* ws = C.ws;
    AttnCtx A;
    A.Q = (const bf16*)(ws + WS_Q); A.KN = (const bf16*)(ws + WS_KN); A.VT = (const bf16*)(ws + WS_VT);
    A.ropec = (const float*)(ws + WS_ROPEC); A.ropes = (const float*)(ws + WS_ROPES); A.qnw = C.in[22] + j * 64;
    A.w = task & 7; const int blk = (task >> 3) & 63; A.kh = (task >> 9) & 3; A.b = task >> 11; A.t0 = blk * 128;
    A.fr = C.lane & 15; A.fq = C.lane >> 4;
    { const float mq = wave_max(fabsf(A.qnw[C.lane])), mk = wave_max(fabsf(C.in[20][C.lane])); A.cshift = 8.f * mq * mk; }
    f32x4 O[4][4]; float lsum[4];
#pragma unroll
    for (int a = 0; a < 4; ++a) { lsum[a] = 0.f;
#pragma unroll
        for (int b = 0; b < 4; ++b) O[a][b] = (f32x4){0.f, 0.f, 0.f, 0.f}; }
    const int fr = A.fr, w = A.w, t0 = A.t0;
    {
        int mq[2];
#pragma unroll
        for (int qt = 0; qt < 2; ++qt) mq[qt] = t0 + w + 8 * (2 * (fr & 7) + (qt & 1));
        attn_group<0, 1, 2>(A, O, lsum, 0, 0, 0, t0 - 128, 8, mq);
        asm volatile("" ::: "memory"); __builtin_amdgcn_sched_barrier(0);
        attn_group<2, 1, 2>(A, O, lsum, 0, 0, 0, t0 - 128, 8, mq);
    }
    asm volatile("" ::: "memory"); __builtin_amdgcn_sched_barrier(0);
    {
        int mq[2];
#pragma unroll
        for (int qt = 0; qt < 2; ++qt) mq[qt] = t0 / 4 + (w >> 2) + 2 * (2 * (fr & 7) + (qt & 1));
        attn_group<0, 1, 2>(A, O, lsum, 1, 2, w & 3, t0 / 4 - 128, 5, mq);
        asm volatile("" ::: "memory"); __builtin_amdgcn_sched_barrier(0);
        attn_group<2, 1, 2>(A, O, lsum, 1, 2, w & 3, t0 / 4 - 128, 5, mq);
    }
    asm volatile("" ::: "memory"); __builtin_amdgcn_sched_barrier(0);
    {
        int mq[2]; mq[0] = t0 / 16 + (fr & 7); mq[1] = mq[0];
        attn_group<0, 2, 2>(A, O, lsum, 2, 4, w, t0 / 16 - 152, 5, mq);
        asm volatile("" ::: "memory"); __builtin_amdgcn_sched_barrier(0);
        attn_group<1, 2, 2>(A, O, lsum, 2, 4, w + 8, t0 / 16 - 152, 5, mq);
    }
    asm volatile("" ::: "memory"); __builtin_amdgcn_sched_barrier(0);
    const bf16* GATE = (const bf16*)(ws + WS_GATE); bf16* OB = (bf16*)(ws + WS_OB);
    int fr_o = A.fr, fq_o = A.fq; asm volatile("" : "+v"(fr_o), "+v"(fq_o) :: "memory");
#pragma unroll
    for (int qt = 0; qt < 4; ++qt) {
        float l = lsum[qt]; l += __shfl_xor(l, 16); l += __shfl_xor(l, 32);
        const float li = 1.f / l;
        const int rep = 2 * (qt >> 1) + (fr_o >> 3), i = 2 * (fr_o & 7) + (qt & 1), t = t0 + w + 8 * i, head = A.kh * 4 + rep;
        const size_t off = (size_t)(A.b * 8192 + t) * 1024 + head * 64 + 4 * fq_o;
#pragma unroll
        for (int dt = 0; dt < 4; ++dt) {
            const u32x2 gr = *(const u32x2*)(GATE + off + dt * 16);
            const float g0 = bflo(gr.x), g1 = bfhi(gr.x), g2 = bflo(gr.y), g3 = bfhi(gr.y);
            u32x2 o; o.x = pk2(O[qt][dt][0] * li * silu_f(g0), O[qt][dt][1] * li * silu_f(g1)); o.y = pk2(O[qt][dt][2] * li * silu_f(g2), O[qt][dt][3] * li * silu_f(g3));
            *(u32x2*)(OB + off + dt * 16) = o;
        }
    }
}

__device__ __forceinline__ void attn_sample_task(const Ctx& C, int j, int task, LAS float* wl) {
    unsigned char* ws = C.ws;
    const int t = task & 7, kh = (task >> 3) & 3, sb = task >> 5, lane = C.lane;
    const int row = TP + sb * 8 + t, pos = 8192 + t;
    const bf16* Q = (const bf16*)(ws + WS_Q); const bf16* GATE = (const bf16*)(ws + WS_GATE); bf16* OB = (bf16*)(ws + WS_OB);
    const float* KSS = (const float*)(ws + WS_KSS); const float* VSS = (const float*)(ws + WS_VSS);
    const float* ropec = (const float*)(ws + WS_ROPEC); const float* ropes = (const float*)(ws + WS_ROPES);
    const float* qnw = C.in[22] + j * 64;
    LAS float* qs = wl;
    LAS float* sc = wl + 768;
    const float cr = ropec[pos * 32 + (lane & 31)], sr = ropes[pos * 32 + (lane & 31)], wq = qnw[lane];
#pragma unroll
    for (int gi = 0; gi < 3; ++gi)
#pragma unroll
        for (int rep = 0; rep < 4; ++rep) {
            const float q = bf1(Q[(size_t)row * 3072 + gi * 1024 + (kh * 4 + rep) * 64 + lane]);
            const float ss = wave_sum(q * q);
            const float qn = q * rsqrtf(ss * (1.f / 64.f) + EPS) * wq;
            const float pr = __shfl_xor(qn, 32);
            const float o = (lane < 32) ? qn * cr - pr * sr : qn * cr + pr * sr;
            qs[(gi * 4 + rep) * 64 + lane] = o * 0.125f;
        }
    asm volatile("s_waitcnt lgkmcnt(0)" ::: "memory");
    const int kq = lane >> 4, c16 = lane & 15;
#pragma unroll 1
    for (int gi = 0; gi < 3; ++gi) {
        const int W = (gi == 0) ? 128 : (gi == 1) ? 512 : 2048, d = 1 << (2 * gi);
        const float* cache = C.in[4 + gi];
        f32x4 q4[4];
#pragma unroll
        for (int rep = 0; rep < 4; ++rep) q4[rep] = *(LAS f32x4*)(qs + (gi * 4 + rep) * 64 + 4 * c16);
#pragma unroll 1
        for (int it0 = 0; it0 < 33; it0 += 11) {
          f32x4 kv[11];
#pragma unroll
          for (int u = 0; u < 11; ++u) {
            int jj = (it0 + u) * 4 + kq; jj = jj <= 128 ? jj : 128;
            const int idx = W + t - jj * d;
            const float* src = (idx >= W) ? KSS + (size_t)(sb * 8 + idx - W) * 768 + gi * 256 + kh * 64 : cache + ((size_t)(sb * W + idx) * 2) * 256 + kh * 64;
            kv[u] = *(const f32x4*)(src + 4 * c16);
          }
#pragma unroll
          for (int u = 0; u < 11; ++u) {
            int jj = (it0 + u) * 4 + kq; const bool ok = jj <= 128; jj = ok ? jj : 128;
            const f32x4 k4 = kv[u];
            float mine = 0.f;
#pragma unroll
            for (int rep = 0; rep < 4; ++rep) {
                float s = (k4[0] * q4[rep][0] + k4[1] * q4[rep][1]) + (k4[2] * q4[rep][2] + k4[3] * q4[rep][3]);
                s += __shfl_xor(s, 1); s += __shfl_xor(s, 2); s += __shfl_xor(s, 4); s += __shfl_xor(s, 8);
                if (c16 == rep) mine = s;
            }
            if (c16 < 4 && ok) sc[(gi * 4 + c16) * 132 + jj] = mine;
          }
        }
    }
    asm volatile("s_waitcnt lgkmcnt(0)" ::: "memory");
    float linv[4];
#pragma unroll
    for (int rep = 0; rep < 4; ++rep) {
        float m = -3.0e38f;
#pragma unroll
        for (int gi = 0; gi < 3; ++gi)
            for (int jj = lane; jj <= 128; jj += 64) m = fmaxf(m, sc[(gi * 4 + rep) * 132 + jj]);
        m = wave_max(m);
        float sum = 0.f;
#pragma unroll
        for (int gi = 0; gi < 3; ++gi)
            for (int jj = lane; jj <= 128; jj += 64) { const float p = __expf(sc[(gi * 4 + rep) * 132 + jj] - m); sc[(gi * 4 + rep) * 132 + jj] = p; sum += p; }
        sum = wave_sum(sum);
        linv[rep] = 1.f / sum;
    }
    asm volatile("s_waitcnt lgkmcnt(0)" ::: "memory");
    f32x4 o[4];
#pragma unroll
    for (int rep = 0; rep < 4; ++rep) o[rep] = (f32x4){0.f, 0.f, 0.f, 0.f};
#pragma unroll 1
    for (int gi = 0; gi < 3; ++gi) {
        const int W = (gi == 0) ? 128 : (gi == 1) ? 512 : 2048, d = 1 << (2 * gi);
        const float* cache = C.in[4 + gi];
#pragma unroll 1
        for (int it0 = 0; it0 < 33; it0 += 11) {
          f32x4 vv[11];
#pragma unroll
          for (int u = 0; u < 11; ++u) {
            int jj = (it0 + u) * 4 + kq; jj = jj <= 128 ? jj : 128;
            const int idx = W + t - jj * d;
            const float* src = (idx >= W) ? VSS + (size_t)(sb * 8 + idx - W) * 768 + gi * 256 + kh * 64 : cache + ((size_t)(sb * W + idx) * 2 + 1) * 256 + kh * 64;
            vv[u] = *(const f32x4*)(src + 4 * c16);
          }
#pragma unroll
          for (int u = 0; u < 11; ++u) {
            int jj = (it0 + u) * 4 + kq; const bool ok = jj <= 128; jj = ok ? jj : 128;
            const f32x4 v4 = vv[u];
#pragma unroll
            for (int rep = 0; rep < 4; ++rep) { const float p = ok ? sc[(gi * 4 + rep) * 132 + jj] : 0.f; o[rep] += v4 * p; }
          }
        }
    }
#pragma unroll
    for (int rep = 0; rep < 4; ++rep)
#pragma unroll
        for (int e = 0; e < 4; ++e) { float v = o[rep][e]; v += __shfl_xor(v, 16); v += __shfl_xor(v, 32); o[rep][e] = v; }
    {
        f32x4 mine = o[0]; float li = linv[0];
#pragma unroll
        for (int rep = 1; rep < 4; ++rep) if (kq == rep) { mine = o[rep]; li = linv[rep]; }
        const size_t off = (size_t)row * 1024 + (kh * 4 + kq) * 64 + 4 * c16;
        const u32x2 gr = *(const u32x2*)(GATE + off);
        u32x2 w; w.x = pk2(mine[0] * li * silu_f(bflo(gr.x)), mine[1] * li * silu_f(bfhi(gr.x))); w.y = pk2(mine[2] * li * silu_f(bflo(gr.y)), mine[3] * li * silu_f(bfhi(gr.y)));
        *(u32x2*)(OB + off) = w;
    }
    asm volatile("s_waitcnt lgkmcnt(0)" ::: "memory");
}

constexpr int N_PHASES = 33;
#ifndef PH_MASK
#define PH_MASK 0xFFFFFFu
#endif
#define PHK(k) (((PH_MASK) >> (k)) & 1u)
#ifndef DUP_MASK
#define DUP_MASK 0ull
#endif
#ifndef MK_LAUNCH_PER_PHASE
#define MK_LAUNCH_PER_PHASE 0
#endif

__device__ __forceinline__ Ctx make_ctx(const Args& args, LAS unsigned char* lds) {
    Ctx C; int t = threadIdx.x; asm volatile("" : "+v"(t));
    int bx = blockIdx.x, G = gridDim.x; asm volatile("" : "+s"(bx), "+s"(G));
    C.lds = lds; C.tid = t; C.lane = t & 63; C.wave = __builtin_amdgcn_readfirstlane(t >> 6);
    C.G = G; C.vcu = (G % 8 == 0) ? (bx % 8) * (G / 8) + bx / 8 : bx;
    C.gw = C.vcu * 8 + C.wave; C.ngw = G * 8;
    C.in = args.in; C.out = args.out; C.ws = args.ws;
    return C;
}
template <class Epi> __device__ __forceinline__ void run_gemm(const Ctx& C, const bf16* A, const bf16* Bt, int N, int K, const Epi& E, int M = TT) {
    asm volatile("" : "+s"(K), "+s"(N), "+s"(M));
    pg8::Gemm g{A, Bt, M, N, K}; pg8::StaticOrder S; S.init(M, N, C.G, (int)blockIdx.x);
    pg8::gemm_phase<Epi, pg8::StaticOrder, true, true>(C.lds, g, S, E);
}

__global__ void __launch_bounds__(512, 2) mk_fwd(Args args) {
    extern __shared__ __attribute__((aligned(16))) unsigned char lds_raw[];
    LAS unsigned char* const ldsb = (LAS unsigned char*)lds_raw;
    for (int u = threadIdx.x; u < (LDS_BYTES - RING_BYTES) / 4; u += 512) ((LAS unsigned*)(ldsb + RING_BYTES))[u] = 0u;
    __syncthreads();
    const int lo = args.ph_lo, hi = args.ph_hi;
    if (hi - lo > 1) (void)xcd_barrier_post((unsigned*)(args.ws + WS_CTL) + CW_BAR, (volatile LAS unsigned*)(ldsb + MISC_OFF) + 8);
    for (int ph = lo; ph < hi; ++ph) {
        bool need_bar = true;
        const int nrep = 1 + (int)((args.dup >> ph) & 1ull);
#pragma unroll 1
        for (int rep = 0; rep < nrep; ++rep) {
        const Ctx C = make_ctx(args, ldsb);
        unsigned char* ws = C.ws;
        float* H = C.out; float* SSQ = (float*)(ws + WS_SSQ);
        bf16* HB0 = (bf16*)(ws + WS_HB); bf16* HB1 = (bf16*)(ws + WS_OB);
        bf16* PBUF[2] = {(bf16*)(ws + WS_PBUFA), (bf16*)(ws + WS_PBUFB)};
        bf16* PP = (bf16*)(ws + WS_PP);
        float* Hw = rep ? (float*)(ws + WS_ZB) : H; bf16* HB0w = rep ? (bf16*)(ws + WS_XT) : HB0; bf16* HB1w = rep ? (bf16*)(ws + WS_XT) : HB1; float* SSQd = SSQ + (size_t)8 * TT;
        if (ph == 0) { if (PHK(0)) {
            const Ctx& Cp = C; p0_prologue(Cp);
            convert_p(Cp, 0, PBUF[0]);  }
        } else if (ph < 19) {
            const int i = (ph - 1) / 9, sub = (ph - 1) % 9;
            if (sub == 0) { if (PHK(1)) {
                EpiSplit<2048, 5120, 5120, 2048, 3072, 3072, true> E{SSQ + (size_t)(2 * i) * TT, (bf16*)(ws + WS_ZB), (bf16*)(ws + WS_XBC), nullptr, (float*)(ws + WS_DTRAW)};
                run_gemm(C, HB1, (const bf16*)(ws + (i ? WS_WIN1 : WS_WIN0)), MINP, 1024, E);  }
            } else if (sub == 1) { if (PHK(2)) {
                const Ctx& Cp = C; p2_conv(Cp, i);
                convert_p(Cp, i + 1, PBUF[(i + 1) & 1]);  }
            } else if (sub == 2) { need_bar = false; if (PHK(3)) {
                const Ctx& Cp = C; LAS float* wl = (LAS float*)(Cp.lds + Cp.wave * 16384);
                for (int task = Cp.gw; task < 1024; task += Cp.ngw) ssd_sample_task(Cp, i, task >> 5, task & 31, wl);  }
            } else if (sub == 3) { if (PHK(14)) {
                const Ctx& Cp = C; for (int task = Cp.ngw - 1 - Cp.gw; task < 4096; task += Cp.ngw) s1_task(Cp, task >> 5, task & 31);  }
            } else if (sub == 4) { if (PHK(4)) {
                const Ctx& Cp = C; s2_scan(Cp, i, rep);
                sample_norm(Cp);  }
            } else if (sub == 5) { if (PHK(5)) {
                const Ctx& Cp = C; for (int unit = Cp.vcu; unit < 512; unit += Cp.G) s3_unit(Cp, i, unit >> 2, unit & 3);  }
            } else if (sub == 6) { need_bar = false; if (PHK(6)) {
                EpiRes<0> E{H, HB0w, rep ? SSQd : SSQ + (size_t)(2 * i + 1) * TT, nullptr, nullptr, Hw};
                run_gemm(C, (const bf16*)(ws + WS_YB), (const bf16*)(ws + (i ? WS_WOUT1 : WS_WOUT0)), 1024, 2048, E, TP);
                side_gemm<0>(C, (const bf16*)(ws + WS_YB), (const bf16*)(ws + (i ? WS_WOUT1 : WS_WOUT0)), 2048, H, Hw, HB0w, E.ssq_out, nullptr, nullptr, nullptr); }
            } else if (sub == 7) { if (PHK(15)) {
                EpiPlain E2{PP, 1024};
                run_gemm(C, PBUF[i & 1], (const bf16*)(ws + WS_WP0 + (size_t)i * 512 * 1024), 1024, 256, E2, TP);
                side_gemm<2>(C, PBUF[i & 1], (const bf16*)(ws + WS_WP0 + (size_t)i * 512 * 1024), 256, nullptr, nullptr, nullptr, nullptr, nullptr, nullptr, PP); }
            } else { if (PHK(7)) {
                EpiRes<1> E{H, HB1w, rep ? SSQd : SSQ + (size_t)(2 * i + 2) * TT, SSQ + (size_t)(2 * i + 1) * TT, PP, Hw};
                run_gemm(C, HB0, (const bf16*)(ws + WS_WG0 + (size_t)i * 2 * MiB), 1024, 1024, E, TP);
                side_gemm<1>(C, HB0, (const bf16*)(ws + WS_WG0 + (size_t)i * 2 * MiB), 1024, H, Hw, HB1w, E.ssq_out, E.ssq_in, PP, nullptr); }
            }
        } else {
            const int j = (ph - 19) / 7, sub = (ph - 19) % 7, l = 2 + j;
            if (sub == 0) {
                if (j == 0) { if (PHK(8)) {
                    EpiSplit<1536, 4608, 5632, 1536, 3072, 1024, false> E{SSQ + (size_t)4 * TT, (bf16*)(ws + WS_KVRAW), (bf16*)(ws + WS_Q), (bf16*)(ws + WS_GATE), nullptr};
                    run_gemm(C, HB1, (const bf16*)(ws + WS_WKVA), 5632, 1024, E);  }
                } else { if (PHK(9)) {
                    EpiSplit<3072, 4096, 4096, 3072, 1024, 1024, false> E{SSQ + (size_t)6 * TT, (bf16*)(ws + WS_Q), (bf16*)(ws + WS_GATE), nullptr, nullptr};
                    run_gemm(C, HB1, (const bf16*)(ws + WS_WAIN1), 4096, 1024, E);  }
                }
            } else if (sub == 1) {
                if (j == 0) { if (PHK(10)) { const Ctx& Cp = C; p9_kvpass(Cp); convert_p(Cp, 3, PBUF[1]);  } } else need_bar = false;
            } else if (sub == 2) { need_bar = false; if (PHK(11)) {
                const Ctx& Cp = C; LAS float* wl = (LAS float*)(Cp.lds + Cp.wave * 16384);
                for (int task = Cp.gw; task < 1024; task += Cp.ngw) attn_sample_task(Cp, j, task, wl);  }
            } else if (sub == 3) { if (PHK(16)) {
                const Ctx& Cp = C; for (int task = Cp.ngw * 2 - 1 - Cp.gw; task >= 0 && task < 4096; task -= Cp.ngw) attn_prompt_task(Cp, j, task);  }
            } else if (sub == 4) { need_bar = false; if (PHK(12)) {
                EpiRes<0> E{H, HB0w, rep ? SSQd : SSQ + (size_t)(2 * l + 1) * TT, nullptr, nullptr, Hw};
                run_gemm(C, (const bf16*)(ws + WS_OB), (const bf16*)(ws + (j ? WS_WAOUT1 : WS_WAOUT0)), 1024, 1024, E, TP);
                side_gemm<0>(C, (const bf16*)(ws + WS_OB), (const bf16*)(ws + (j ? WS_WAOUT1 : WS_WAOUT0)), 1024, H, Hw, HB0w, E.ssq_out, nullptr, nullptr, nullptr); }
            } else if (sub == 5) { if (PHK(15)) {
                EpiPlain E2{PP, 1024};
                run_gemm(C, PBUF[l & 1], (const bf16*)(ws + WS_WP0 + (size_t)l * 512 * 1024), 1024, 256, E2, TP);
                side_gemm<2>(C, PBUF[l & 1], (const bf16*)(ws + WS_WP0 + (size_t)l * 512 * 1024), 256, nullptr, nullptr, nullptr, nullptr, nullptr, nullptr, PP); }
            } else { if (PHK(13)) {
                EpiRes<1> E{H, HB1w, rep ? SSQd : ((l < 3) ? SSQ + (size_t)(2 * l + 2) * TT : nullptr), SSQ + (size_t)(2 * l + 1) * TT, PP, Hw};
                run_gemm(C, HB0, (const bf16*)(ws + WS_WG0 + (size_t)l * 2 * MiB), 1024, 1024, E, TP);
                side_gemm<1>(C, HB0, (const bf16*)(ws + WS_WG0 + (size_t)l * 2 * MiB), 1024, H, Hw, HB1w, E.ssq_out, E.ssq_in, PP, nullptr); }
            }
        }
        }
        if (ph + 1 < hi && need_bar) { XcdBarrier bar; bar.bar = (unsigned*)(args.ws + WS_CTL) + CW_BAR; bar.x = xb_xcc_id(); bar.st = (volatile LAS unsigned*)(ldsb + MISC_OFF) + 8; xcd_barrier(bar); }
    }
}

extern "C" void kernel_launch(void* const* d_in, const int* in_sizes, int n_in, void* d_out, int out_size, void* d_ws, size_t ws_size, hipStream_t stream) {
    static int grid = 0;
    if (grid == 0) {
        int dev = 0, cus = 0;
        if (n_in != 27 || ws_size < WS_END) { fprintf(stderr, "kernel_launch: unexpected n_in %d or ws_size %zu\n", n_in, ws_size); grid = -1; return; }
        if (hipGetDevice(&dev) != hipSuccess || hipDeviceGetAttribute(&cus, hipDeviceAttributeMultiprocessorCount, dev) != hipSuccess) { grid = -1; return; }
        if (hipFuncSetAttribute((const void*)mk_fwd, hipFuncAttributeMaxDynamicSharedMemorySize, LDS_BYTES) != hipSuccess) { grid = -1; return; }
        grid = cus;
    }
    if (grid < 0) return;
    (void)hipMemsetAsync((char*)d_ws + WS_CTL, 0, WS_ZERO_BYTES, stream);
    Args a{};
    for (int i = 0; i < 27; ++i) a.in[i] = (const float*)d_in[i];
    a.out = (float*)d_out; a.ws = (unsigned char*)d_ws; a.dup = (unsigned long long)(DUP_MASK);
#if MK_LAUNCH_PER_PHASE
    for (int ph = 0; ph < N_PHASES; ++ph) { a.ph_lo = ph; a.ph_hi = ph + 1; hipLaunchKernelGGL(mk_fwd, dim3(grid), dim3(512), LDS_BYTES, stream, a); }
#else
    a.ph_lo = 0; a.ph_hi = N_PHASES;
    hipLaunchKernelGGL(mk_fwd, dim3(grid), dim3(512), LDS_BYTES, stream, a);
#endif
}
```

```cpp
#include <hip/hip_runtime.h>
#include <cstdio>
#include <cstdint>

#define LAS __attribute__((address_space(3)))
#define RLX_AGENT __ATOMIC_RELAXED, __HIP_MEMORY_SCOPE_AGENT
typedef unsigned short bf16;
typedef float f32x4 __attribute__((ext_vector_type(4)));
typedef float f32x2 __attribute__((ext_vector_type(2)));
typedef unsigned u32x4 __attribute__((ext_vector_type(4)));
typedef unsigned u32x2 __attribute__((ext_vector_type(2)));
typedef short bf16x8 __attribute__((ext_vector_type(8)));
typedef __bf16 bf16x2_t __attribute__((ext_vector_type(2)));

__device__ __forceinline__ unsigned pk2(float lo, float hi) { f32x2 v = {lo, hi}; bf16x2_t b = __builtin_convertvector(v, bf16x2_t); return __builtin_bit_cast(unsigned, b); }
__device__ __forceinline__ float bflo(unsigned u) { return __uint_as_float(u << 16); }
__device__ __forceinline__ float bfhi(unsigned u) { return __uint_as_float(u & 0xffff0000u); }
__device__ __forceinline__ float bf1(bf16 h) { return __uint_as_float(((unsigned)h) << 16); }
__device__ __forceinline__ void unpack8(const u32x4 v, float* f) { f[0] = bflo(v.x); f[1] = bfhi(v.x); f[2] = bflo(v.y); f[3] = bfhi(v.y); f[4] = bflo(v.z); f[5] = bfhi(v.z); f[6] = bflo(v.w); f[7] = bfhi(v.w); }
__device__ __forceinline__ u32x4 pack8(const float* f) { u32x4 v; v.x = pk2(f[0], f[1]); v.y = pk2(f[2], f[3]); v.z = pk2(f[4], f[5]); v.w = pk2(f[6], f[7]); return v; }
__device__ __forceinline__ float silu_f(float x) { return x / (1.f + __expf(-x)); }
__device__ __forceinline__ float sigmoid_f(float x) { return 1.f / (1.f + __expf(-x)); }
__device__ __forceinline__ float softplus_f(float x) { return x > 20.f ? x : log1pf(__expf(x)); }
__device__ __forceinline__ float wave_sum(float v) {
#pragma unroll
    for (int o = 1; o < 64; o <<= 1) v += __shfl_xor(v, o);
    return v;
}
__device__ __forceinline__ float wave_max(float v) {
#pragma unroll
    for (int o = 1; o < 64; o <<= 1) v = fmaxf(v, __shfl_xor(v, o));
    return v;
}

#define XB_TMO      128
#define XB_XCNT(j)  (256  + 64 * (j))
#define XB_XSUB(j)  (1280 + 64 * (j))
#define XB_XGEN(j)  (2304 + 64 * (j))
#define XB_TOP      3328
#define XB_TOPGEN   3392
#define XCD_BAR_WORDS 3456
#define XB_SPIN_CAP (1u << 18)

__device__ __forceinline__ unsigned xb_ld(unsigned* p)              { return __hip_atomic_load(p, __ATOMIC_RELAXED, __HIP_MEMORY_SCOPE_AGENT); }
__device__ __forceinline__ unsigned xb_add(unsigned* p, unsigned v) { return __hip_atomic_fetch_add(p, v, __ATOMIC_RELAXED, __HIP_MEMORY_SCOPE_AGENT); }
__device__ __forceinline__ unsigned xb_xcc_id() { return (unsigned)__builtin_amdgcn_s_getreg((3 << 11) | 20) & 0xFu; }
#define XB_SPIN(cond, bar) do { unsigned _sp = 0; while (cond) { __builtin_amdgcn_s_sleep(1); \
    if ((++_sp & 255u) == 0u) { if (xb_ld(&(bar)[XB_TMO])) break; if (_sp > XB_SPIN_CAP) { atomicAdd(&(bar)[XB_TMO], 1u); break; } } } } while (0)

struct XcdBarrier { unsigned* bar; unsigned x; volatile LAS unsigned* st; };

__device__ __forceinline__ XcdBarrier xcd_barrier_post(unsigned* bar, volatile LAS unsigned* st) {
    XcdBarrier b; b.bar = bar; b.x = xb_xcc_id(); b.st = st;
    if (threadIdx.x == 0) (void)xb_add(&bar[XB_XCNT(b.x)], 1u);
    return b;
}
__device__ __forceinline__ void xcd_barrier_complete(unsigned* bar, unsigned x, unsigned& nloc, unsigned& nx) {
    const unsigned G = gridDim.x * gridDim.y * gridDim.z;
    unsigned sum, cnt, mine, sp = 0u;
    for (;;) {
        sum = 0u; cnt = 0u; mine = 0u;
#pragma unroll
        for (unsigned j = 0; j < 16; ++j) { const unsigned c = xb_ld(&bar[XB_XCNT(j)]); sum += c; cnt += (c > 0u) ? 1u : 0u; mine = (j == x) ? c : mine; }
        if (sum == G) break;
        __builtin_amdgcn_s_sleep(1);
        if ((++sp & 255u) == 0u) { if (xb_ld(&bar[XB_TMO])) break; if (sp > XB_SPIN_CAP) { atomicAdd(&bar[XB_TMO], 1u); break; } }
    }
    nloc = mine > 0u ? mine : 1u; nx = cnt > 0u ? cnt : 1u;
}
__device__ __forceinline__ void xcd_barrier(const XcdBarrier& b) {
    asm volatile("s_waitcnt vmcnt(0)" ::: "memory");
    __syncthreads();
    if (threadIdx.x == 0) {
        unsigned* bar = b.bar;
        __builtin_amdgcn_s_waitcnt(0);
        unsigned nloc = b.st[0], nx = b.st[1];
        if (nloc == 0u) { xcd_barrier_complete(bar, b.x, nloc, nx); b.st[0] = nloc; b.st[1] = nx; }
        const unsigned old = xb_add(&bar[XB_XSUB(b.x)], 1u);
        const unsigned gen = old / nloc;
        if (old + 1u == (gen + 1u) * nloc) {
            __builtin_amdgcn_fence(__ATOMIC_RELEASE, "agent");
            asm volatile("s_waitcnt vmcnt(0)" ::: "memory");
            const unsigned og = xb_add(&bar[XB_TOP], 1u);
            const unsigned tg = og / nx;
            if (og + 1u == (tg + 1u) * nx) xb_add(&bar[XB_TOPGEN], 1u);
            else XB_SPIN(xb_ld(&bar[XB_TOPGEN]) == tg, bar);
            __builtin_amdgcn_fence(__ATOMIC_ACQUIRE, "agent");
            xb_add(&bar[XB_XGEN(b.x)], 1u);
            asm volatile("s_waitcnt vmcnt(0)" ::: "memory");
        } else {
            XB_SPIN(xb_ld(&bar[XB_XGEN(b.x)]) == gen, bar);
            __builtin_amdgcn_fence(__ATOMIC_ACQUIRE, "agent");
            asm volatile("s_waitcnt vmcnt(0)" ::: "memory");
        }
    }
    __syncthreads();
}
namespace pg8 {
#define PG8_LAS __attribute__((address_space(3)))
typedef unsigned short bf16_t;
typedef short bf16x8 __attribute__((ext_vector_type(8)));
typedef float f32x4 __attribute__((ext_vector_type(4)));
typedef unsigned u32x4 __attribute__((ext_vector_type(4)));
constexpr int BM = 256, BK = 64, HALF = 128, HTB = HALF * BK * 2  , STAGE_BYTES = 8 * HTB, NXCD = 8, WGM = 8;

__host__ __device__ __forceinline__ int lds_byte(int r, int c) { const int st = (r >> 4) * 2 + (c >> 5), rr = r & 15, cc = c & 31, ob = rr * 64 + cc * 2; return st * 1024 + (ob ^ (((ob >> 9) & 1) << 5)); }
__host__ __device__ __forceinline__ void stage_rc(int b, int& R, int& C) { const int st = b / 1024, sb = b % 1024, swz = sb ^ (((sb >> 9) & 1) << 5); R = (st >> 1) * 16 + swz / 64; C = (st & 1) * 32 + (swz % 64) / 2; }
__host__ __device__ __forceinline__ int perm32(int rho) { const int n = rho >> 4, i = rho & 15; return 8 * (i >> 2) + 4 * n + (i & 3); }

struct Unit { int pm, pn; };
struct Gemm { const bf16_t* A; const bf16_t* Bt; int M, N, K; };

struct StaticOrder {
    int nM, nN, nwg, G, c;
    __host__ __device__ void init(int M, int N, int G_, int c_) { nM = M / BM; nN = N / BM; nwg = nM * nN; G = G_; c = c_; }
    __host__ __device__ bool next(int i, Unit& u) const {
        const long L = (long)i * G + c; if (L >= nwg) return false;
        int wgid = (int)L; { const int q = nwg / NXCD, r = nwg % NXCD, xcd = wgid % NXCD, off = wgid / NXCD; wgid = (xcd < r ? xcd * (q + 1) : r * (q + 1) + (xcd - r) * q) + off; }
        const int nig = WGM * nN, gid = wgid / nig, fm = gid * WGM, gsz = (nM - fm) < WGM ? (nM - fm) : WGM;
        u.pm = fm + ((wgid % nig) % gsz); u.pn = (wgid % nig) / gsz; return true;
    }
    __device__ __forceinline__ void a_ready(const Unit&) const {}
    __device__ __forceinline__ void done(const Unit&) const {}
};

template <class Epi, class Sched, bool ALIGN_EPI = false, bool SP2 = false>
__device__ __forceinline__ void gemm_phase(PG8_LAS unsigned char* lds, const Gemm g, const Sched& S, const Epi& E) {
    int tid_l = threadIdx.x; asm volatile("" : "+v"(tid_l));
    const int tid = tid_l, wid = __builtin_amdgcn_readfirstlane(tid >> 6), lane = tid & 63, wr = wid >> 2, wc = wid & 3, fr = lane & 15, fq = lane >> 4;
    const int K = g.K, nt = K / BK;
    unsigned voffA[2], voffB[2];
#pragma unroll
    for (int i = 0; i < 2; ++i) { int R, C; stage_rc(tid * 16 + i * 8192, R, C); const int Rb = Epi::PERM ? ((R & ~31) + perm32(R & 31)) : R;
        voffA[i] = (unsigned)(R * K + C) * 2u; voffB[i] = (unsigned)(Rb * K + C) * 2u; }
    const size_t kstep = (size_t)(BK * 2);
    const size_t hstep = (size_t)HALF * K * 2;
    const size_t tstep = 2 * hstep;
    const unsigned ldsw = (unsigned)wid * 1024u;
    const int aoff = lds_byte(wr * 64 + fr, fq * 8), boff = lds_byte(wc * 32 + fr, fq * 8);
#define PG8_SA(b, h) (((b) * 2 + (h)) * HTB)
#define PG8_SB(b, h) ((4 + (b) * 2 + (h)) * HTB)
#define PG8_STAGE(bufoff, gbase, voff) do { _Pragma("unroll") for (int _i = 0; _i < 2; ++_i) \
        __builtin_amdgcn_global_load_lds((const unsigned*)((const char*)(gbase) + (voff)[_i]), (PG8_LAS unsigned*)(lds + (bufoff) + ldsw + _i * 8192), 16, 0, 0); } while (0)
#define PG8_LDA(dst, b, h) do { _Pragma("unroll") for (int m = 0; m < 4; ++m) _Pragma("unroll") for (int k = 0; k < 2; ++k) dst[m][k] = *(const PG8_LAS bf16x8*)(lds + PG8_SA(b, h) + aoff + m * 2048 + k * 1024); } while (0)
#define PG8_LDB(dst, b, h) do { _Pragma("unroll") for (int n = 0; n < 2; ++n) _Pragma("unroll") for (int k = 0; k < 2; ++k) dst[n][k] = *(const PG8_LAS bf16x8*)(lds + PG8_SB(b, h) + boff + n * 2048 + k * 1024); } while (0)
#define PG8_MMA(ai, bj, At, Bt) do { __builtin_amdgcn_s_setprio(1); _Pragma("unroll") for (int m = 0; m < 4; ++m) _Pragma("unroll") for (int n = 0; n < 2; ++n) _Pragma("unroll") for (int k = 0; k < 2; ++k) \
        acc[ai][bj][m][n] = __builtin_amdgcn_mfma_f32_16x16x32_bf16(Bt[n][k], At[m][k], acc[ai][bj][m][n], 0, 0, 0); __builtin_amdgcn_s_setprio(0); } while (0)
#define PG8_WAIT_V(n) asm volatile("s_waitcnt vmcnt(" #n ")" ::: "memory")
#define PG8_WAIT_L(n) asm volatile("s_waitcnt lgkmcnt(" #n ")" ::: "memory")
#define PG8_BAR __builtin_amdgcn_s_barrier()
#define PG8_SCHED __builtin_amdgcn_sched_barrier(0)
    Unit cur, nxt; int ui = 0;
    if (!S.next(0, cur)) return;
    f32x4 acc[2][2][4][2];
#pragma unroll
    for (int a = 0; a < 2; ++a)
#pragma unroll
        for (int b = 0; b < 2; ++b)
#pragma unroll
            for (int m = 0; m < 4; ++m)
#pragma unroll
                for (int n = 0; n < 2; ++n) acc[a][b][m][n] = (f32x4){0.f, 0.f, 0.f, 0.f};
    bf16x8 At[4][2], B0[2][2], B1[2][2];
    const char* cA = (const char*)g.A + (size_t)cur.pm * tstep; const char* cB = (const char*)g.Bt + (size_t)cur.pn * tstep;
    S.a_ready(cur);
    if constexpr (SP2) {
        PG8_STAGE(PG8_SB(0, 0), cB, voffB); PG8_STAGE(PG8_SB(0, 1), cB + hstep, voffB); PG8_STAGE(PG8_SA(0, 0), cA, voffA); PG8_STAGE(PG8_SA(0, 1), cA + hstep, voffA);
        if (wr == 1) PG8_BAR;
        PG8_WAIT_V(2); PG8_BAR;
        PG8_STAGE(PG8_SB(1, 0), cB + kstep, voffB); PG8_STAGE(PG8_SA(1, 0), cA + kstep, voffA); PG8_STAGE(PG8_SB(1, 1), cB + hstep + kstep, voffB);
        PG8_WAIT_V(6); PG8_BAR;
    } else {
        PG8_STAGE(PG8_SB(0, 0), cB, voffB); PG8_STAGE(PG8_SA(0, 0), cA, voffA); PG8_STAGE(PG8_SB(0, 1), cB + hstep, voffB); PG8_STAGE(PG8_SA(0, 1), cA + hstep, voffA);
        if (wr == 1) PG8_BAR;
        PG8_WAIT_V(4); PG8_BAR;
        PG8_STAGE(PG8_SB(1, 0), cB + kstep, voffB); PG8_STAGE(PG8_SA(1, 0), cA + kstep, voffA); PG8_STAGE(PG8_SB(1, 1), cB + hstep + kstep, voffB);
        PG8_WAIT_V(6); PG8_BAR;
    }
    for (;;) {
        const bool has_next = S.next(ui + 1, nxt);
        const char* nA = has_next ? (const char*)g.A + (size_t)nxt.pm * tstep : cA; const char* nB = has_next ? (const char*)g.Bt + (size_t)nxt.pn * tstep : cB;
        for (int t = 0; t < nt; t += 2) {
            const bool last = (t == nt - 2);
            const char* a1 = cA + (size_t)(t + 1) * kstep;
            const char* a2 = last ? nA : cA + (size_t)(t + 2) * kstep; const char* b2 = last ? nB : cB + (size_t)(t + 2) * kstep;
            const char* a3 = a2 + kstep; const char* b3 = b2 + kstep;
            if (last && has_next) S.a_ready(nxt);
            if constexpr (SP2) {
            PG8_LDB(B0, 0, 0); PG8_LDB(B1, 0, 1); PG8_SCHED; PG8_LDA(At, 0, 0); PG8_STAGE(PG8_SA(1, 1), a1 + hstep, voffA);
            PG8_WAIT_V(8); PG8_WAIT_L(0); PG8_BAR; PG8_MMA(0, 0, At, B0); PG8_MMA(0, 1, At, B1); PG8_BAR; PG8_SCHED;
            PG8_LDA(At, 0, 1); PG8_STAGE(PG8_SB(0, 0), b2, voffB); PG8_STAGE(PG8_SB(0, 1), b2 + hstep, voffB); PG8_STAGE(PG8_SA(0, 0), a2, voffA);
            PG8_WAIT_V(8); PG8_WAIT_L(0); PG8_BAR; PG8_MMA(1, 0, At, B0); PG8_MMA(1, 1, At, B1); PG8_BAR; PG8_SCHED;
            PG8_LDB(B0, 1, 0); PG8_LDB(B1, 1, 1); PG8_SCHED; PG8_LDA(At, 1, 0); PG8_STAGE(PG8_SA(0, 1), a2 + hstep, voffA);
            PG8_WAIT_V(8); PG8_WAIT_L(0); PG8_BAR; PG8_MMA(0, 0, At, B0); PG8_MMA(0, 1, At, B1); PG8_BAR; PG8_SCHED;
            PG8_LDA(At, 1, 1); PG8_STAGE(PG8_SB(1, 0), b3, voffB); PG8_STAGE(PG8_SB(1, 1), b3 + hstep, voffB); PG8_STAGE(PG8_SA(1, 0), a3, voffA);
            PG8_WAIT_V(8); PG8_WAIT_L(0); PG8_BAR; PG8_MMA(1, 0, At, B0); PG8_MMA(1, 1, At, B1); PG8_BAR; PG8_SCHED;
            } else {
            PG8_LDB(B0, 0, 0); PG8_SCHED; PG8_LDA(At, 0, 0); PG8_STAGE(PG8_SA(1, 1), a1 + hstep, voffA);
            PG8_WAIT_L(8); PG8_BAR; PG8_WAIT_L(0); PG8_MMA(0, 0, At, B0); PG8_BAR; PG8_SCHED;
            PG8_LDB(B1, 0, 1); PG8_STAGE(PG8_SB(0, 0), b2, voffB);
            PG8_BAR; PG8_WAIT_L(0); PG8_MMA(0, 1, At, B1); PG8_BAR;
            PG8_LDA(At, 0, 1); PG8_STAGE(PG8_SA(0, 0), a2, voffA);
            PG8_BAR; PG8_WAIT_L(0); PG8_MMA(1, 0, At, B0); PG8_BAR; PG8_SCHED;
            PG8_STAGE(PG8_SB(0, 1), b2 + hstep, voffB);
            PG8_WAIT_V(6); PG8_BAR; PG8_MMA(1, 1, At, B1); PG8_BAR;
            PG8_LDB(B0, 1, 0); PG8_SCHED; PG8_LDA(At, 1, 0); PG8_STAGE(PG8_SA(0, 1), a2 + hstep, voffA);
            PG8_WAIT_L(8); PG8_BAR; PG8_WAIT_L(0); PG8_MMA(0, 0, At, B0); PG8_BAR; PG8_SCHED;
            PG8_LDB(B1, 1, 1); PG8_STAGE(PG8_SB(1, 0), b3, voffB);
            PG8_BAR; PG8_WAIT_L(0); PG8_MMA(0, 1, At, B1); PG8_BAR;
            PG8_LDA(At, 1, 1); PG8_STAGE(PG8_SA(1, 0), a3, voffA);
            PG8_BAR; PG8_WAIT_L(0); PG8_MMA(1, 0, At, B0); PG8_BAR; PG8_SCHED;
            PG8_STAGE(PG8_SB(1, 1), b3 + hstep, voffB);
            PG8_WAIT_V(6); PG8_BAR; PG8_MMA(1, 1, At, B1); PG8_BAR;
            }
        }
        if constexpr (ALIGN_EPI) { if (wr == 0) PG8_BAR; }
        if constexpr (!Epi::AFTER_DRAIN) { E(acc, cur, wr, wc, fr, fq); S.done(cur); }
        if (!has_next) break;
#pragma unroll
        for (int a = 0; a < 2; ++a)
#pragma unroll
            for (int b = 0; b < 2; ++b)
#pragma unroll
                for (int m = 0; m < 4; ++m)
#pragma unroll
                    for (int n = 0; n < 2; ++n) acc[a][b][m][n] = (f32x4){0.f, 0.f, 0.f, 0.f};
        cur = nxt; cA = nA; cB = nB; ++ui;
        if constexpr (ALIGN_EPI) { if (wr == 1) PG8_BAR; }
    }
    PG8_WAIT_V(0);
    if constexpr (!ALIGN_EPI) { if (wr == 0) PG8_BAR; }
    PG8_BAR;
    if constexpr (Epi::AFTER_DRAIN) { E.fused(acc, cur, wr, wc, fr, fq, lds, wid, lane); S.done(cur); }
#undef PG8_SA
#undef PG8_SB
#undef PG8_STAGE
#undef PG8_LDA
#undef PG8_LDB
#undef PG8_MMA
#undef PG8_WAIT_V
#undef PG8_WAIT_L
#undef PG8_BAR
#undef PG8_SCHED
}
}

constexpr int DM = 1024, TP = 16384, TSM = 256, TT = 16640, SEQ = 8192;
constexpr int DIN = 2048, CONVD = 3072, NH = 32, DST = 128;
constexpr int MINW = 5152, MINP = 5376;
constexpr float EPS = 1e-6f;
constexpr size_t MiB = 1u << 20;
constexpr size_t O_Y = 0, O_SSMP = 17039360, O_CONVP = 18087936, O_SSMS = 18124800, O_CONVS = 34902016;
constexpr size_t O_KVP1 = 35491840, O_KVP2 = 35622912, O_KVP3 = 36147200, O_KVS1 = 38244352, O_KVS2 = 38375424, O_KVS3 = 38506496;
constexpr size_t WS_CTL = 0, WS_SSQ = 1 * MiB, WS_ZERO_BYTES = 2 * MiB;
constexpr size_t WS_WIN0 = 2 * MiB, WS_WIN1 = 13 * MiB, WS_WOUT0 = 24 * MiB, WS_WOUT1 = 28 * MiB, WS_WKVA = 32 * MiB, WS_WAIN1 = 43 * MiB;
constexpr size_t WS_WAOUT0 = 51 * MiB, WS_WAOUT1 = 53 * MiB, WS_WG0 = 55 * MiB, WS_WP0 = 63 * MiB;
constexpr size_t WS_ROPEC = 65 * MiB, WS_ROPES = 66 * MiB + 512 * 1024;
constexpr size_t WS_HB = 68 * MiB, WS_PBUFA = 101 * MiB, WS_PBUFB = 110 * MiB, WS_PP = 119 * MiB;
constexpr size_t WS_DTRAW = 152 * MiB, WS_DTC = 155 * MiB, WS_ACU = 157 * MiB, WS_XSS = 159 * MiB, WS_YSRAW = 162 * MiB;
constexpr size_t WS_ZB = 164 * MiB, WS_XBC = 229 * MiB, WS_XT = 327 * MiB, WS_BROW = 391 * MiB, WS_BT = 407 * MiB, WS_CROW = 423 * MiB, WS_STATES = 439 * MiB;
constexpr size_t WS_YB = WS_XBC;
constexpr size_t WS_GATE = WS_ZB, WS_Q = WS_XBC, WS_KVRAW = WS_XT, WS_KN = WS_BROW, WS_KSS = WS_CROW, WS_VSS = WS_CROW + 1 * MiB, WS_VT = WS_STATES, WS_OB = WS_STATES + 24 * MiB;
constexpr size_t WS_END = 503 * MiB;
constexpr int CW_BAR = 4096;
constexpr int ROPE_ROWS = 8200;

constexpr int RING_BYTES = 151552, MISC_OFF = RING_BYTES + 320, LDS_BYTES = 155648;

struct Args { const float* in[27]; float* out; unsigned char* ws; unsigned long long dup; int ph_lo, ph_hi; };

struct Ctx {
    LAS unsigned char* lds;
    int tid, lane, wave, vcu, G;
    int gw, ngw;
    const float* const* in; float* out; unsigned char* ws;
};

template <int C1, int C2, int C3, int LD0, int LD1, int LD2, bool HAS_DT>
struct EpiSplit {
    static constexpr bool PERM = true, AFTER_DRAIN = false;
    const float* ssq; bf16* p0; bf16* p1; bf16* p2; float* dt;
    template <int LD> __device__ __forceinline__ void seg(const f32x4 (&acc)[2][2][4][2], bf16* base, unsigned row0, unsigned col0) const {
#pragma unroll
        for (int ai = 0; ai < 2; ++ai)
#pragma unroll
            for (int m = 0; m < 4; ++m) { const unsigned r = row0 + ai * 128 + m * 16; bf16* rowp = base + (r * (unsigned)LD + col0); const float s = rsqrtf(ssq[r] * (1.f / 1024.f) + EPS);
#pragma unroll
                for (int bj = 0; bj < 2; ++bj) { const f32x4 v0 = acc[ai][bj][m][0] * s, v1 = acc[ai][bj][m][1] * s;
                    u32x4 w; w.x = pk2(v0[0], v0[1]); w.y = pk2(v0[2], v0[3]); w.z = pk2(v1[0], v1[1]); w.w = pk2(v1[2], v1[3]);
                    *(u32x4*)(rowp + bj * 128) = w; } }
    }
    __device__ __forceinline__ void operator()(const f32x4 (&acc)[2][2][4][2], const pg8::Unit& u, int wr, int wc, int fr, int fq) const {
        const int colt = u.pn * 256; const unsigned row0 = u.pm * 256 + wr * 64 + fr; const unsigned cw = wc * 32 + 8 * fq;
        if (colt >= C3) {
            if (HAS_DT && wc == 0) {
#pragma unroll
                for (int ai = 0; ai < 2; ++ai)
#pragma unroll
                    for (int m = 0; m < 4; ++m) { const unsigned r = row0 + ai * 128 + m * 16; float* o = dt + (r * 32u + 8 * fq); const float s = rsqrtf(ssq[r] * (1.f / 1024.f) + EPS);
                        *(f32x4*)o = acc[ai][0][m][0] * s; *(f32x4*)(o + 4) = acc[ai][0][m][1] * s; }
            }
            return;
        }
        if (colt < C1) seg<LD0>(acc, p0, row0, colt + cw);
        else if (colt < C2) seg<LD1>(acc, p1, row0, colt - C1 + cw);
        else seg<LD2>(acc, p2, row0, colt - C2 + cw);
    }
};

template <int MODE> struct EpiRes {
    static constexpr bool PERM = true, AFTER_DRAIN = false;
    float* H; bf16* HB; float* ssq_out; const float* ssq_in; const bf16* PP; float* Hout;
    __device__ __forceinline__ void operator()(const f32x4 (&acc)[2][2][4][2], const pg8::Unit& u, int wr, int wc, int fr, int fq) const {
        const int row0 = u.pm * 256 + wr * 64 + fr, col0 = u.pn * 256 + wc * 32 + 8 * fq;
#pragma unroll
        for (int ai = 0; ai < 2; ++ai)
#pragma unroll
            for (int m = 0; m < 4; ++m) {
                const int r = row0 + ai * 128 + m * 16; const size_t off = (size_t)r * DM + col0;
                float rs = 1.f; if (MODE == 1) rs = rsqrtf(ssq_in[r] * (1.f / 1024.f) + EPS);
                float ss = 0.f;
#pragma unroll
                for (int bj = 0; bj < 2; ++bj) {
                    const f32x4 b0 = *(const f32x4*)(H + off + bj * 128), b1 = *(const f32x4*)(H + off + bj * 128 + 4);
                    f32x4 d0 = acc[ai][bj][m][0], d1 = acc[ai][bj][m][1];
                    if (MODE == 1) {
                        const u32x4 pv = *(const u32x4*)(PP + off + bj * 128); float pf[8]; unpack8(pv, pf);
#pragma unroll
                        for (int j = 0; j < 4; ++j) { d0[j] = sigmoid_f(d0[j] * rs) * pf[j]; d1[j] = sigmoid_f(d1[j] * rs) * pf[4 + j]; }
                    }
                    const f32x4 h0 = b0 + d0, h1 = b1 + d1;
                    *(f32x4*)(Hout + off + bj * 128) = h0; *(f32x4*)(Hout + off + bj * 128 + 4) = h1;
                    u32x4 w; w.x = pk2(h0[0], h0[1]); w.y = pk2(h0[2], h0[3]); w.z = pk2(h1[0], h1[1]); w.w = pk2(h1[2], h1[3]);
                    *(u32x4*)(HB + off + bj * 128) = w;
                    ss += (h0[0] * h0[0] + h0[1] * h0[1]) + (h0[2] * h0[2] + h0[3] * h0[3]) + (h1[0] * h1[0] + h1[1] * h1[1]) + (h1[2] * h1[2] + h1[3] * h1[3]);
                }
                ss += __shfl_xor(ss, 16); ss += __shfl_xor(ss, 32);
                if (fq == 0 && ssq_out != nullptr) atomicAdd(ssq_out + r, ss);
                if (m & 1) asm volatile("" ::: "memory");
            }
    }
};

struct EpiPlain {
    static constexpr bool PERM = true, AFTER_DRAIN = false;
    bf16* O; int ld;
    __device__ __forceinline__ void operator()(const f32x4 (&acc)[2][2][4][2], const pg8::Unit& u, int wr, int wc, int fr, int fq) const {
        const int row0 = u.pm * 256 + wr * 64 + fr, col0 = u.pn * 256 + wc * 32 + 8 * fq;
#pragma unroll
        for (int ai = 0; ai < 2; ++ai)
#pragma unroll
            for (int m = 0; m < 4; ++m) { bf16* rowp = O + (size_t)(row0 + ai * 128 + m * 16) * ld + col0;
#pragma unroll
                for (int bj = 0; bj < 2; ++bj) { const f32x4 v0 = acc[ai][bj][m][0], v1 = acc[ai][bj][m][1];
                    u32x4 w; w.x = pk2(v0[0], v0[1]); w.y = pk2(v0[2], v0[3]); w.z = pk2(v1[0], v1[1]); w.w = pk2(v1[2], v1[3]);
                    *(u32x4*)(rowp + bj * 128) = w; } }
    }
};

__device__ __forceinline__ void transpose_item(const float* __restrict__ W, int K, int Nsrc, bf16* __restrict__ WT, int row_off, const float* __restrict__ scale,
                                               LAS float* scr, int kb, int nb, int lane) {
    const int k0 = 64 * kb, n0 = 64 * nb;
    const int c = lane & 7, ns = lane >> 3;
    if (n0 >= Nsrc) {
#pragma unroll
        for (int j = 0; j < 8; ++j) { const int n = ns + 8 * j; *(u32x4*)(WT + (size_t)(row_off + n0 + n) * K + k0 + 8 * c) = (u32x4){0u, 0u, 0u, 0u}; }
        return;
    }
    const int r4 = lane >> 4, c16 = lane & 15;
    f32x4 v[16];
#pragma unroll
    for (int i = 0; i < 16; ++i) { v[i] = (f32x4){0.f, 0.f, 0.f, 0.f}; if (n0 + 4 * c16 < Nsrc) v[i] = *(const f32x4*)(W + (size_t)(k0 + 4 * i + r4) * Nsrc + n0 + 4 * c16); }
#pragma unroll
    for (int i = 0; i < 16; ++i) { const int kk = 4 * i + r4; const float sc = scale ? scale[k0 + kk] : 1.f; LAS float* d = scr + kk * 65 + 4 * c16;
        d[0] = v[i][0] * sc; d[1] = v[i][1] * sc; d[2] = v[i][2] * sc; d[3] = v[i][3] * sc; }
    asm volatile("s_waitcnt lgkmcnt(0)" ::: "memory");
#pragma unroll
    for (int j = 0; j < 8; ++j) { const int n = ns + 8 * j; const LAS float* s = scr + (8 * c) * 65 + n;
        u32x4 o; o.x = pk2(s[0 * 65], s[1 * 65]); o.y = pk2(s[2 * 65], s[3 * 65]); o.z = pk2(s[4 * 65], s[5 * 65]); o.w = pk2(s[6 * 65], s[7 * 65]);
        *(u32x4*)(WT + (size_t)(row_off + n0 + n) * K + k0 + 8 * c) = o; }
    asm volatile("s_waitcnt lgkmcnt(0)" ::: "memory");
}

struct WJob { const float* W; const float* scale; bf16* WT; int K, Nsrc, Ndst, row_off; };

__device__ __forceinline__ void p0_prologue(const Ctx& C) {
    LAS float* scr = (LAS float*)(C.lds + C.wave * 17408);
    unsigned char* ws = C.ws;
#pragma unroll 1
    for (int job = 0; job < 20; ++job) {
        WJob J;
        if (job < 2)       { J = {C.in[10] + (size_t)job * 1024 * MINW, C.in[9] + job * 1024, (bf16*)(ws + (job ? WS_WIN1 : WS_WIN0)), 1024, MINW, MINP, 0}; }
        else if (job < 4)  { const int i = job - 2; J = {C.in[17] + (size_t)i * 2048 * 1024, C.in[16] + i * 2048, (bf16*)(ws + (i ? WS_WOUT1 : WS_WOUT0)), 2048, 1024, 1024, 0}; }
        else if (job == 4) { J = {C.in[19], C.in[18], (bf16*)(ws + WS_WKVA), 1024, 1536, 1536, 0}; }
        else if (job == 5) { J = {C.in[21], C.in[9] + 2 * 1024, (bf16*)(ws + WS_WKVA), 1024, 4096, 4096, 1536}; }
        else if (job == 6) { J = {C.in[21] + (size_t)1024 * 4096, C.in[9] + 3 * 1024, (bf16*)(ws + WS_WAIN1), 1024, 4096, 4096, 0}; }
        else if (job < 9)  { const int i = job - 7; J = {C.in[23] + (size_t)i * 1024 * 1024, nullptr, (bf16*)(ws + (i ? WS_WAOUT1 : WS_WAOUT0)), 1024, 1024, 1024, 0}; }
        else if (job < 13) { const int i = job - 9; J = {C.in[25] + (size_t)i * 1024 * 1024, C.in[26] + i * 1024, (bf16*)(ws + WS_WG0 + (size_t)i * 2 * MiB), 1024, 1024, 1024, 0}; }
        else if (job < 17) { const int i = job - 13; J = {C.in[24] + (size_t)i * 256 * 1024, nullptr, (bf16*)(ws + WS_WP0 + (size_t)i * 512 * 1024), 256, 1024, 1024, 0}; }
        else break;
        const int nblk = J.Ndst / 64, nitems = (J.K / 64) * nblk;
        for (int it = C.gw; it < nitems; it += C.ngw) transpose_item(J.W, J.K, J.Nsrc, J.WT, J.row_off, J.scale, scr, it / nblk, it % nblk, C.lane);
    }
    {
        float* H = C.out; bf16* HB = (bf16*)(ws + WS_OB); float* ssq = (float*)(ws + WS_SSQ);
        for (int m = C.gw; m < TT; m += C.ngw) {
            const float* xrow = (m < TP) ? C.in[0] + (size_t)m * DM : C.in[1] + (size_t)(m - TP) * DM;
            const f32x4* xr = (const f32x4*)xrow + C.lane;
            f32x4 v[4]; float s = 0.f;
#pragma unroll
            for (int j = 0; j < 4; ++j) { v[j] = xr[64 * j]; s += (v[j][0] * v[j][0] + v[j][1] * v[j][1]) + (v[j][2] * v[j][2] + v[j][3] * v[j][3]); }
            s = wave_sum(s);
            f32x4* ho = (f32x4*)(H + (size_t)m * DM) + C.lane; u32x2* bo = (u32x2*)(HB + (size_t)m * DM) + C.lane;
#pragma unroll
            for (int j = 0; j < 4; ++j) { ho[64 * j] = v[j]; u32x2 w; w.x = pk2(v[j][0], v[j][1]); w.y = pk2(v[j][2], v[j][3]); bo[64 * j] = w; }
            if (C.lane == 0) ssq[m] = s;
        }
    }
    {
        float* rc = (float*)(ws + WS_ROPEC); float* rsn = (float*)(ws + WS_ROPES);
        const int gt = C.gw * 64 + C.lane, ngt = C.ngw * 64;
        for (int e = gt; e < ROPE_ROWS * 32; e += ngt) {
            const int pos = e >> 5, i = e & 31;
            const float inv = 1.0f / powf(10000.0f, (float)i / 32.0f);
            const float ang = (float)pos * inv;
            rc[e] = cosf(ang); rsn[e] = sinf(ang);
        }
    }
}

__device__ __forceinline__ void convert_p(const Ctx& C, int layer, bf16* dst) {
    const float* pp = C.in[7] + (size_t)layer * TP * 256; const float* ps = C.in[8] + (size_t)layer * TSM * 256;
    const int gt = C.gw * 64 + C.lane, ngt = C.ngw * 64;
    for (int e = gt; e < TT * 32; e += ngt) {
        const int row = e >> 5, c = (e & 31) * 8;
        const float* src = (row < TP) ? pp + (size_t)row * 256 + c : ps + (size_t)(row - TP) * 256 + c;
        const f32x4 a = *(const f32x4*)src, b = *(const f32x4*)(src + 4);
        u32x4 w; w.x = pk2(a[0], a[1]); w.y = pk2(a[2], a[3]); w.z = pk2(b[0], b[1]); w.w = pk2(b[2], b[3]);
        *(u32x4*)(dst + (size_t)row * 256 + c) = w;
    }
}

__device__ __forceinline__ void p2_conv(const Ctx& C, int layer) {
    unsigned char* ws = C.ws;
    const bf16* XBC = (const bf16*)(ws + WS_XBC);
    bf16* XT = (bf16*)(ws + WS_XT); bf16* BROW = (bf16*)(ws + WS_BROW); bf16* BT = (bf16*)(ws + WS_BT); bf16* CROW = (bf16*)(ws + WS_CROW);
    const float* cw = C.in[11] + (size_t)layer * 4 * CONVD; const float* cbias = C.in[12] + (size_t)layer * CONVD;
    for (int unit = blockIdx.x; unit < 128 * 12; unit += C.G) {
        const int cidx = unit / 12, cb = unit % 12;
        const int c8 = cb * 32 + (C.tid >> 4), run = C.tid & 15, ch = c8 * 8;
        const int tok0 = cidx * 128 + run * 8, sseq0 = (cidx & 63) * 128 + run * 8;
        float w[4][8], o[8][8];
#pragma unroll
        for (int k = 0; k < 4; ++k) { const f32x4 a = *(const f32x4*)(cw + k * CONVD + ch), b = *(const f32x4*)(cw + k * CONVD + ch + 4);
#pragma unroll
            for (int i = 0; i < 4; ++i) { w[k][i] = a[i]; w[k][4 + i] = b[i]; } }
        { const f32x4 a = *(const f32x4*)(cbias + ch), b = *(const f32x4*)(cbias + ch + 4);
#pragma unroll
            for (int j = 0; j < 8; ++j)
#pragma unroll
                for (int i = 0; i < 4; ++i) { o[j][i] = a[i]; o[j][4 + i] = b[i]; } }
        u32x4 raw[11];
#pragma unroll
        for (int r = 0; r < 11; ++r) { raw[r] = (u32x4){0u, 0u, 0u, 0u}; if (sseq0 + r - 3 >= 0) raw[r] = *(const u32x4*)(XBC + (size_t)(tok0 + r - 3) * CONVD + ch); }
#pragma unroll
        for (int r = 0; r < 11; ++r) { float x[8]; unpack8(raw[r], x);
#pragma unroll
            for (int j = 0; j < 8; ++j) { const int k = r - j; if (k >= 0 && k < 4) {
#pragma unroll
                for (int i = 0; i < 8; ++i) o[j][i] += w[k][i] * x[i]; } } }
#pragma unroll
        for (int j = 0; j < 8; ++j)
#pragma unroll
            for (int i = 0; i < 8; ++i) o[j][i] = silu_f(o[j][i]);
        if (ch < DIN) {
            const int head = ch >> 6, p0 = ch & 63;
#pragma unroll
            for (int i = 0; i < 8; ++i) { float t[8];
#pragma unroll
                for (int j = 0; j < 8; ++j) t[j] = o[j][i];
                *(u32x4*)(XT + ((size_t)(cidx * 32 + head) * 64 + p0 + i) * 128 + run * 8) = pack8(t); }
        } else if (ch < DIN + 512) {
            const int g = (ch - DIN) >> 7, n0 = (ch - DIN) & 127;
#pragma unroll
            for (int j = 0; j < 8; ++j) *(u32x4*)(BROW + ((size_t)(cidx * 4 + g) * 128 + run * 8 + j) * 128 + n0) = pack8(o[j]);
#pragma unroll
            for (int i = 0; i < 8; ++i) { float t[8];
#pragma unroll
                for (int j = 0; j < 8; ++j) t[j] = o[j][i];
                *(u32x4*)(BT + ((size_t)(cidx * 4 + g) * 128 + n0 + i) * 128 + run * 8) = pack8(t); }
        } else {
            const int g = (ch - DIN - 512) >> 7, n0 = (ch - DIN - 512) & 127;
#pragma unroll
            for (int j = 0; j < 8; ++j) *(u32x4*)(CROW + ((size_t)(cidx * 4 + g) * 128 + run * 8 + j) * 128 + n0) = pack8(o[j]);
        }
        if ((cidx & 63) == 63 && run == 15) {
            const int b = cidx >> 6;
#pragma unroll
            for (int j = 0; j < 3; ++j) { float x[8]; unpack8(raw[8 + j], x); float* dst = C.out + O_CONVP + ((size_t)(layer * 2 + b) * 3 + j) * CONVD + ch;
                *(f32x4*)dst = (f32x4){x[0], x[1], x[2], x[3]}; *(f32x4*)(dst + 4) = (f32x4){x[4], x[5], x[6], x[7]}; }
        }
    }
    {
        const float* cst = C.in[3] + (size_t)layer * 32 * 3 * CONVD; float* XSS = (float*)(ws + WS_XSS);
        const int gt = C.gw * 64 + C.lane, ngt = C.ngw * 64;
        for (int e = gt; e < 32 * 384; e += ngt) {
            const int sb = e / 384, ch = (e % 384) * 8;
            float w[4][8], xin[11][8];
#pragma unroll
            for (int k = 0; k < 4; ++k) { const f32x4 a = *(const f32x4*)(cw + k * CONVD + ch), b = *(const f32x4*)(cw + k * CONVD + ch + 4);
#pragma unroll
                for (int i = 0; i < 4; ++i) { w[k][i] = a[i]; w[k][4 + i] = b[i]; } }
            float bs[8]; { const f32x4 a = *(const f32x4*)(cbias + ch), b = *(const f32x4*)(cbias + ch + 4);
#pragma unroll
                for (int i = 0; i < 4; ++i) { bs[i] = a[i]; bs[4 + i] = b[i]; } }
#pragma unroll
            for (int r = 0; r < 3; ++r) { const float* s = cst + ((size_t)sb * 3 + r) * CONVD + ch; const f32x4 a = *(const f32x4*)s, b = *(const f32x4*)(s + 4);
#pragma unroll
                for (int i = 0; i < 4; ++i) { xin[r][i] = a[i]; xin[r][4 + i] = b[i]; } }
#pragma unroll
            for (int r = 0; r < 8; ++r) { const u32x4 v = *(const u32x4*)(XBC + (size_t)(TP + sb * 8 + r) * CONVD + ch); unpack8(v, xin[3 + r]); }
#pragma unroll
            for (int j = 0; j < 8; ++j) { float o[8];
#pragma unroll
                for (int i = 0; i < 8; ++i) { float a = bs[i];
#pragma unroll
                    for (int k = 0; k < 4; ++k) a += w[k][i] * xin[j + k][i];
                    o[i] = silu_f(a); }
                float* dst = XSS + (size_t)(sb * 8 + j) * CONVD + ch;
                *(f32x4*)dst = (f32x4){o[0], o[1], o[2], o[3]}; *(f32x4*)(dst + 4) = (f32x4){o[4], o[5], o[6], o[7]}; }
#pragma unroll
            for (int j = 0; j < 3; ++j) { float* dst = C.out + O_CONVS + ((size_t)(layer * 32 + sb) * 3 + j) * CONVD + ch;
                *(f32x4*)dst = (f32x4){xin[8 + j][0], xin[8 + j][1], xin[8 + j][2], xin[8 + j][3]}; *(f32x4*)(dst + 4) = (f32x4){xin[8 + j][4], xin[8 + j][5], xin[8 + j][6], xin[8 + j][7]}; }
        }
    }
    {
        const float* DTRAW = (const float*)(ws + WS_DTRAW); float* DTC = (float*)(ws + WS_DTC); float* ACU = (float*)(ws + WS_ACU);
        const float* dtb = C.in[13] + layer * 32; const float* alog = C.in[14] + layer * 32;
        for (int task = C.gw; task < 128 * 32; task += C.ngw) {
            const int cidx = task >> 5, head = task & 31;
            const int t = cidx * 128 + 2 * C.lane;
            const float A = -__expf(alog[head]), bsv = dtb[head];
            const float d0 = softplus_f(DTRAW[(size_t)t * 32 + head] + bsv), d1 = softplus_f(DTRAW[(size_t)(t + 1) * 32 + head] + bsv);
            const float a0 = d0 * A, a1 = d1 * A;
            float x = a0 + a1;
#pragma unroll
            for (int o = 1; o < 64; o <<= 1) { const float v = __shfl_up(x, o); if (C.lane >= o) x += v; }
            *(f32x2*)(DTC + (size_t)task * 128 + 2 * C.lane) = (f32x2){d0, d1};
            *(f32x2*)(ACU + (size_t)task * 128 + 2 * C.lane) = (f32x2){x - a1, x};
        }
    }
}

#define MFMA16(a, b, c) __builtin_amdgcn_mfma_f32_16x16x32_bf16((a), (b), (c), 0, 0, 0)

__device__ __forceinline__ void s1_task(const Ctx& C, int cidx, int head) {
    unsigned char* ws = C.ws;
    const bf16* xt = (const bf16*)(ws + WS_XT) + (size_t)(cidx * 32 + head) * 64 * 128;
    const bf16* bt = (const bf16*)(ws + WS_BT) + (size_t)(cidx * 4 + (head >> 3)) * 128 * 128;
    const float* dtc = (const float*)(ws + WS_DTC) + (size_t)(cidx * 32 + head) * 128;
    const float* acu = (const float*)(ws + WS_ACU) + (size_t)(cidx * 32 + head) * 128;
    bf16* st = (bf16*)(ws + WS_STATES) + (size_t)(cidx * 32 + head) * 64 * 128;
    const int fr = C.lane & 15, fq = C.lane >> 4;
    const float aend = acu[127];
    f32x4 acc[8][4];
#pragma unroll
    for (int a = 0; a < 8; ++a)
#pragma unroll
        for (int b = 0; b < 4; ++b) acc[a][b] = (f32x4){0.f, 0.f, 0.f, 0.f};
#pragma unroll 1
    for (int ks = 0; ks < 4; ++ks) {
        const int s0 = ks * 32 + 8 * fq;
        float wv[8];
        { const f32x4 d0 = *(const f32x4*)(dtc + s0), d1 = *(const f32x4*)(dtc + s0 + 4), a0 = *(const f32x4*)(acu + s0), a1 = *(const f32x4*)(acu + s0 + 4);
#pragma unroll
          for (int j = 0; j < 4; ++j) { wv[j] = d0[j] * __expf(aend - a0[j]); wv[4 + j] = d1[j] * __expf(aend - a1[j]); } }
        bf16x8 bfr[8];
#pragma unroll
        for (int nt = 0; nt < 8; ++nt) bfr[nt] = *(const bf16x8*)(bt + (size_t)(nt * 16 + fr) * 128 + s0);
#pragma unroll
        for (int pt = 0; pt < 4; ++pt) {
            const u32x4 raw = *(const u32x4*)(xt + (size_t)(pt * 16 + fr) * 128 + s0);
            float x[8]; unpack8(raw, x);
#pragma unroll
            for (int j = 0; j < 8; ++j) x[j] *= wv[j];
            const bf16x8 afr = __builtin_bit_cast(bf16x8, pack8(x));
#pragma unroll
            for (int nt = 0; nt < 8; ++nt) acc[nt][pt] = MFMA16(bfr[nt], afr, acc[nt][pt]);
        }
    }
#pragma unroll
    for (int nt = 0; nt < 8; ++nt)
#pragma unroll
        for (int pt = 0; pt < 4; ++pt) { u32x2 w; w.x = pk2(acc[nt][pt][0], acc[nt][pt][1]); w.y = pk2(acc[nt][pt][2], acc[nt][pt][3]);
            *(u32x2*)(st + (size_t)(pt * 16 + fr) * 128 + nt * 16 + 4 * fq) = w; }
}

__device__ __forceinline__ void ssd_sample_task(const Ctx& C, int layer, int sb, int head, LAS float* wl) {
    unsigned char* ws = C.ws;
    const float* XSS = (const float*)(ws + WS_XSS); const float* DTRAW = (const float*)(ws + WS_DTRAW); const bf16* ZB = (const bf16*)(ws + WS_ZB);
    float* YSRAW = (float*)(ws + WS_YSRAW);
    const float* h0 = C.in[2] + ((size_t)(layer * 32 + sb) * 32 + head) * 64 * 128;
    float* hout = C.out + O_SSMS + ((size_t)(layer * 32 + sb) * 32 + head) * 64 * 128;
    const int g = head >> 3, lane = C.lane, tok0 = sb * 8;
    LAS float* Bl = wl;
    LAS float* Cl = wl + 1024;
    LAS float* Xl = wl + 2048;
    LAS float* XWl = wl + 2560;
    LAS float* Gl = wl + 3072;
    LAS float* Sc = wl + 3136;
    const float A = -__expf(C.in[14][layer * 32 + head]), dtb = C.in[13][layer * 32 + head], Dh = C.in[15][layer * 32 + head];
    float dtv[8], ac[8];
    { float run = 0.f;
#pragma unroll
      for (int s = 0; s < 8; ++s) { dtv[s] = softplus_f(DTRAW[(size_t)(TP + tok0 + s) * 32 + head] + dtb); run += dtv[s] * A; ac[s] = run; } }
    const float ac7 = ac[7];
    if (lane == 0) {
#pragma unroll
        for (int s = 0; s < 8; ++s) { Sc[s] = dtv[s]; Sc[8 + s] = ac[s]; }
    }
#pragma unroll
    for (int s = 0; s < 8; ++s) {
        const float* row = XSS + (size_t)(tok0 + s) * CONVD;
        *(LAS f32x2*)(Bl + s * 128 + 2 * lane) = *(const f32x2*)(row + DIN + g * 128 + 2 * lane);
        *(LAS f32x2*)(Cl + s * 128 + 2 * lane) = *(const f32x2*)(row + DIN + 512 + g * 128 + 2 * lane);
        const float xv = row[head * 64 + lane];
        Xl[s * 64 + lane] = xv; XWl[s * 64 + lane] = xv * dtv[s] * __expf(ac7 - ac[s]);
    }
    asm volatile("s_waitcnt lgkmcnt(0)" ::: "memory");
#pragma unroll 1
    for (int l = 0; l < 8; ++l) {
        const f32x2 cv = *(LAS f32x2*)(Cl + l * 128 + 2 * lane); const float acl = Sc[8 + l];
#pragma unroll 1
        for (int s = 0; s <= l; ++s) {
            const f32x2 bv = *(LAS f32x2*)(Bl + s * 128 + 2 * lane);
            float d = wave_sum(cv[0] * bv[0] + cv[1] * bv[1]);
            d = d * __expf(acl - Sc[8 + s]) * Sc[s] + ((s == l) ? Dh : 0.f);
            if (lane == 0) Gl[l * 8 + s] = d;
        }
    }
    asm volatile("s_waitcnt lgkmcnt(0)" ::: "memory");
    const int pi = lane >> 3, nj = lane & 7;
    const float cd = __expf(ac7);
    const float eal = __expf(Sc[8 + nj]);
#pragma unroll 1
    for (int pb = 0; pb < 8; ++pb) {
        const int p = pb * 8 + pi;
        float xw[8], yo[8];
#pragma unroll
        for (int s = 0; s < 8; ++s) { xw[s] = XWl[s * 64 + p]; yo[s] = 0.f; }
        f32x4 hv[4];
#pragma unroll
        for (int nb = 0; nb < 4; ++nb) hv[nb] = *(const f32x4*)(h0 + (size_t)p * 128 + nb * 32 + nj * 4);
#pragma unroll
        for (int nb = 0; nb < 4; ++nb) {
            const int n = nb * 32 + nj * 4;
            const f32x4 h4 = hv[nb];
            f32x4 hn = h4 * cd;
#pragma unroll
            for (int s = 0; s < 8; ++s) { const f32x4 b4 = *(LAS f32x4*)(Bl + s * 128 + n), c4 = *(LAS f32x4*)(Cl + s * 128 + n);
                hn += b4 * xw[s];
                yo[s] += (c4[0] * h4[0] + c4[1] * h4[1]) + (c4[2] * h4[2] + c4[3] * h4[3]); }
            *(f32x4*)(hout + (size_t)p * 128 + n) = hn;
            __builtin_amdgcn_sched_barrier(0);
        }
        float mine = 0.f;
#pragma unroll
        for (int l = 0; l < 8; ++l) { float v = yo[l]; v += __shfl_xor(v, 1); v += __shfl_xor(v, 2); v += __shfl_xor(v, 4); if (nj == l) mine = v; }
        const int l = nj;
        float y = mine * eal;
#pragma unroll 1
        for (int s = 0; s <= l; ++s) y += Gl[l * 8 + s] * Xl[s * 64 + p];
        const float z = bf1(ZB[(size_t)(TP + tok0 + l) * DIN + head * 64 + p]);
        YSRAW[(size_t)(tok0 + l) * DIN + head * 64 + p] = y * silu_f(z);
    }
    asm volatile("s_waitcnt lgkmcnt(0)" ::: "memory");
}

__device__ __forceinline__ void s2_scan(const Ctx& C, int layer, int rep) {
    unsigned char* ws = C.ws;
    bf16* ST = (bf16*)(ws + WS_STATES); const float* ACU = (const float*)(ws + WS_ACU);
    bf16* STw = rep ? (bf16*)(ws + WS_XBC) : ST; float* fin = rep ? (float*)(ws + WS_XBC + 70 * MiB) : C.out + O_SSMP;
    for (int e = blockIdx.x * 512 + C.tid; e < 2 * 32 * 64 * 32; e += C.G * 512) {
        const int n4 = e & 31, p = (e >> 5) & 63, head = (e >> 11) & 31, b = e >> 16;
        f32x4 h = (f32x4){0.f, 0.f, 0.f, 0.f};
#pragma unroll 1
        for (int c0 = 0; c0 < 64; c0 += 8) {
            u32x2 raw[8]; float cdv[8];
#pragma unroll
            for (int k = 0; k < 8; ++k) { const int cidx = b * 64 + c0 + k;
                raw[k] = *(const u32x2*)(ST + ((size_t)(cidx * 32 + head) * 64 + p) * 128 + n4 * 4);
                cdv[k] = ACU[(size_t)(cidx * 32 + head) * 128 + 127]; }
#pragma unroll
            for (int k = 0; k < 8; ++k) { const int cidx = b * 64 + c0 + k;
                u32x2 w; w.x = pk2(h[0], h[1]); w.y = pk2(h[2], h[3]);
                *(u32x2*)(STw + ((size_t)(cidx * 32 + head) * 64 + p) * 128 + n4 * 4) = w;
                const f32x4 s = (f32x4){bflo(raw[k].x), bfhi(raw[k].x), bflo(raw[k].y), bfhi(raw[k].y)};
                h = h * __expf(cdv[k]) + s; }
        }
        *(f32x4*)(fin + (((size_t)(layer * 2 + b) * 32 + head) * 64 + p) * 128 + n4 * 4) = h;
    }
}
__device__ __forceinline__ void sample_norm(const Ctx& C) {
    unsigned char* ws = C.ws; const float* YSRAW = (const float*)(ws + WS_YSRAW); bf16* YB = (bf16*)(ws + WS_YB);
    for (int task = C.gw; task < 256 * 4; task += C.ngw) {
        const int row = task >> 2, g = task & 3;
        const float* src = YSRAW + (size_t)row * DIN + g * 512 + C.lane * 8;
        const f32x4 a = *(const f32x4*)src, b = *(const f32x4*)(src + 4);
        float ss = (a[0] * a[0] + a[1] * a[1]) + (a[2] * a[2] + a[3] * a[3]) + (b[0] * b[0] + b[1] * b[1]) + (b[2] * b[2] + b[3] * b[3]);
        ss = wave_sum(ss);
        const float rs = rsqrtf(ss * (1.f / 512.f) + EPS);
        u32x4 w; w.x = pk2(a[0] * rs, a[1] * rs); w.y = pk2(a[2] * rs, a[3] * rs); w.z = pk2(b[0] * rs, b[1] * rs); w.w = pk2(b[2] * rs, b[3] * rs);
        *(u32x4*)(YB + (size_t)(TP + row) * DIN + g * 512 + C.lane * 8) = w;
    }
}

constexpr int S3_LD = 136;
constexpr int S3_CS = 0, S3_CB = 128 * S3_LD * 2, S3_BS = 2 * 128 * S3_LD * 2;
constexpr int S3_DA = 69632 + 66560;
constexpr int S3_YLD = 520;
__device__ __forceinline__ void s3_unit(const Ctx& C, int layer, int cidx, int g) {
    unsigned char* ws = C.ws;
    const bf16* CROW = (const bf16*)(ws + WS_CROW) + (size_t)(cidx * 4 + g) * 128 * 128;
    const bf16* BROW = (const bf16*)(ws + WS_BROW) + (size_t)(cidx * 4 + g) * 128 * 128;
    LAS bf16* Cs = (LAS bf16*)(C.lds + S3_CS); LAS bf16* Bs = (LAS bf16*)(C.lds + S3_BS); LAS bf16* CBs = (LAS bf16*)(C.lds + S3_CB);
    LAS bf16* Ys = (LAS bf16*)(C.lds + S3_BS);
    const int tid = C.tid, lane = C.lane, w = C.wave, fr = lane & 15, fq = lane >> 4;
#pragma unroll
    for (int i = 0; i < 4; ++i) { const int idx = tid + 512 * i, row = idx >> 4, chk = idx & 15;
        *(LAS u32x4*)(Cs + row * S3_LD + chk * 8) = *(const u32x4*)(CROW + row * 128 + chk * 8);
        *(LAS u32x4*)(Bs + row * S3_LD + chk * 8) = *(const u32x4*)(BROW + row * 128 + chk * 8); }
    __syncthreads();
    {
        f32x4 cb[8];
#pragma unroll
        for (int st = 0; st < 8; ++st) cb[st] = (f32x4){0.f, 0.f, 0.f, 0.f};
#pragma unroll
        for (int ks = 0; ks < 4; ++ks) {
            const bf16x8 cf = *(LAS bf16x8*)(Cs + (w * 16 + fr) * S3_LD + ks * 32 + 8 * fq);
#pragma unroll
            for (int st = 0; st < 8; ++st) if (st <= w) { const bf16x8 bf = *(LAS bf16x8*)(Bs + (st * 16 + fr) * S3_LD + ks * 32 + 8 * fq); cb[st] = MFMA16(bf, cf, cb[st]); }
        }
#pragma unroll
        for (int st = 0; st < 8; ++st) { u32x2 v; v.x = pk2(cb[st][0], cb[st][1]); v.y = pk2(cb[st][2], cb[st][3]);
            *(LAS u32x2*)(CBs + (w * 16 + fr) * S3_LD + st * 16 + 4 * fq) = v; }
    }
    __syncthreads();
    const int head = g * 8 + w;
    const bf16* xt = (const bf16*)(ws + WS_XT) + (size_t)(cidx * 32 + head) * 64 * 128;
    const bf16* hin = (const bf16*)(ws + WS_STATES) + (size_t)(cidx * 32 + head) * 64 * 128;
    const float* dtc = (const float*)(ws + WS_DTC) + (size_t)(cidx * 32 + head) * 128;
    const float* acu = (const float*)(ws + WS_ACU) + (size_t)(cidx * 32 + head) * 128;
    const float Dh = C.in[15][layer * 32 + head];
    LAS float* dtl = (LAS float*)(C.lds + S3_DA) + w * 256; LAS float* acl = dtl + 128;
    { const f32x2 d2 = *(const f32x2*)(dtc + 2 * lane), a2 = *(const f32x2*)(acu + 2 * lane); *(LAS f32x2*)(dtl + 2 * lane) = d2; *(LAS f32x2*)(acl + 2 * lane) = a2; }
    asm volatile("s_waitcnt lgkmcnt(0)" ::: "memory");
#pragma unroll 1
    for (int half = 0; half < 2; ++half) {
        bf16x8 hf[4][4];
#pragma unroll
        for (int ks = 0; ks < 4; ++ks)
#pragma unroll
            for (int pt = 0; pt < 4; ++pt) hf[ks][pt] = *(const bf16x8*)(hin + (size_t)(pt * 16 + fr) * 128 + ks * 32 + 8 * fq);
        f32x4 acc[4][4];
#pragma unroll
        for (int a = 0; a < 4; ++a)
#pragma unroll
            for (int b = 0; b < 4; ++b) acc[a][b] = (f32x4){0.f, 0.f, 0.f, 0.f};
#pragma unroll
        for (int ks = 0; ks < 4; ++ks) {
#pragma unroll
            for (int lt = 0; lt < 4; ++lt) { const bf16x8 cf = *(LAS bf16x8*)(Cs + ((4 * half + lt) * 16 + fr) * S3_LD + ks * 32 + 8 * fq);
#pragma unroll
                for (int pt = 0; pt < 4; ++pt) acc[lt][pt] = MFMA16(hf[ks][pt], cf, acc[lt][pt]); }
            __builtin_amdgcn_sched_barrier(0);
        }
        float al[4];
#pragma unroll
        for (int lt = 0; lt < 4; ++lt) { al[lt] = acl[(4 * half + lt) * 16 + fr]; const float e = __expf(al[lt]);
#pragma unroll
            for (int pt = 0; pt < 4; ++pt) acc[lt][pt] *= e; }
#pragma unroll 1
        for (int ks = 0; ks < 2 * half + 2; ++ks) {
            const int s0 = ks * 32 + 8 * fq;
            bf16x8 xf[4];
#pragma unroll
            for (int pt = 0; pt < 4; ++pt) xf[pt] = *(const bf16x8*)(xt + (size_t)(pt * 16 + fr) * 128 + s0);
            float ds[8], as[8];
            { const f32x4 d0 = *(LAS f32x4*)(dtl + s0), d1 = *(LAS f32x4*)(dtl + s0 + 4), a0 = *(LAS f32x4*)(acl + s0), a1 = *(LAS f32x4*)(acl + s0 + 4);
#pragma unroll
              for (int j = 0; j < 4; ++j) { ds[j] = d0[j]; ds[4 + j] = d1[j]; as[j] = a0[j]; as[4 + j] = a1[j]; } }
#pragma unroll
            for (int lt = 0; lt < 4; ++lt) if (4 * half + lt >= 2 * ks) {
                const int l = (4 * half + lt) * 16 + fr;
                const u32x4 raw = *(LAS u32x4*)(CBs + l * S3_LD + s0);
                float gv[8]; unpack8(raw, gv);
#pragma unroll
                for (int j = 0; j < 8; ++j) { const int s = s0 + j; float v = gv[j] * __expf(al[lt] - as[j]) * ds[j]; v = (s <= l) ? v : 0.f; gv[j] = (s == l) ? v + Dh : v; }
                const bf16x8 gf = __builtin_bit_cast(bf16x8, pack8(gv));
#pragma unroll
                for (int pt = 0; pt < 4; ++pt) acc[lt][pt] = MFMA16(xf[pt], gf, acc[lt][pt]);
            }
        }
#pragma unroll
        for (int lt = 0; lt < 4; ++lt)
#pragma unroll
            for (int pt = 0; pt < 4; ++pt) { u32x2 v; v.x = pk2(acc[lt][pt][0], acc[lt][pt][1]); v.y = pk2(acc[lt][pt][2], acc[lt][pt][3]);
                *(LAS u32x2*)(Ys + (lt * 16 + fr) * S3_YLD + w * 64 + pt * 16 + 4 * fq) = v; }
        __syncthreads();
        {
            const int lr = tid >> 3, oc = tid & 7; const size_t tok = (size_t)cidx * 128 + half * 64 + lr;
            const bf16* zrow = (const bf16*)(ws + WS_ZB) + tok * DIN + g * 512 + oc * 64;
            bf16* yrow = (bf16*)(ws + WS_YB) + tok * DIN + g * 512 + oc * 64;
            float v[8][8]; float ss = 0.f;
#pragma unroll
            for (int c = 0; c < 8; ++c) { const u32x4 yr = *(LAS u32x4*)(Ys + lr * S3_YLD + oc * 64 + c * 8); const u32x4 zr = *(const u32x4*)(zrow + c * 8);
                float zf[8]; unpack8(yr, v[c]); unpack8(zr, zf);
#pragma unroll
                for (int j = 0; j < 8; ++j) { v[c][j] *= silu_f(zf[j]); ss += v[c][j] * v[c][j]; } }
            ss += __shfl_xor(ss, 1); ss += __shfl_xor(ss, 2); ss += __shfl_xor(ss, 4);
            const float rs = rsqrtf(ss * (1.f / 512.f) + EPS);
#pragma unroll
            for (int c = 0; c < 8; ++c) {
#pragma unroll
                for (int j = 0; j < 8; ++j) v[c][j] *= rs;
                *(u32x4*)(yrow + c * 8) = pack8(v[c]); }
        }
        __syncthreads();
    }
}

template <int MODE>
__device__ __forceinline__ void side_gemm(const Ctx& C, const bf16* __restrict__ A, const bf16* __restrict__ Wt, int K,
                                          float* H, float* Hout, bf16* HB, float* ssq_out, const float* ssq_in, const bf16* PP, bf16* OUT) {
    const int lane = C.lane, w = C.wave, fr = lane & 15, fq = lane >> 4, tid = C.tid;
    LAS float* red = (LAS float*)C.lds;
    const int kper = K >> 3;
    for (int tile = C.vcu; tile < 256; tile += C.G) {
        const int rg = tile >> 4, cg = tile & 15;
        const bf16* ap = A + (size_t)(TP + rg * 16 + fr) * K + w * kper + 8 * fq;
        const bf16* wp = Wt + (size_t)(cg * 64 + fr) * K + w * kper + 8 * fq;
        f32x4 acc[4];
#pragma unroll
        for (int ct = 0; ct < 4; ++ct) acc[ct] = (f32x4){0.f, 0.f, 0.f, 0.f};
#pragma unroll 1
        for (int k0 = 0; k0 < kper; k0 += 128) {
            bf16x8 af[4], wf[4][4];
#pragma unroll
            for (int s = 0; s < 4; ++s) if (k0 + 32 * s < kper) {
                af[s] = *(const bf16x8*)(ap + k0 + 32 * s);
#pragma unroll
                for (int ct = 0; ct < 4; ++ct) wf[s][ct] = *(const bf16x8*)(wp + (size_t)ct * 16 * K + k0 + 32 * s);
            }
#pragma unroll
            for (int s = 0; s < 4; ++s) if (k0 + 32 * s < kper) {
#pragma unroll
                for (int ct = 0; ct < 4; ++ct) acc[ct] = MFMA16(wf[s][ct], af[s], acc[ct]);
            }
        }
#pragma unroll
        for (int ct = 0; ct < 4; ++ct) *(LAS f32x4*)(red + (w * 16 + fr) * 64 + ct * 16 + 4 * fq) = acc[ct];
        __syncthreads();
        if (tid < 256) {
            const int m = tid >> 4, c4 = (tid & 15) * 4;
            f32x4 v = (f32x4){0.f, 0.f, 0.f, 0.f};
#pragma unroll
            for (int ww = 0; ww < 8; ++ww) v += *(LAS f32x4*)(red + (ww * 16 + m) * 64 + c4);
            const int row = TP + rg * 16 + m; const size_t off = (size_t)row * DM + cg * 64 + c4;
            if (MODE == 2) {
                u32x2 o; o.x = pk2(v[0], v[1]); o.y = pk2(v[2], v[3]); *(u32x2*)(OUT + off) = o;
            } else {
                if (MODE == 1) {
                    const float rs = rsqrtf(ssq_in[row] * (1.f / 1024.f) + EPS);
                    const u32x2 pr = *(const u32x2*)(PP + off);
                    v[0] = sigmoid_f(v[0] * rs) * bflo(pr.x); v[1] = sigmoid_f(v[1] * rs) * bfhi(pr.x); v[2] = sigmoid_f(v[2] * rs) * bflo(pr.y); v[3] = sigmoid_f(v[3] * rs) * bfhi(pr.y);
                }
                const f32x4 h = *(const f32x4*)(H + off) + v;
                *(f32x4*)(Hout + off) = h;
                u32x2 o; o.x = pk2(h[0], h[1]); o.y = pk2(h[2], h[3]); *(u32x2*)(HB + off) = o;
                float ss = (h[0] * h[0] + h[1] * h[1]) + (h[2] * h[2] + h[3] * h[3]);
                ss += __shfl_xor(ss, 1); ss += __shfl_xor(ss, 2); ss += __shfl_xor(ss, 4); ss += __shfl_xor(ss, 8);
                if ((tid & 15) == 0 && ssq_out != nullptr) atomicAdd(ssq_out + row, ss);
            }
        }
        __syncthreads();
    }
}

__device__ __forceinline__ void p9_kvpass(const Ctx& C) {
    unsigned char* ws = C.ws;
    const bf16* KVRAW = (const bf16*)(ws + WS_KVRAW); bf16* KN = (bf16*)(ws + WS_KN); bf16* VT = (bf16*)(ws + WS_VT);
    float* KSS = (float*)(ws + WS_KSS); float* VSS = (float*)(ws + WS_VSS);
    const float* ropec = (const float*)(ws + WS_ROPEC); const float* ropes = (const float*)(ws + WS_ROPES);
    const float* knw = C.in[20];
    const int lane = C.lane, q4 = lane & 3;
    float wk[16];
#pragma unroll
    for (int j = 0; j < 8; ++j) { wk[j] = knw[8 * q4 + j]; wk[8 + j] = knw[32 + 8 * q4 + j]; }
    for (int pass = C.gw; pass < TT * 12 / 16; pass += C.ngw) {
        const int hr = pass * 16 + (lane >> 2), row = hr / 12, gk = hr % 12, gi = gk >> 2, kh = gk & 3;
        const bf16* src = KVRAW + (size_t)row * 1536 + gk * 64 + 8 * q4;
        float k[16], v[16];
        unpack8(*(const u32x4*)src, k); unpack8(*(const u32x4*)(src + 32), k + 8);
        unpack8(*(const u32x4*)(src + 768), v); unpack8(*(const u32x4*)(src + 768 + 32), v + 8);
        float ss = 0.f;
#pragma unroll
        for (int j = 0; j < 16; ++j) ss += k[j] * k[j];
        ss += __shfl_xor(ss, 1); ss += __shfl_xor(ss, 2);
        const float rs = rsqrtf(ss * (1.f / 64.f) + EPS);
        const int pos = (row < TP) ? (row & 8191) : 8192 + ((row - TP) & 7);
        float ko[16];
#pragma unroll
        for (int j = 0; j < 8; ++j) { const float x1 = k[j] * rs * wk[j], x2 = k[8 + j] * rs * wk[8 + j];
            const float c = ropec[pos * 32 + 8 * q4 + j], s = ropes[pos * 32 + 8 * q4 + j];
            ko[j] = x1 * c - x2 * s; ko[8 + j] = x2 * c + x1 * s; }
        bf16* kd = KN + (size_t)row * 768 + gk * 64 + 8 * q4;
        *(u32x4*)kd = pack8(ko); *(u32x4*)(kd + 32) = pack8(ko + 8);
        float* ok = nullptr; float* ov = nullptr;
        if (row < TP) {
            const int b = row >> 13, W = (gi == 0) ? 128 : (gi == 1) ? 512 : 2048;
            const size_t obase = (gi == 0) ? O_KVP1 : (gi == 1) ? O_KVP2 : O_KVP3;
            if (pos >= 8192 - W) { const int jw = pos - (8192 - W); ok = C.out + obase + ((size_t)(b * W + jw) * 2) * 256 + kh * 64 + 8 * q4; ov = ok + 256; }
        } else {
            const int rs_ = row - TP;
            const size_t obase = (gi == 0) ? O_KVS1 : (gi == 1) ? O_KVS2 : O_KVS3;
            ok = C.out + obase + ((size_t)rs_ * 2) * 256 + kh * 64 + 8 * q4; ov = ok + 256;
            float* k2 = KSS + (size_t)rs_ * 768 + gk * 64 + 8 * q4; float* v2 = VSS + (size_t)rs_ * 768 + gk * 64 + 8 * q4;
#pragma unroll
            for (int h2 = 0; h2 < 2; ++h2) {
                *(f32x4*)(k2 + 32 * h2) = (f32x4){ko[8 * h2], ko[8 * h2 + 1], ko[8 * h2 + 2], ko[8 * h2 + 3]}; *(f32x4*)(k2 + 32 * h2 + 4) = (f32x4){ko[8 * h2 + 4], ko[8 * h2 + 5], ko[8 * h2 + 6], ko[8 * h2 + 7]};
                *(f32x4*)(v2 + 32 * h2) = (f32x4){v[8 * h2], v[8 * h2 + 1], v[8 * h2 + 2], v[8 * h2 + 3]}; *(f32x4*)(v2 + 32 * h2 + 4) = (f32x4){v[8 * h2 + 4], v[8 * h2 + 5], v[8 * h2 + 6], v[8 * h2 + 7]}; }
        }
        if (ok != nullptr) {
#pragma unroll
            for (int h2 = 0; h2 < 2; ++h2) {
                *(f32x4*)(ok + 32 * h2) = (f32x4){ko[8 * h2], ko[8 * h2 + 1], ko[8 * h2 + 2], ko[8 * h2 + 3]}; *(f32x4*)(ok + 32 * h2 + 4) = (f32x4){ko[8 * h2 + 4], ko[8 * h2 + 5], ko[8 * h2 + 6], ko[8 * h2 + 7]};
                *(f32x4*)(ov + 32 * h2) = (f32x4){v[8 * h2], v[8 * h2 + 1], v[8 * h2 + 2], v[8 * h2 + 3]}; *(f32x4*)(ov + 32 * h2 + 4) = (f32x4){v[8 * h2 + 4], v[8 * h2 + 5], v[8 * h2 + 6], v[8 * h2 + 7]}; }
        }
    }
    {
        const int gt = C.gw * 64 + lane, ngt = C.ngw * 64;
        for (int e = gt; e < 2 * 12 * 8 * 1024; e += ngt) {
            const int ddc = e & 7, run = (e >> 3) & 1023, bg = e >> 13, gk = bg % 12, b = bg / 12, gi = gk >> 2;
            const int dsh = 2 * gi, d = 1 << dsh, Ld = 8192 >> dsh;
            const int pi0 = run * 8, r = pi0 / Ld, m0 = pi0 % Ld;
            float vv[8][8];
#pragma unroll
            for (int j = 0; j < 8; ++j) { const int tok = r + d * (m0 + j); unpack8(*(const u32x4*)(KVRAW + (size_t)(b * 8192 + tok) * 1536 + 768 + gk * 64 + ddc * 8), vv[j]); }
#pragma unroll
            for (int i = 0; i < 8; ++i) { float t[8];
#pragma unroll
                for (int j = 0; j < 8; ++j) t[j] = vv[j][i];
                *(u32x4*)(VT + ((size_t)(b * 12 + gk) * 64 + ddc * 8 + i) * 8192 + pi0) = pack8(t); }
        }
    }
}

constexpr size_t WS_PART = WS_XT;
constexpr size_t WS_LPART = WS_ZB + 33 * MiB;
__device__ __forceinline__ void attn_unit_decode(int gi, int x, int& b, int& kh, int& r, int& M0) {
    b = x >> 8; kh = (x >> 6) & 3; const int rb = x & 63, bpr = 64 >> (2 * gi);
    r = rb / bpr; M0 = (rb % bpr) * 128;
}
__device__ __forceinline__ void attn_stage(const Ctx& C, int gi, int x, LAS unsigned char* buf) {
    int b, kh, r, M0; attn_unit_decode(gi, x, b, kh, r, M0);
    const int dsh = 2 * gi, d = 1 << dsh, Ld = 8192 >> dsh, tid = C.tid;
    const bf16* kbase = (const bf16*)(C.ws + WS_KN) + (size_t)b * 8192 * 768 + gi * 256 + kh * 64;
    const bf16* vbase = (const bf16*)(C.ws + WS_VT) + ((size_t)(b * 12 + gi * 4 + kh) * 64) * 8192 + r * Ld;
    const unsigned wbase = (unsigned)(tid & ~63) * 16u;
#pragma unroll
    for (int i = 0; i < 4; ++i) { const int id = i * 512 + tid, row = id >> 3, c = id & 7; int m = M0 - 128 + row; m = m < 0 ? 0 : m;
        __builtin_amdgcn_global_load_lds((const unsigned*)(kbase + (size_t)(r + d * m) * 768 + ((c ^ ((row >> 1) & 7)) * 8)), (LAS unsigned*)(buf + i * 8192 + wbase), 16, 0, 0); }
#pragma unroll
    for (int i = 0; i < 4; ++i) { const int id = i * 512 + tid, row = id >> 5, c = id & 31; int p0 = M0 - 128 + ((c ^ (row & 15)) * 8); p0 = p0 < 0 ? 0 : p0;
        __builtin_amdgcn_global_load_lds((const unsigned*)(vbase + (size_t)row * 8192 + p0), (LAS unsigned*)(buf + 32768 + i * 8192 + wbase), 16, 0, 0); }
}

template <int GI0>
__device__ __forceinline__ void attn_band_phase(const Ctx& C, int j, unsigned pf_) {
    unsigned char* ws = C.ws;
    const int NU = GI0 ? 1024 : 512;
    const bf16* Q = (const bf16*)(ws + WS_Q); const bf16* GATE = (const bf16*)(ws + WS_GATE); bf16* OB = (bf16*)(ws + WS_OB);
    bf16* PART = (bf16*)(ws + WS_PART); float* LPART = (float*)(ws + WS_LPART);
    const float* ropec = (const float*)(ws + WS_ROPEC); const float* ropes = (const float*)(ws + WS_ROPES); const float* qnw = C.in[22] + j * 64;
    const int lane = C.lane, w = C.wave, fr = lane & 15, fq = lane >> 4, rep = w & 3, half = w >> 2;
    float cshift; { const float mq = wave_max(fabsf(qnw[lane])), mk = wave_max(fabsf(C.in[20][lane])); cshift = 8.f * mq * mk * 1.4426950408889634f; }
    __syncthreads();
    int u = C.vcu, bsel = 0;
    if (u < NU) attn_stage(C, GI0 ? 1 + (u >> 9) : 0, u & 511, C.lds);
#pragma unroll 1
    for (; u < NU; u += C.G, bsel ^= 1) {
        const int gi = GI0 ? 1 + (u >> 9) : 0; int b, kh, r, M0; attn_unit_decode(gi, u & 511, b, kh, r, M0);
        const int dsh = 2 * gi, d = 1 << dsh, head = kh * 4 + rep;
        LAS unsigned char* Kl = C.lds + bsel * 65536; LAS unsigned char* Vl = Kl + 32768;
        asm volatile("s_waitcnt vmcnt(0)" ::: "memory");
        __syncthreads();
        if (u + C.G < NU) attn_stage(C, GI0 ? 1 + ((u + C.G) >> 9) : 0, (u + C.G) & 511, C.lds + (bsel ^ 1) * 65536);
        if ((pf_ & 1u) && u + C.G < NU) attn_stage(C, GI0 ? 1 + ((u + C.G) >> 9) : 0, (u + C.G) & 511, C.lds + (bsel ^ 1) * 65536);
        {
            bf16x8 qf[4][2];
#pragma unroll
            for (int qt = 0; qt < 4; ++qt) {
                const int t = r + d * (M0 + half * 64 + qt * 16 + fr);
                const bf16* src = Q + (size_t)(b * 8192 + t) * 3072 + gi * 1024 + head * 64 + 8 * fq;
                float x[16]; unpack8(*(const u32x4*)src, x); unpack8(*(const u32x4*)(src + 32), x + 8);
                float ss = 0.f;
#pragma unroll
                for (int e = 0; e < 16; ++e) ss += x[e] * x[e];
                ss += __shfl_xor(ss, 16); ss += __shfl_xor(ss, 32);
                const float rs = rsqrtf(ss * (1.f / 64.f) + EPS);
                float o1[8], o2[8];
#pragma unroll
                for (int e = 0; e < 8; ++e) { const float x1 = x[e] * rs * qnw[8 * fq + e], x2 = x[8 + e] * rs * qnw[32 + 8 * fq + e];
                    const float c = ropec[t * 32 + 8 * fq + e], s = ropes[t * 32 + 8 * fq + e];
                    o1[e] = (x1 * c - x2 * s) * (0.125f * 1.4426950408889634f); o2[e] = (x2 * c + x1 * s) * (0.125f * 1.4426950408889634f); }
                qf[qt][0] = __builtin_bit_cast(bf16x8, pack8(o1)); qf[qt][1] = __builtin_bit_cast(bf16x8, pack8(o2));
                __builtin_amdgcn_sched_barrier(0);
            }
            f32x4 O[4][4]; float lsum[4];
#pragma unroll 1
            for (int rc = 0; rc < 1 + (int)((pf_ >> 1) & 1u); ++rc) {
#pragma unroll
            for (int a = 0; a < 4; ++a) { lsum[a] = 0.f;
#pragma unroll
                for (int c = 0; c < 4; ++c) O[a][c] = (f32x4){0.f, 0.f, 0.f, 0.f}; }
            const int Q0 = M0 + half * 64;
#pragma unroll 1
            for (int sk = 0; sk < 6; ++sk) {
                const int Rb = half * 64 + sk * 32, klo = M0 - 128 + Rb;
                bf16x8 kf[2][2], vf[4];
#pragma unroll
                for (int t16 = 0; t16 < 2; ++t16) { const int row = Rb + t16 * 16 + fr; const int sw = (fr >> 1) & 7;
                    kf[t16][0] = *(LAS bf16x8*)(Kl + row * 128 + ((fq ^ sw) * 16)); kf[t16][1] = *(LAS bf16x8*)(Kl + row * 128 + (((fq + 4) ^ sw) * 16)); }
#pragma unroll
                for (int dt = 0; dt < 4; ++dt) { const int row = dt * 16 + fr, ch = (Rb >> 3) + (fq >> 1);
                    const u32x2 lo = *(LAS u32x2*)(Vl + row * 512 + ((ch ^ fr) * 16) + (fq & 1) * 8), hi = *(LAS u32x2*)(Vl + row * 512 + (((ch + 2) ^ fr) * 16) + (fq & 1) * 8);
                    vf[dt] = __builtin_bit_cast(bf16x8, (u32x4){lo.x, lo.y, hi.x, hi.y}); }
#pragma unroll
                for (int qt = 0; qt < 4; ++qt) {
                    const int qlo = Q0 + qt * 16;
                    if (klo > qlo + 15 || klo + 31 < qlo - 128 || klo + 31 < 0) continue;
                    const bool full = (klo + 31 <= qlo) && (klo >= qlo + 15 - 128) && (klo >= 0);
                    const int mq = qlo + fr, lo_k = (mq - 128) > 0 ? (mq - 128) : 0;
                    f32x4 s0 = (f32x4){0.f, 0.f, 0.f, 0.f}, s1 = s0;
                    s0 = MFMA16(kf[0][0], qf[qt][0], s0); s1 = MFMA16(kf[1][0], qf[qt][0], s1);
                    s0 = MFMA16(kf[0][1], qf[qt][1], s0); s1 = MFMA16(kf[1][1], qf[qt][1], s1);
                    float p0[4], p1[4];
#pragma unroll
                    for (int e = 0; e < 4; ++e) { p0[e] = __builtin_amdgcn_exp2f(s0[e] - cshift); p1[e] = __builtin_amdgcn_exp2f(s1[e] - cshift); }
                    if (!full) {
#pragma unroll
                        for (int e = 0; e < 4; ++e) { const int ka = klo + 4 * fq + e, kc = ka + 16;
                            p0[e] = (ka >= lo_k && ka <= mq) ? p0[e] : 0.f; p1[e] = (kc >= lo_k && kc <= mq) ? p1[e] : 0.f; }
                    }
                    lsum[qt] += ((p0[0] + p0[1]) + (p0[2] + p0[3])) + ((p1[0] + p1[1]) + (p1[2] + p1[3]));
                    const bf16x8 pf = __builtin_bit_cast(bf16x8, (u32x4){pk2(p0[0], p0[1]), pk2(p0[2], p0[3]), pk2(p1[0], p1[1]), pk2(p1[2], p1[3])});
#pragma unroll
                    for (int dt = 0; dt < 4; ++dt) O[qt][dt] = MFMA16(vf[dt], pf, O[qt][dt]);
                }
            }
            }
            __syncthreads();
            LAS unsigned char* Ow = Kl + w * 8192; LAS float* lw = (LAS float*)(C.lds + 131072) + w * 64;
#pragma unroll
            for (int qt = 0; qt < 4; ++qt) {
                float l = lsum[qt]; l += __shfl_xor(l, 16); l += __shfl_xor(l, 32);
                if (fq == 0) lw[qt * 16 + fr] = l;
                const int row = qt * 16 + fr;
#pragma unroll
                for (int dt = 0; dt < 4; ++dt) { u32x2 o; o.x = pk2(O[qt][dt][0], O[qt][dt][1]); o.y = pk2(O[qt][dt][2], O[qt][dt][3]);
                    *(LAS u32x2*)(Ow + row * 128 + (((dt * 2 + (fq >> 1)) ^ (fr & 7)) * 16) + (fq & 1) * 8) = o; }
            }
            asm volatile("s_waitcnt lgkmcnt(0)" ::: "memory");
#pragma unroll 1
            for (int re = 0; re < 1 + (int)((pf_ >> 2) & 1u); ++re)
#pragma unroll
            for (int i = 0; i < 8; ++i) {
                const int row = i * 8 + (lane >> 3), c = lane & 7;
                const u32x4 ov = *(LAS u32x4*)(Ow + row * 128 + ((c ^ (row & 7)) * 16));
                const int t = r + d * (M0 + half * 64 + row);
                const size_t tok = (size_t)(b * 8192 + t), off = tok * 1024 + head * 64 + c * 8;
                if (GI0) {
                    *(u32x4*)(PART + (size_t)(gi - 1) * TP * 1024 + off) = ov;
                    if (c == 0) LPART[(size_t)(gi - 1) * TP * 16 + tok * 16 + head] = lw[row];
                } else {
                    const u32x4 a1 = *(const u32x4*)(PART + off), a2 = *(const u32x4*)(PART + (size_t)TP * 1024 + off), gr = *(const u32x4*)(GATE + off);
                    const float li = 1.f / (lw[row] + LPART[tok * 16 + head] + LPART[(size_t)TP * 16 + tok * 16 + head]);
                    float o8[8], x1[8], x2[8], g8[8]; unpack8(ov, o8); unpack8(a1, x1); unpack8(a2, x2); unpack8(gr, g8);
#pragma unroll
                    for (int e = 0; e < 8; ++e) o8[e] = (o8[e] + x1[e] + x2[e]) * li * silu_f(g8[e]);
                    *(u32x4*)(OB + off) = pack8(o8);
                }
            }
        }
    }
    asm volatile("s_waitcnt vmcnt(0)" ::: "memory");
    __syncthreads();
}

__device__ __forceinline__ void attn_sample_task(const Ctx& C, int j, int task, LAS float* wl) {
    unsigned char* ws = C.ws;
    const int t = task & 7, kh = (task >> 3) & 3, sb = task >> 5, lane = C.lane;
    const int row = TP + sb * 8 + t, pos = 8192 + t;
    const bf16* Q = (const bf16*)(ws + WS_Q); const bf16* GATE = (const bf16*)(ws + WS_GATE); bf16* OB = (bf16*)(ws + WS_OB);
    const float* KSS = (const float*)(ws + WS_KSS); const float* VSS = (const float*)(ws + WS_VSS);
    const float* ropec = (const float*)(ws + WS_ROPEC); const float* ropes = (const float*)(ws + WS_ROPES);
    const float* qnw = C.in[22] + j * 64;
    LAS float* qs = wl;
    LAS float* sc = wl + 768;
    const float cr = ropec[pos * 32 + (lane & 31)], sr = ropes[pos * 32 + (lane & 31)], wq = qnw[lane];
#pragma unroll
    for (int gi = 0; gi < 3; ++gi)
#pragma unroll
        for (int rep = 0; rep < 4; ++rep) {
            const float q = bf1(Q[(size_t)row * 3072 + gi * 1024 + (kh * 4 + rep) * 64 + lane]);
            const float ss = wave_sum(q * q);
            const float qn = q * rsqrtf(ss * (1.f / 64.f) + EPS) * wq;
            const float pr = __shfl_xor(qn, 32);
            const float o = (lane < 32) ? qn * cr - pr * sr : qn * cr + pr * sr;
            qs[(gi * 4 + rep) * 64 + lane] = o * 0.125f;
        }
    asm volatile("s_waitcnt lgkmcnt(0)" ::: "memory");
    const int kq = lane >> 4, c16 = lane & 15;
#pragma unroll 1
    for (int gi = 0; gi < 3; ++gi) {
        const int W = (gi == 0) ? 128 : (gi == 1) ? 512 : 2048, d = 1 << (2 * gi);
        const float* cache = C.in[4 + gi];
        f32x4 q4[4];
#pragma unroll
        for (int rep = 0; rep < 4; ++rep) q4[rep] = *(LAS f32x4*)(qs + (gi * 4 + rep) * 64 + 4 * c16);
#pragma unroll 1
        for (int it0 = 0; it0 < 33; it0 += 11) {
          f32x4 kv[11];
#pragma unroll
          for (int u = 0; u < 11; ++u) {
            int jj = (it0 + u) * 4 + kq; jj = jj <= 128 ? jj : 128;
            const int idx = W + t - jj * d;
            const float* src = (idx >= W) ? KSS + (size_t)(sb * 8 + idx - W) * 768 + gi * 256 + kh * 64 : cache + ((size_t)(sb * W + idx) * 2) * 256 + kh * 64;
            kv[u] = *(const f32x4*)(src + 4 * c16);
          }
#pragma unroll
          for (int u = 0; u < 11; ++u) {
            int jj = (it0 + u) * 4 + kq; const bool ok = jj <= 128; jj = ok ? jj : 128;
            const f32x4 k4 = kv[u];
            float mine = 0.f;
#pragma unroll
            for (int rep = 0; rep < 4; ++rep) {
                float s = (k4[0] * q4[rep][0] + k4[1] * q4[rep][1]) + (k4[2] * q4[rep][2] + k4[3] * q4[rep][3]);
                s += __shfl_xor(s, 1); s += __shfl_xor(s, 2); s += __shfl_xor(s, 4); s += __shfl_xor(s, 8);
                if (c16 == rep) mine = s;
            }
            if (c16 < 4 && ok) sc[(gi * 4 + c16) * 132 + jj] = mine;
          }
        }
    }
    asm volatile("s_waitcnt lgkmcnt(0)" ::: "memory");
    float linv[4];
#pragma unroll
    for (int rep = 0; rep < 4; ++rep) {
        float m = -3.0e38f;
#pragma unroll
        for (int gi = 0; gi < 3; ++gi)
            for (int jj = lane; jj <= 128; jj += 64) m = fmaxf(m, sc[(gi * 4 + rep) * 132 + jj]);
        m = wave_max(m);
        float sum = 0.f;
#pragma unroll
        for (int gi = 0; gi < 3; ++gi)
            for (int jj = lane; jj <= 128; jj += 64) { const float p = __expf(sc[(gi * 4 + rep) * 132 + jj] - m); sc[(gi * 4 + rep) * 132 + jj] = p; sum += p; }
        sum = wave_sum(sum);
        linv[rep] = 1.f / sum;
    }
    asm volatile("s_waitcnt lgkmcnt(0)" ::: "memory");
    f32x4 o[4];
#pragma unroll
    for (int rep = 0; rep < 4; ++rep) o[rep] = (f32x4){0.f, 0.f, 0.f, 0.f};
#pragma unroll 1
    for (int gi = 0; gi < 3; ++gi) {
        const int W = (gi == 0) ? 128 : (gi == 1) ? 512 : 2048, d = 1 << (2 * gi);
        const float* cache = C.in[4 + gi];
#pragma unroll 1
        for (int it0 = 0; it0 < 33; it0 += 11) {
          f32x4 vv[11];
#pragma unroll
          for (int u = 0; u < 11; ++u) {
            int jj = (it0 + u) * 4 + kq; jj = jj <= 128 ? jj : 128;
            const int idx = W + t - jj * d;
            const float* src = (idx >= W) ? VSS + (size_t)(sb * 8 + idx - W) * 768 + gi * 256 + kh * 64 : cache + ((size_t)(sb * W + idx) * 2 + 1) * 256 + kh * 64;
            vv[u] = *(const f32x4*)(src + 4 * c16);
          }
#pragma unroll
          for (int u = 0; u < 11; ++u) {
            int jj = (it0 + u) * 4 + kq; const bool ok = jj <= 128; jj = ok ? jj : 128;
            const f32x4 v4 = vv[u];
#pragma unroll
            for (int rep = 0; rep < 4; ++rep) { const float p = ok ? sc[(gi * 4 + rep) * 132 + jj] : 0.f; o[rep] += v4 * p; }
          }
        }
    }
#pragma unroll
    for (int rep = 0; rep < 4; ++rep)
#pragma unroll
        for (int e = 0; e < 4; ++e) { float v = o[rep][e]; v += __shfl_xor(v, 16); v += __shfl_xor(v, 32); o[rep][e] = v; }
    {
        f32x4 mine = o[0]; float li = linv[0];
#pragma unroll
        for (int rep = 1; rep < 4; ++rep) if (kq == rep) { mine = o[rep]; li = linv[rep]; }
        const size_t off = (size_t)row * 1024 + (kh * 4 + kq) * 64 + 4 * c16;
        const u32x2 gr = *(const u32x2*)(GATE + off);
        u32x2 w; w.x = pk2(mine[0] * li * silu_f(bflo(gr.x)), mine[1] * li * silu_f(bfhi(gr.x))); w.y = pk2(mine[2] * li * silu_f(bflo(gr.y)), mine[3] * li * silu_f(bfhi(gr.y)));
        *(u32x2*)(OB + off) = w;
    }
    asm volatile("s_waitcnt lgkmcnt(0)" ::: "memory");
}

constexpr int N_PHASES = 35;
#ifndef PH_MASK
#define PH_MASK 0xFFFFFFu
#endif
#define PHK(k) (((PH_MASK) >> (k)) & 1u)
#ifndef DUP_MASK
#define DUP_MASK 0ull
#endif
#ifndef MK_LAUNCH_PER_PHASE
#define MK_LAUNCH_PER_PHASE 0
#endif

__device__ __forceinline__ Ctx make_ctx(const Args& args, LAS unsigned char* lds) {
    Ctx C; int t = threadIdx.x; asm volatile("" : "+v"(t));
    int bx = blockIdx.x, G = gridDim.x; asm volatile("" : "+s"(bx), "+s"(G));
    C.lds = lds; C.tid = t; C.lane = t & 63; C.wave = __builtin_amdgcn_readfirstlane(t >> 6);
    C.G = G; C.vcu = (G % 8 == 0) ? (bx % 8) * (G / 8) + bx / 8 : bx;
    C.gw = C.vcu * 8 + C.wave; C.ngw = G * 8;
    C.in = args.in; C.out = args.out; C.ws = args.ws;
    return C;
}
template <class Epi> __device__ __forceinline__ void run_gemm(const Ctx& C, const bf16* A, const bf16* Bt, int N, int K, const Epi& E, int M = TT) {
    asm volatile("" : "+s"(K), "+s"(N), "+s"(M));
    pg8::Gemm g{A, Bt, M, N, K}; pg8::StaticOrder S; S.init(M, N, C.G, (int)blockIdx.x);
    pg8::gemm_phase<Epi, pg8::StaticOrder, true, true>(C.lds, g, S, E);
}

__global__ void __launch_bounds__(512, 2) mk_fwd(Args args) {
    extern __shared__ __attribute__((aligned(16))) unsigned char lds_raw[];
    LAS unsigned char* const ldsb = (LAS unsigned char*)lds_raw;
    for (int u = threadIdx.x; u < (LDS_BYTES - RING_BYTES) / 4; u += 512) ((LAS unsigned*)(ldsb + RING_BYTES))[u] = 0u;
    __syncthreads();
    const int lo = args.ph_lo, hi = args.ph_hi;
    if (hi - lo > 1) (void)xcd_barrier_post((unsigned*)(args.ws + WS_CTL) + CW_BAR, (volatile LAS unsigned*)(ldsb + MISC_OFF) + 8);
    for (int ph = lo; ph < hi; ++ph) {
        bool need_bar = true;
        const int nrep = 1 + (int)((args.dup >> ph) & 1ull);
#pragma unroll 1
        for (int rep = 0; rep < nrep; ++rep) {
        const Ctx C = make_ctx(args, ldsb);
        unsigned char* ws = C.ws;
        float* H = C.out; float* SSQ = (float*)(ws + WS_SSQ);
        bf16* HB0 = (bf16*)(ws + WS_HB); bf16* HB1 = (bf16*)(ws + WS_OB);
        bf16* PBUF[2] = {(bf16*)(ws + WS_PBUFA), (bf16*)(ws + WS_PBUFB)};
        bf16* PP = (bf16*)(ws + WS_PP);
        float* Hw = rep ? (float*)(ws + WS_ZB) : H; bf16* HB0w = rep ? (bf16*)(ws + WS_XT) : HB0; bf16* HB1w = rep ? (bf16*)(ws + WS_XT) : HB1; float* SSQd = SSQ + (size_t)8 * TT;
        if (ph == 0) { if (PHK(0)) {
            const Ctx& Cp = C; p0_prologue(Cp);
            convert_p(Cp, 0, PBUF[0]);  }
        } else if (ph < 19) {
            const int i = (ph - 1) / 9, sub = (ph - 1) % 9;
            if (sub == 0) { if (PHK(1)) {
                EpiSplit<2048, 5120, 5120, 2048, 3072, 3072, true> E{SSQ + (size_t)(2 * i) * TT, (bf16*)(ws + WS_ZB), (bf16*)(ws + WS_XBC), nullptr, (float*)(ws + WS_DTRAW)};
                run_gemm(C, HB1, (const bf16*)(ws + (i ? WS_WIN1 : WS_WIN0)), MINP, 1024, E);  }
            } else if (sub == 1) { if (PHK(2)) {
                const Ctx& Cp = C; p2_conv(Cp, i);
                convert_p(Cp, i + 1, PBUF[(i + 1) & 1]);  }
            } else if (sub == 2) { need_bar = false; if (PHK(3)) {
                const Ctx& Cp = C; LAS float* wl = (LAS float*)(Cp.lds + Cp.wave * 16384);
                for (int task = Cp.gw; task < 1024; task += Cp.ngw) ssd_sample_task(Cp, i, task >> 5, task & 31, wl);  }
            } else if (sub == 3) { if (PHK(14)) {
                const Ctx& Cp = C; for (int task = Cp.ngw - 1 - Cp.gw; task < 4096; task += Cp.ngw) s1_task(Cp, task >> 5, task & 31);  }
            } else if (sub == 4) { if (PHK(4)) {
                const Ctx& Cp = C; s2_scan(Cp, i, rep);
                sample_norm(Cp);  }
            } else if (sub == 5) { if (PHK(5)) {
                const Ctx& Cp = C; for (int unit = Cp.vcu; unit < 512; unit += Cp.G) s3_unit(Cp, i, unit >> 2, unit & 3);  }
            } else if (sub == 6) { need_bar = false; if (PHK(6)) {
                EpiRes<0> E{H, HB0w, rep ? SSQd : SSQ + (size_t)(2 * i + 1) * TT, nullptr, nullptr, Hw};
                run_gemm(C, (const bf16*)(ws + WS_YB), (const bf16*)(ws + (i ? WS_WOUT1 : WS_WOUT0)), 1024, 2048, E, TP);
                side_gemm<0>(C, (const bf16*)(ws + WS_YB), (const bf16*)(ws + (i ? WS_WOUT1 : WS_WOUT0)), 2048, H, Hw, HB0w, E.ssq_out, nullptr, nullptr, nullptr); }
            } else if (sub == 7) { if (PHK(15)) {
                EpiPlain E2{PP, 1024};
                run_gemm(C, PBUF[i & 1], (const bf16*)(ws + WS_WP0 + (size_t)i * 512 * 1024), 1024, 256, E2, TP);
                side_gemm<2>(C, PBUF[i & 1], (const bf16*)(ws + WS_WP0 + (size_t)i * 512 * 1024), 256, nullptr, nullptr, nullptr, nullptr, nullptr, nullptr, PP); }
            } else { if (PHK(7)) {
                EpiRes<1> E{H, HB1w, rep ? SSQd : SSQ + (size_t)(2 * i + 2) * TT, SSQ + (size_t)(2 * i + 1) * TT, PP, Hw};
                run_gemm(C, HB0, (const bf16*)(ws + WS_WG0 + (size_t)i * 2 * MiB), 1024, 1024, E, TP);
                side_gemm<1>(C, HB0, (const bf16*)(ws + WS_WG0 + (size_t)i * 2 * MiB), 1024, H, Hw, HB1w, E.ssq_out, E.ssq_in, PP, nullptr); }
            }
        } else {
            const int j = (ph - 19) / 8, sub = (ph - 19) % 8, l = 2 + j;
            if (sub == 0) {
                if (j == 0) { if (PHK(8)) {
                    EpiSplit<1536, 4608, 5632, 1536, 3072, 1024, false> E{SSQ + (size_t)4 * TT, (bf16*)(ws + WS_KVRAW), (bf16*)(ws + WS_Q), (bf16*)(ws + WS_GATE), nullptr};
                    run_gemm(C, HB1, (const bf16*)(ws + WS_WKVA), 5632, 1024, E);  }
                } else { if (PHK(9)) {
                    EpiSplit<3072, 4096, 4096, 3072, 1024, 1024, false> E{SSQ + (size_t)6 * TT, (bf16*)(ws + WS_Q), (bf16*)(ws + WS_GATE), nullptr, nullptr};
                    run_gemm(C, HB1, (const bf16*)(ws + WS_WAIN1), 4096, 1024, E);  }
                }
            } else if (sub == 1) {
                if (j == 0) { if (PHK(10)) { const Ctx& Cp = C; p9_kvpass(Cp); convert_p(Cp, 3, PBUF[1]);  } } else need_bar = false;
            } else if (sub == 2) { need_bar = false; if (PHK(11)) {
                const Ctx& Cp = C; LAS float* wl = (LAS float*)(Cp.lds + Cp.wave * 16384);
                for (int task = Cp.gw; task < 1024; task += Cp.ngw) attn_sample_task(Cp, j, task, wl);  }
            } else if (sub == 3) { if (PHK(16)) {
                const Ctx& Cp = C; attn_band_phase<1>(Cp, j, (unsigned)(args.dup >> 60) & 7u); }
            } else if (sub == 4) { if (PHK(17)) {
                const Ctx& Cp = C; attn_band_phase<0>(Cp, j, (unsigned)(args.dup >> 60) & 7u); }
            } else if (sub == 5) { need_bar = false; if (PHK(12)) {
                EpiRes<0> E{H, HB0w, rep ? SSQd : SSQ + (size_t)(2 * l + 1) * TT, nullptr, nullptr, Hw};
                run_gemm(C, (const bf16*)(ws + WS_OB), (const bf16*)(ws + (j ? WS_WAOUT1 : WS_WAOUT0)), 1024, 1024, E, TP);
                side_gemm<0>(C, (const bf16*)(ws + WS_OB), (const bf16*)(ws + (j ? WS_WAOUT1 : WS_WAOUT0)), 1024, H, Hw, HB0w, E.ssq_out, nullptr, nullptr, nullptr); }
            } else if (sub == 6) { if (PHK(15)) {
                EpiPlain E2{PP, 1024};
                run_gemm(C, PBUF[l & 1], (const bf16*)(ws + WS_WP0 + (size_t)l * 512 * 1024), 1024, 256, E2, TP);
                side_gemm<2>(C, PBUF[l & 1], (const bf16*)(ws + WS_WP0 + (size_t)l * 512 * 1024), 256, nullptr, nullptr, nullptr, nullptr, nullptr, nullptr, PP); }
            } else { if (PHK(13)) {
                EpiRes<1> E{H, HB1w, rep ? SSQd : ((l < 3) ? SSQ + (size_t)(2 * l + 2) * TT : nullptr), SSQ + (size_t)(2 * l + 1) * TT, PP, Hw};
                run_gemm(C, HB0, (const bf16*)(ws + WS_WG0 + (size_t)l * 2 * MiB), 1024, 1024, E, TP);
                side_gemm<1>(C, HB0, (const bf16*)(ws + WS_WG0 + (size_t)l * 2 * MiB), 1024, H, Hw, HB1w, E.ssq_out, E.ssq_in, PP, nullptr); }
            }
        }
        }
        if (ph + 1 < hi && need_bar) { XcdBarrier bar; bar.bar = (unsigned*)(args.ws + WS_CTL) + CW_BAR; bar.x = xb_xcc_id(); bar.st = (volatile LAS unsigned*)(ldsb + MISC_OFF) + 8; xcd_barrier(bar); if (args.dup >> 63) xcd_barrier(bar); }
    }
}

extern "C" void kernel_launch(void* const* d_in, const int* in_sizes, int n_in, void* d_out, int out_size, void* d_ws, size_t ws_size, hipStream_t stream) {
    static int grid = 0;
    if (grid == 0) {
        int dev = 0, cus = 0;
        if (n_in != 27 || ws_size < WS_END) { fprintf(stderr, "kernel_launch: unexpected n_in %d or ws_size %zu\n", n_in, ws_size); grid = -1; return; }
        if (hipGetDevice(&dev) != hipSuccess || hipDeviceGetAttribute(&cus, hipDeviceAttributeMultiprocessorCount, dev) != hipSuccess) { grid = -1; return; }
        if (hipFuncSetAttribute((const void*)mk_fwd, hipFuncAttributeMaxDynamicSharedMemorySize, LDS_BYTES) != hipSuccess) { grid = -1; return; }
        grid = cus;
    }
    if (grid < 0) return;
    (void)hipMemsetAsync((char*)d_ws + WS_CTL, 0, WS_ZERO_BYTES, stream);
    Args a{};
    for (int i = 0; i < 27; ++i) a.in[i] = (const float*)d_in[i];
    a.out = (float*)d_out; a.ws = (unsigned char*)d_ws; a.dup = (unsigned long long)(DUP_MASK);
#if MK_LAUNCH_PER_PHASE
    for (int ph = 0; ph < N_PHASES; ++ph) { a.ph_lo = ph; a.ph_hi = ph + 1; hipLaunchKernelGGL(mk_fwd, dim3(grid), dim3(512), LDS_BYTES, stream, a); }
#else
    a.ph_lo = 0; a.ph_hi = N_PHASES;
    hipLaunchKernelGGL(mk_fwd, dim3(grid), dim3(512), LDS_BYTES, stream, a);
#endif
}
```

```cpp
#include <hip/hip_runtime.h>
#include <cstdio>
#include <cstdint>

#define LAS __attribute__((address_space(3)))
#define RLX_AGENT __ATOMIC_RELAXED, __HIP_MEMORY_SCOPE_AGENT
typedef unsigned short bf16;
typedef float f32x4 __attribute__((ext_vector_type(4)));
typedef float f32x2 __attribute__((ext_vector_type(2)));
typedef unsigned u32x4 __attribute__((ext_vector_type(4)));
typedef unsigned u32x2 __attribute__((ext_vector_type(2)));
typedef short bf16x8 __attribute__((ext_vector_type(8)));
typedef __bf16 bf16x2_t __attribute__((ext_vector_type(2)));

__device__ __forceinline__ unsigned pk2(float lo, float hi) { f32x2 v = {lo, hi}; bf16x2_t b = __builtin_convertvector(v, bf16x2_t); return __builtin_bit_cast(unsigned, b); }
__device__ __forceinline__ float bflo(unsigned u) { return __uint_as_float(u << 16); }
__device__ __forceinline__ float bfhi(unsigned u) { return __uint_as_float(u & 0xffff0000u); }
__device__ __forceinline__ float bf1(bf16 h) { return __uint_as_float(((unsigned)h) << 16); }
__device__ __forceinline__ void unpack8(const u32x4 v, float* f) { f[0] = bflo(v.x); f[1] = bfhi(v.x); f[2] = bflo(v.y); f[3] = bfhi(v.y); f[4] = bflo(v.z); f[5] = bfhi(v.z); f[6] = bflo(v.w); f[7] = bfhi(v.w); }
__device__ __forceinline__ u32x4 pack8(const float* f) { u32x4 v; v.x = pk2(f[0], f[1]); v.y = pk2(f[2], f[3]); v.z = pk2(f[4], f[5]); v.w = pk2(f[6], f[7]); return v; }
__device__ __forceinline__ float silu_f(float x) { return x / (1.f + __expf(-x)); }
__device__ __forceinline__ float sigmoid_f(float x) { return 1.f / (1.f + __expf(-x)); }
__device__ __forceinline__ float softplus_f(float x) { return x > 20.f ? x : log1pf(__expf(x)); }
__device__ __forceinline__ float wave_sum(float v) {
#pragma unroll
    for (int o = 1; o < 64; o <<= 1) v += __shfl_xor(v, o);
    return v;
}
__device__ __forceinline__ float wave_max(float v) {
#pragma unroll
    for (int o = 1; o < 64; o <<= 1) v = fmaxf(v, __shfl_xor(v, o));
    return v;
}

#define XB_TMO      128
#define XB_XCNT(j)  (256  + 64 * (j))
#define XB_XSUB(j)  (1280 + 64 * (j))
#define XB_XGEN(j)  (2304 + 64 * (j))
#define XB_TOP      3328
#define XB_TOPGEN   3392
#define XCD_BAR_WORDS 3456
#define XB_SPIN_CAP (1u << 18)

__device__ __forceinline__ unsigned xb_ld(unsigned* p)              { return __hip_atomic_load(p, __ATOMIC_RELAXED, __HIP_MEMORY_SCOPE_AGENT); }
__device__ __forceinline__ unsigned xb_add(unsigned* p, unsigned v) { return __hip_atomic_fetch_add(p, v, __ATOMIC_RELAXED, __HIP_MEMORY_SCOPE_AGENT); }
__device__ __forceinline__ unsigned xb_xcc_id() { return (unsigned)__builtin_amdgcn_s_getreg((3 << 11) | 20) & 0xFu; }
#define XB_SPIN(cond, bar) do { unsigned _sp = 0; while (cond) { __builtin_amdgcn_s_sleep(1); \
    if ((++_sp & 255u) == 0u) { if (xb_ld(&(bar)[XB_TMO])) break; if (_sp > XB_SPIN_CAP) { atomicAdd(&(bar)[XB_TMO], 1u); break; } } } } while (0)

struct XcdBarrier { unsigned* bar; unsigned x; volatile LAS unsigned* st; };

__device__ __forceinline__ XcdBarrier xcd_barrier_post(unsigned* bar, volatile LAS unsigned* st) {
    XcdBarrier b; b.bar = bar; b.x = xb_xcc_id(); b.st = st;
    if (threadIdx.x == 0) (void)xb_add(&bar[XB_XCNT(b.x)], 1u);
    return b;
}
__device__ __forceinline__ void xcd_barrier_complete(unsigned* bar, unsigned x, unsigned& nloc, unsigned& nx) {
    const unsigned G = gridDim.x * gridDim.y * gridDim.z;
    unsigned sum, cnt, mine, sp = 0u;
    for (;;) {
        sum = 0u; cnt = 0u; mine = 0u;
#pragma unroll
        for (unsigned j = 0; j < 16; ++j) { const unsigned c = xb_ld(&bar[XB_XCNT(j)]); sum += c; cnt += (c > 0u) ? 1u : 0u; mine = (j == x) ? c : mine; }
        if (sum == G) break;
        __builtin_amdgcn_s_sleep(1);
        if ((++sp & 255u) == 0u) { if (xb_ld(&bar[XB_TMO])) break; if (sp > XB_SPIN_CAP) { atomicAdd(&bar[XB_TMO], 1u); break; } }
    }
    nloc = mine > 0u ? mine : 1u; nx = cnt > 0u ? cnt : 1u;
}
__device__ __forceinline__ void xcd_barrier(const XcdBarrier& b) {
    asm volatile("s_waitcnt vmcnt(0)" ::: "memory");
    __syncthreads();
    if (threadIdx.x == 0) {
        unsigned* bar = b.bar;
        __builtin_amdgcn_s_waitcnt(0);
        unsigned nloc = b.st[0], nx = b.st[1];
        if (nloc == 0u) { xcd_barrier_complete(bar, b.x, nloc, nx); b.st[0] = nloc; b.st[1] = nx; }
        const unsigned old = xb_add(&bar[XB_XSUB(b.x)], 1u);
        const unsigned gen = old / nloc;
        if (old + 1u == (gen + 1u) * nloc) {
            __builtin_amdgcn_fence(__ATOMIC_RELEASE, "agent");
            asm volatile("s_waitcnt vmcnt(0)" ::: "memory");
            const unsigned og = xb_add(&bar[XB_TOP], 1u);
            const unsigned tg = og / nx;
            if (og + 1u == (tg + 1u) * nx) xb_add(&bar[XB_TOPGEN], 1u);
            else XB_SPIN(xb_ld(&bar[XB_TOPGEN]) == tg, bar);
            __builtin_amdgcn_fence(__ATOMIC_ACQUIRE, "agent");
            xb_add(&bar[XB_XGEN(b.x)], 1u);
            asm volatile("s_waitcnt vmcnt(0)" ::: "memory");
        } else {
            XB_SPIN(xb_ld(&bar[XB_XGEN(b.x)]) == gen, bar);
            __builtin_amdgcn_fence(__ATOMIC_ACQUIRE, "agent");
            asm volatile("s_waitcnt vmcnt(0)" ::: "memory");
        }
    }
    __syncthreads();
}
namespace pg8 {
#define PG8_LAS __attribute__((address_space(3)))
typedef unsigned short bf16_t;
typedef short bf16x8 __attribute__((ext_vector_type(8)));
typedef float f32x4 __attribute__((ext_vector_type(4)));
typedef unsigned u32x4 __attribute__((ext_vector_type(4)));
constexpr int BM = 256, BK = 64, HALF = 128, HTB = HALF * BK * 2  , STAGE_BYTES = 8 * HTB, NXCD = 8, WGM = 8;

__host__ __device__ __forceinline__ int lds_byte(int r, int c) { const int st = (r >> 4) * 2 + (c >> 5), rr = r & 15, cc = c & 31, ob = rr * 64 + cc * 2; return st * 1024 + (ob ^ (((ob >> 9) & 1) << 5)); }
__host__ __device__ __forceinline__ void stage_rc(int b, int& R, int& C) { const int st = b / 1024, sb = b % 1024, swz = sb ^ (((sb >> 9) & 1) << 5); R = (st >> 1) * 16 + swz / 64; C = (st & 1) * 32 + (swz % 64) / 2; }
__host__ __device__ __forceinline__ int perm32(int rho) { const int n = rho >> 4, i = rho & 15; return 8 * (i >> 2) + 4 * n + (i & 3); }

struct Unit { int pm, pn; };
struct Gemm { const bf16_t* A; const bf16_t* Bt; int M, N, K; };

struct StaticOrder {
    int nM, nN, nwg, G, c;
    __host__ __device__ void init(int M, int N, int G_, int c_) { nM = M / BM; nN = N / BM; nwg = nM * nN; G = G_; c = c_; }
    __host__ __device__ bool next(int i, Unit& u) const {
        const long L = (long)i * G + c; if (L >= nwg) return false;
        int wgid = (int)L; { const int q = nwg / NXCD, r = nwg % NXCD, xcd = wgid % NXCD, off = wgid / NXCD; wgid = (xcd < r ? xcd * (q + 1) : r * (q + 1) + (xcd - r) * q) + off; }
        const int nig = WGM * nN, gid = wgid / nig, fm = gid * WGM, gsz = (nM - fm) < WGM ? (nM - fm) : WGM;
        u.pm = fm + ((wgid % nig) % gsz); u.pn = (wgid % nig) / gsz; return true;
    }
    __device__ __forceinline__ void a_ready(const Unit&) const {}
    __device__ __forceinline__ void done(const Unit&) const {}
};

template <class Epi, class Sched, bool ALIGN_EPI = false, bool SP2 = false>
__device__ __forceinline__ void gemm_phase(PG8_LAS unsigned char* lds, const Gemm g, const Sched& S, const Epi& E) {
    int tid_l = threadIdx.x; asm volatile("" : "+v"(tid_l));
    const int tid = tid_l, wid = __builtin_amdgcn_readfirstlane(tid >> 6), lane = tid & 63, wr = wid >> 2, wc = wid & 3, fr = lane & 15, fq = lane >> 4;
    const int K = g.K, nt = K / BK;
    unsigned voffA[2], voffB[2];
#pragma unroll
    for (int i = 0; i < 2; ++i) { int R, C; stage_rc(tid * 16 + i * 8192, R, C); const int Rb = Epi::PERM ? ((R & ~31) + perm32(R & 31)) : R;
        voffA[i] = (unsigned)(R * K + C) * 2u; voffB[i] = (unsigned)(Rb * K + C) * 2u; }
    const size_t kstep = (size_t)(BK * 2);
    const size_t hstep = (size_t)HALF * K * 2;
    const size_t tstep = 2 * hstep;
    const unsigned ldsw = (unsigned)wid * 1024u;
    const int aoff = lds_byte(wr * 64 + fr, fq * 8), boff = lds_byte(wc * 32 + fr, fq * 8);
#define PG8_SA(b, h) (((b) * 2 + (h)) * HTB)
#define PG8_SB(b, h) ((4 + (b) * 2 + (h)) * HTB)
#define PG8_STAGE(bufoff, gbase, voff) do { _Pragma("unroll") for (int _i = 0; _i < 2; ++_i) \
        __builtin_amdgcn_global_load_lds((const unsigned*)((const char*)(gbase) + (voff)[_i]), (PG8_LAS unsigned*)(lds + (bufoff) + ldsw + _i * 8192), 16, 0, 0); } while (0)
#define PG8_LDA(dst, b, h) do { _Pragma("unroll") for (int m = 0; m < 4; ++m) _Pragma("unroll") for (int k = 0; k < 2; ++k) dst[m][k] = *(const PG8_LAS bf16x8*)(lds + PG8_SA(b, h) + aoff + m * 2048 + k * 1024); } while (0)
#define PG8_LDB(dst, b, h) do { _Pragma("unroll") for (int n = 0; n < 2; ++n) _Pragma("unroll") for (int k = 0; k < 2; ++k) dst[n][k] = *(const PG8_LAS bf16x8*)(lds + PG8_SB(b, h) + boff + n * 2048 + k * 1024); } while (0)
#define PG8_MMA(ai, bj, At, Bt) do { __builtin_amdgcn_s_setprio(1); _Pragma("unroll") for (int m = 0; m < 4; ++m) _Pragma("unroll") for (int n = 0; n < 2; ++n) _Pragma("unroll") for (int k = 0; k < 2; ++k) \
        acc[ai][bj][m][n] = __builtin_amdgcn_mfma_f32_16x16x32_bf16(Bt[n][k], At[m][k], acc[ai][bj][m][n], 0, 0, 0); __builtin_amdgcn_s_setprio(0); } while (0)
#define PG8_WAIT_V(n) asm volatile("s_waitcnt vmcnt(" #n ")" ::: "memory")
#define PG8_WAIT_L(n) asm volatile("s_waitcnt lgkmcnt(" #n ")" ::: "memory")
#define PG8_BAR __builtin_amdgcn_s_barrier()
#define PG8_SCHED __builtin_amdgcn_sched_barrier(0)
    Unit cur, nxt; int ui = 0;
    if (!S.next(0, cur)) return;
    f32x4 acc[2][2][4][2];
#pragma unroll
    for (int a = 0; a < 2; ++a)
#pragma unroll
        for (int b = 0; b < 2; ++b)
#pragma unroll
            for (int m = 0; m < 4; ++m)
#pragma unroll
                for (int n = 0; n < 2; ++n) acc[a][b][m][n] = (f32x4){0.f, 0.f, 0.f, 0.f};
    bf16x8 At[4][2], B0[2][2], B1[2][2];
    const char* cA = (const char*)g.A + (size_t)cur.pm * tstep; const char* cB = (const char*)g.Bt + (size_t)cur.pn * tstep;
    S.a_ready(cur);
    if constexpr (SP2) {
        PG8_STAGE(PG8_SB(0, 0), cB, voffB); PG8_STAGE(PG8_SB(0, 1), cB + hstep, voffB); PG8_STAGE(PG8_SA(0, 0), cA, voffA); PG8_STAGE(PG8_SA(0, 1), cA + hstep, voffA);
        if (wr == 1) PG8_BAR;
        PG8_WAIT_V(2); PG8_BAR;
        PG8_STAGE(PG8_SB(1, 0), cB + kstep, voffB); PG8_STAGE(PG8_SA(1, 0), cA + kstep, voffA); PG8_STAGE(PG8_SB(1, 1), cB + hstep + kstep, voffB);
        PG8_WAIT_V(6); PG8_BAR;
    } else {
        PG8_STAGE(PG8_SB(0, 0), cB, voffB); PG8_STAGE(PG8_SA(0, 0), cA, voffA); PG8_STAGE(PG8_SB(0, 1), cB + hstep, voffB); PG8_STAGE(PG8_SA(0, 1), cA + hstep, voffA);
        if (wr == 1) PG8_BAR;
        PG8_WAIT_V(4); PG8_BAR;
        PG8_STAGE(PG8_SB(1, 0), cB + kstep, voffB); PG8_STAGE(PG8_SA(1, 0), cA + kstep, voffA); PG8_STAGE(PG8_SB(1, 1), cB + hstep + kstep, voffB);
        PG8_WAIT_V(6); PG8_BAR;
    }
    for (;;) {
        const bool has_next = S.next(ui + 1, nxt);
        const char* nA = has_next ? (const char*)g.A + (size_t)nxt.pm * tstep : cA; const char* nB = has_next ? (const char*)g.Bt + (size_t)nxt.pn * tstep : cB;
        for (int t = 0; t < nt; t += 2) {
            const bool last = (t == nt - 2);
            const char* a1 = cA + (size_t)(t + 1) * kstep;
            const char* a2 = last ? nA : cA + (size_t)(t + 2) * kstep; const char* b2 = last ? nB : cB + (size_t)(t + 2) * kstep;
            const char* a3 = a2 + kstep; const char* b3 = b2 + kstep;
            if (last && has_next) S.a_ready(nxt);
            if constexpr (SP2) {
            PG8_LDB(B0, 0, 0); PG8_LDB(B1, 0, 1); PG8_SCHED; PG8_LDA(At, 0, 0); PG8_STAGE(PG8_SA(1, 1), a1 + hstep, voffA);
            PG8_WAIT_V(8); PG8_WAIT_L(0); PG8_BAR; PG8_MMA(0, 0, At, B0); PG8_MMA(0, 1, At, B1); PG8_BAR; PG8_SCHED;
            PG8_LDA(At, 0, 1); PG8_STAGE(PG8_SB(0, 0), b2, voffB); PG8_STAGE(PG8_SB(0, 1), b2 + hstep, voffB); PG8_STAGE(PG8_SA(0, 0), a2, voffA);
            PG8_WAIT_V(8); PG8_WAIT_L(0); PG8_BAR; PG8_MMA(1, 0, At, B0); PG8_MMA(1, 1, At, B1); PG8_BAR; PG8_SCHED;
            PG8_LDB(B0, 1, 0); PG8_LDB(B1, 1, 1); PG8_SCHED; PG8_LDA(At, 1, 0); PG8_STAGE(PG8_SA(0, 1), a2 + hstep, voffA);
            PG8_WAIT_V(8); PG8_WAIT_L(0); PG8_BAR; PG8_MMA(0, 0, At, B0); PG8_MMA(0, 1, At, B1); PG8_BAR; PG8_SCHED;
            PG8_LDA(At, 1, 1); PG8_STAGE(PG8_SB(1, 0), b3, voffB); PG8_STAGE(PG8_SB(1, 1), b3 + hstep, voffB); PG8_STAGE(PG8_SA(1, 0), a3, voffA);
            PG8_WAIT_V(8); PG8_WAIT_L(0); PG8_BAR; PG8_MMA(1, 0, At, B0); PG8_MMA(1, 1, At, B1); PG8_BAR; PG8_SCHED;
            } else {
            PG8_LDB(B0, 0, 0); PG8_SCHED; PG8_LDA(At, 0, 0); PG8_STAGE(PG8_SA(1, 1), a1 + hstep, voffA);
            PG8_WAIT_L(8); PG8_BAR; PG8_WAIT_L(0); PG8_MMA(0, 0, At, B0); PG8_BAR; PG8_SCHED;
            PG8_LDB(B1, 0, 1); PG8_STAGE(PG8_SB(0, 0), b2, voffB);
            PG8_BAR; PG8_WAIT_L(0); PG8_MMA(0, 1, At, B1); PG8_BAR;
            PG8_LDA(At, 0, 1); PG8_STAGE(PG8_SA(0, 0), a2, voffA);
            PG8_BAR; PG8_WAIT_L(0); PG8_MMA(1, 0, At, B0); PG8_BAR; PG8_SCHED;
            PG8_STAGE(PG8_SB(0, 1), b2 + hstep, voffB);
            PG8_WAIT_V(6); PG8_BAR; PG8_MMA(1, 1, At, B1); PG8_BAR;
            PG8_LDB(B0, 1, 0); PG8_SCHED; PG8_LDA(At, 1, 0); PG8_STAGE(PG8_SA(0, 1), a2 + hstep, voffA);
            PG8_WAIT_L(8); PG8_BAR; PG8_WAIT_L(0); PG8_MMA(0, 0, At, B0); PG8_BAR; PG8_SCHED;
            PG8_LDB(B1, 1, 1); PG8_STAGE(PG8_SB(1, 0), b3, voffB);
            PG8_BAR; PG8_WAIT_L(0); PG8_MMA(0, 1, At, B1); PG8_BAR;
            PG8_LDA(At, 1, 1); PG8_STAGE(PG8_SA(1, 0), a3, voffA);
            PG8_BAR; PG8_WAIT_L(0); PG8_MMA(1, 0, At, B0); PG8_BAR; PG8_SCHED;
            PG8_STAGE(PG8_SB(1, 1), b3 + hstep, voffB);
            PG8_WAIT_V(6); PG8_BAR; PG8_MMA(1, 1, At, B1); PG8_BAR;
            }
        }
        if constexpr (ALIGN_EPI) { if (wr == 0) PG8_BAR; }
        if constexpr (!Epi::AFTER_DRAIN) { E(acc, cur, wr, wc, fr, fq); S.done(cur); }
        if (!has_next) break;
#pragma unroll
        for (int a = 0; a < 2; ++a)
#pragma unroll
            for (int b = 0; b < 2; ++b)
#pragma unroll
                for (int m = 0; m < 4; ++m)
#pragma unroll
                    for (int n = 0; n < 2; ++n) acc[a][b][m][n] = (f32x4){0.f, 0.f, 0.f, 0.f};
        cur = nxt; cA = nA; cB = nB; ++ui;
        if constexpr (ALIGN_EPI) { if (wr == 1) PG8_BAR; }
    }
    PG8_WAIT_V(0);
    if constexpr (!ALIGN_EPI) { if (wr == 0) PG8_BAR; }
    PG8_BAR;
    if constexpr (Epi::AFTER_DRAIN) { E.fused(acc, cur, wr, wc, fr, fq, lds, wid, lane); S.done(cur); }
#undef PG8_SA
#undef PG8_SB
#undef PG8_STAGE
#undef PG8_LDA
#undef PG8_LDB
#undef PG8_MMA
#undef PG8_WAIT_V
#undef PG8_WAIT_L
#undef PG8_BAR
#undef PG8_SCHED
}
}

constexpr int DM = 1024, TP = 16384, TSM = 256, TT = 16640, SEQ = 8192;
constexpr int DIN = 2048, CONVD = 3072, NH = 32, DST = 128;
constexpr int MINW = 5152, MINP = 5376;
constexpr float EPS = 1e-6f;
constexpr size_t MiB = 1u << 20;
constexpr size_t O_Y = 0, O_SSMP = 17039360, O_CONVP = 18087936, O_SSMS = 18124800, O_CONVS = 34902016;
constexpr size_t O_KVP1 = 35491840, O_KVP2 = 35622912, O_KVP3 = 36147200, O_KVS1 = 38244352, O_KVS2 = 38375424, O_KVS3 = 38506496;
constexpr size_t WS_CTL = 0, WS_SSQ = 1 * MiB, WS_ZERO_BYTES = 2 * MiB;
constexpr size_t WS_WIN0 = 2 * MiB, WS_WIN1 = 13 * MiB, WS_WOUT0 = 24 * MiB, WS_WOUT1 = 28 * MiB, WS_WKVA = 32 * MiB, WS_WAIN1 = 43 * MiB;
constexpr size_t WS_WAOUT0 = 51 * MiB, WS_WAOUT1 = 53 * MiB, WS_WG0 = 55 * MiB, WS_WP0 = 63 * MiB;
constexpr size_t WS_ROPEC = 65 * MiB, WS_ROPES = 66 * MiB + 512 * 1024;
constexpr size_t WS_HB = 68 * MiB, WS_PBUFA = 101 * MiB, WS_PBUFB = 110 * MiB, WS_PP = 119 * MiB;
constexpr size_t WS_DTRAW = 152 * MiB, WS_DTC = 155 * MiB, WS_ACU = 157 * MiB, WS_XSS = 159 * MiB, WS_YSRAW = 162 * MiB;
constexpr size_t WS_ZB = 164 * MiB, WS_XBC = 229 * MiB, WS_XT = 327 * MiB, WS_BROW = 391 * MiB, WS_BT = 407 * MiB, WS_CROW = 423 * MiB, WS_STATES = 439 * MiB;
constexpr size_t WS_YB = WS_XBC;
constexpr size_t WS_GATE = WS_ZB, WS_Q = WS_XBC, WS_KVRAW = WS_XT, WS_KN = WS_BROW, WS_KSS = WS_CROW, WS_VSS = WS_CROW + 1 * MiB, WS_VT = WS_STATES, WS_OB = WS_STATES + 24 * MiB;
constexpr size_t WS_END = 503 * MiB;
constexpr int CW_BAR = 4096;
constexpr int ROPE_ROWS = 8200;

constexpr int RING_BYTES = 151552, MISC_OFF = RING_BYTES + 320, LDS_BYTES = 155648;

struct Args { const float* in[27]; float* out; unsigned char* ws; unsigned long long dup; int ph_lo, ph_hi; };

struct Ctx {
    LAS unsigned char* lds;
    int tid, lane, wave, vcu, G;
    int gw, ngw;
    const float* const* in; float* out; unsigned char* ws;
};

template <int C1, int C2, int C3, int LD0, int LD1, int LD2, bool HAS_DT>
struct EpiSplit {
    static constexpr bool PERM = true, AFTER_DRAIN = false;
    const float* ssq; bf16* p0; bf16* p1; bf16* p2; float* dt;
    template <int LD> __device__ __forceinline__ void seg(const f32x4 (&acc)[2][2][4][2], bf16* base, unsigned row0, unsigned col0) const {
#pragma unroll
        for (int ai = 0; ai < 2; ++ai)
#pragma unroll
            for (int m = 0; m < 4; ++m) { const unsigned r = row0 + ai * 128 + m * 16; bf16* rowp = base + (r * (unsigned)LD + col0); const float s = rsqrtf(ssq[r] * (1.f / 1024.f) + EPS);
#pragma unroll
                for (int bj = 0; bj < 2; ++bj) { const f32x4 v0 = acc[ai][bj][m][0] * s, v1 = acc[ai][bj][m][1] * s;
                    u32x4 w; w.x = pk2(v0[0], v0[1]); w.y = pk2(v0[2], v0[3]); w.z = pk2(v1[0], v1[1]); w.w = pk2(v1[2], v1[3]);
                    *(u32x4*)(rowp + bj * 128) = w; } }
    }
    __device__ __forceinline__ void operator()(const f32x4 (&acc)[2][2][4][2], const pg8::Unit& u, int wr, int wc, int fr, int fq) const {
        const int colt = u.pn * 256; const unsigned row0 = u.pm * 256 + wr * 64 + fr; const unsigned cw = wc * 32 + 8 * fq;
        if (colt >= C3) {
            if (HAS_DT && wc == 0) {
#pragma unroll
                for (int ai = 0; ai < 2; ++ai)
#pragma unroll
                    for (int m = 0; m < 4; ++m) { const unsigned r = row0 + ai * 128 + m * 16; float* o = dt + (r * 32u + 8 * fq); const float s = rsqrtf(ssq[r] * (1.f / 1024.f) + EPS);
                        *(f32x4*)o = acc[ai][0][m][0] * s; *(f32x4*)(o + 4) = acc[ai][0][m][1] * s; }
            }
            return;
        }
        if (colt < C1) seg<LD0>(acc, p0, row0, colt + cw);
        else if (colt < C2) seg<LD1>(acc, p1, row0, colt - C1 + cw);
        else seg<LD2>(acc, p2, row0, colt - C2 + cw);
    }
};

template <int MODE> struct EpiRes {
    static constexpr bool PERM = true, AFTER_DRAIN = false;
    const bf16* Hin; bf16* Hout; float* ssq_out; const float* ssq_in; const bf16* PP; float* Yf32;
    __device__ __forceinline__ void operator()(const f32x4 (&acc)[2][2][4][2], const pg8::Unit& u, int wr, int wc, int fr, int fq) const {
        const int row0 = u.pm * 256 + wr * 64 + fr, col0 = u.pn * 256 + wc * 32 + 8 * fq;
#pragma unroll
        for (int ai = 0; ai < 2; ++ai)
#pragma unroll
            for (int m = 0; m < 4; ++m) {
                const int r = row0 + ai * 128 + m * 16; const size_t off = (size_t)r * DM + col0;
                float rs = 1.f; if (MODE == 1) rs = rsqrtf(ssq_in[r] * (1.f / 1024.f) + EPS);
                float ss = 0.f;
#pragma unroll
                for (int bj = 0; bj < 2; ++bj) {
                    float hb[8]; unpack8(*(const u32x4*)(Hin + off + bj * 128), hb);
                    f32x4 d0 = acc[ai][bj][m][0], d1 = acc[ai][bj][m][1];
                    if (MODE == 1) {
                        const u32x4 pv = *(const u32x4*)(PP + off + bj * 128); float pf[8]; unpack8(pv, pf);
#pragma unroll
                        for (int j = 0; j < 4; ++j) { d0[j] = sigmoid_f(d0[j] * rs) * pf[j]; d1[j] = sigmoid_f(d1[j] * rs) * pf[4 + j]; }
                    }
                    const f32x4 h0 = (f32x4){hb[0], hb[1], hb[2], hb[3]} + d0, h1 = (f32x4){hb[4], hb[5], hb[6], hb[7]} + d1;
                    if (Yf32 != nullptr) { *(f32x4*)(Yf32 + off + bj * 128) = h0; *(f32x4*)(Yf32 + off + bj * 128 + 4) = h1; }
                    u32x4 w; w.x = pk2(h0[0], h0[1]); w.y = pk2(h0[2], h0[3]); w.z = pk2(h1[0], h1[1]); w.w = pk2(h1[2], h1[3]);
                    if (Hout != nullptr) *(u32x4*)(Hout + off + bj * 128) = w;
                    ss += (h0[0] * h0[0] + h0[1] * h0[1]) + (h0[2] * h0[2] + h0[3] * h0[3]) + (h1[0] * h1[0] + h1[1] * h1[1]) + (h1[2] * h1[2] + h1[3] * h1[3]);
                }
                ss += __shfl_xor(ss, 16); ss += __shfl_xor(ss, 32);
                if (fq == 0 && ssq_out != nullptr) atomicAdd(ssq_out + r, ss);
                if (m & 1) asm volatile("" ::: "memory");
            }
    }
};

struct EpiPlain {
    static constexpr bool PERM = true, AFTER_DRAIN = false;
    bf16* O; int ld;
    __device__ __forceinline__ void operator()(const f32x4 (&acc)[2][2][4][2], const pg8::Unit& u, int wr, int wc, int fr, int fq) const {
        const int row0 = u.pm * 256 + wr * 64 + fr, col0 = u.pn * 256 + wc * 32 + 8 * fq;
#pragma unroll
        for (int ai = 0; ai < 2; ++ai)
#pragma unroll
            for (int m = 0; m < 4; ++m) { bf16* rowp = O + (size_t)(row0 + ai * 128 + m * 16) * ld + col0;
#pragma unroll
                for (int bj = 0; bj < 2; ++bj) { const f32x4 v0 = acc[ai][bj][m][0], v1 = acc[ai][bj][m][1];
                    u32x4 w; w.x = pk2(v0[0], v0[1]); w.y = pk2(v0[2], v0[3]); w.z = pk2(v1[0], v1[1]); w.w = pk2(v1[2], v1[3]);
                    *(u32x4*)(rowp + bj * 128) = w; } }
    }
};

__device__ __forceinline__ void transpose_item(const float* __restrict__ W, int K, int Nsrc, bf16* __restrict__ WT, int row_off, const float* __restrict__ scale,
                                               LAS float* scr, int kb, int nb, int lane) {
    const int k0 = 64 * kb, n0 = 64 * nb;
    const int c = lane & 7, ns = lane >> 3;
    if (n0 >= Nsrc) {
#pragma unroll
        for (int j = 0; j < 8; ++j) { const int n = ns + 8 * j; *(u32x4*)(WT + (size_t)(row_off + n0 + n) * K + k0 + 8 * c) = (u32x4){0u, 0u, 0u, 0u}; }
        return;
    }
    const int r4 = lane >> 4, c16 = lane & 15;
    f32x4 v[16];
#pragma unroll
    for (int i = 0; i < 16; ++i) { v[i] = (f32x4){0.f, 0.f, 0.f, 0.f}; if (n0 + 4 * c16 < Nsrc) v[i] = *(const f32x4*)(W + (size_t)(k0 + 4 * i + r4) * Nsrc + n0 + 4 * c16); }
#pragma unroll
    for (int i = 0; i < 16; ++i) { const int kk = 4 * i + r4; const float sc = scale ? scale[k0 + kk] : 1.f; LAS float* d = scr + kk * 65 + 4 * c16;
        d[0] = v[i][0] * sc; d[1] = v[i][1] * sc; d[2] = v[i][2] * sc; d[3] = v[i][3] * sc; }
    asm volatile("s_waitcnt lgkmcnt(0)" ::: "memory");
#pragma unroll
    for (int j = 0; j < 8; ++j) { const int n = ns + 8 * j; const LAS float* s = scr + (8 * c) * 65 + n;
        u32x4 o; o.x = pk2(s[0 * 65], s[1 * 65]); o.y = pk2(s[2 * 65], s[3 * 65]); o.z = pk2(s[4 * 65], s[5 * 65]); o.w = pk2(s[6 * 65], s[7 * 65]);
        *(u32x4*)(WT + (size_t)(row_off + n0 + n) * K + k0 + 8 * c) = o; }
    asm volatile("s_waitcnt lgkmcnt(0)" ::: "memory");
}

struct WJob { const float* W; const float* scale; bf16* WT; int K, Nsrc, Ndst, row_off; };

__device__ __forceinline__ void p0_prologue(const Ctx& C) {
    LAS float* scr = (LAS float*)(C.lds + C.wave * 17408);
    unsigned char* ws = C.ws;
#pragma unroll 1
    for (int job = 0; job < 20; ++job) {
        WJob J;
        if (job < 2)       { J = {C.in[10] + (size_t)job * 1024 * MINW, C.in[9] + job * 1024, (bf16*)(ws + (job ? WS_WIN1 : WS_WIN0)), 1024, MINW, MINP, 0}; }
        else if (job < 4)  { const int i = job - 2; J = {C.in[17] + (size_t)i * 2048 * 1024, C.in[16] + i * 2048, (bf16*)(ws + (i ? WS_WOUT1 : WS_WOUT0)), 2048, 1024, 1024, 0}; }
        else if (job == 4) { J = {C.in[19], C.in[18], (bf16*)(ws + WS_WKVA), 1024, 1536, 1536, 0}; }
        else if (job == 5) { J = {C.in[21], C.in[9] + 2 * 1024, (bf16*)(ws + WS_WKVA), 1024, 4096, 4096, 1536}; }
        else if (job == 6) { J = {C.in[21] + (size_t)1024 * 4096, C.in[9] + 3 * 1024, (bf16*)(ws + WS_WAIN1), 1024, 4096, 4096, 0}; }
        else if (job < 9)  { const int i = job - 7; J = {C.in[23] + (size_t)i * 1024 * 1024, nullptr, (bf16*)(ws + (i ? WS_WAOUT1 : WS_WAOUT0)), 1024, 1024, 1024, 0}; }
        else if (job < 13) { const int i = job - 9; J = {C.in[25] + (size_t)i * 1024 * 1024, C.in[26] + i * 1024, (bf16*)(ws + WS_WG0 + (size_t)i * 2 * MiB), 1024, 1024, 1024, 0}; }
        else if (job < 17) { const int i = job - 13; J = {C.in[24] + (size_t)i * 256 * 1024, nullptr, (bf16*)(ws + WS_WP0 + (size_t)i * 512 * 1024), 256, 1024, 1024, 0}; }
        else break;
        const int nblk = J.Ndst / 64, nitems = (J.K / 64) * nblk;
        for (int it = C.gw; it < nitems; it += C.ngw) transpose_item(J.W, J.K, J.Nsrc, J.WT, J.row_off, J.scale, scr, it / nblk, it % nblk, C.lane);
    }
    {
        bf16* HB = (bf16*)C.out; float* ssq = (float*)(ws + WS_SSQ);
        for (int m = C.gw; m < TT; m += C.ngw) {
            const float* xrow = (m < TP) ? C.in[0] + (size_t)m * DM : C.in[1] + (size_t)(m - TP) * DM;
            const f32x4* xr = (const f32x4*)xrow + C.lane;
            f32x4 v[4]; float s = 0.f;
#pragma unroll
            for (int j = 0; j < 4; ++j) { v[j] = xr[64 * j]; s += (v[j][0] * v[j][0] + v[j][1] * v[j][1]) + (v[j][2] * v[j][2] + v[j][3] * v[j][3]); }
            s = wave_sum(s);
            u32x2* bo = (u32x2*)(HB + (size_t)m * DM) + C.lane;
#pragma unroll
            for (int j = 0; j < 4; ++j) { u32x2 w; w.x = pk2(v[j][0], v[j][1]); w.y = pk2(v[j][2], v[j][3]); bo[64 * j] = w; }
            if (C.lane == 0) ssq[m] = s;
        }
    }
    {
        float* rc = (float*)(ws + WS_ROPEC); float* rsn = (float*)(ws + WS_ROPES);
        const int gt = C.gw * 64 + C.lane, ngt = C.ngw * 64;
        for (int e = gt; e < ROPE_ROWS * 32; e += ngt) {
            const int pos = e >> 5, i = e & 31;
            const float inv = 1.0f / powf(10000.0f, (float)i / 32.0f);
            const float ang = (float)pos * inv;
            rc[e] = cosf(ang); rsn[e] = sinf(ang);
        }
    }
}

__device__ __forceinline__ void convert_p(const Ctx& C, int layer, bf16* dst) {
    const float* pp = C.in[7] + (size_t)layer * TP * 256; const float* ps = C.in[8] + (size_t)layer * TSM * 256;
    const int gt = C.gw * 64 + C.lane, ngt = C.ngw * 64;
    for (int e = gt; e < TT * 32; e += ngt) {
        const int row = e >> 5, c = (e & 31) * 8;
        const float* src = (row < TP) ? pp + (size_t)row * 256 + c : ps + (size_t)(row - TP) * 256 + c;
        const f32x4 a = *(const f32x4*)src, b = *(const f32x4*)(src + 4);
        u32x4 w; w.x = pk2(a[0], a[1]); w.y = pk2(a[2], a[3]); w.z = pk2(b[0], b[1]); w.w = pk2(b[2], b[3]);
        *(u32x4*)(dst + (size_t)row * 256 + c) = w;
    }
}

__device__ __forceinline__ void p2_conv(const Ctx& C, int layer) {
    unsigned char* ws = C.ws;
    const bf16* XBC = (const bf16*)(ws + WS_XBC);
    bf16* XT = (bf16*)(ws + WS_XT); bf16* BROW = (bf16*)(ws + WS_BROW); bf16* BT = (bf16*)(ws + WS_BT); bf16* CROW = (bf16*)(ws + WS_CROW);
    const float* cw = C.in[11] + (size_t)layer * 4 * CONVD; const float* cbias = C.in[12] + (size_t)layer * CONVD;
    for (int unit = blockIdx.x; unit < 128 * 12; unit += C.G) {
        const int cidx = unit / 12, cb = unit % 12;
        const int c8 = cb * 32 + (C.tid >> 4), run = C.tid & 15, ch = c8 * 8;
        const int tok0 = cidx * 128 + run * 8, sseq0 = (cidx & 63) * 128 + run * 8;
        float w[4][8], o[8][8];
#pragma unroll
        for (int k = 0; k < 4; ++k) { const f32x4 a = *(const f32x4*)(cw + k * CONVD + ch), b = *(const f32x4*)(cw + k * CONVD + ch + 4);
#pragma unroll
            for (int i = 0; i < 4; ++i) { w[k][i] = a[i]; w[k][4 + i] = b[i]; } }
        { const f32x4 a = *(const f32x4*)(cbias + ch), b = *(const f32x4*)(cbias + ch + 4);
#pragma unroll
            for (int j = 0; j < 8; ++j)
#pragma unroll
                for (int i = 0; i < 4; ++i) { o[j][i] = a[i]; o[j][4 + i] = b[i]; } }
        u32x4 raw[11];
#pragma unroll
        for (int r = 0; r < 11; ++r) { raw[r] = (u32x4){0u, 0u, 0u, 0u}; if (sseq0 + r - 3 >= 0) raw[r] = *(const u32x4*)(XBC + (size_t)(tok0 + r - 3) * CONVD + ch); }
#pragma unroll
        for (int r = 0; r < 11; ++r) { float x[8]; unpack8(raw[r], x);
#pragma unroll
            for (int j = 0; j < 8; ++j) { const int k = r - j; if (k >= 0 && k < 4) {
#pragma unroll
                for (int i = 0; i < 8; ++i) o[j][i] += w[k][i] * x[i]; } } }
#pragma unroll
        for (int j = 0; j < 8; ++j)
#pragma unroll
            for (int i = 0; i < 8; ++i) o[j][i] = silu_f(o[j][i]);
        if (ch < DIN) {
            const int head = ch >> 6, p0 = ch & 63;
#pragma unroll
            for (int i = 0; i < 8; ++i) { float t[8];
#pragma unroll
                for (int j = 0; j < 8; ++j) t[j] = o[j][i];
                *(u32x4*)(XT + ((size_t)(cidx * 32 + head) * 64 + p0 + i) * 128 + run * 8) = pack8(t); }
        } else if (ch < DIN + 512) {
            const int g = (ch - DIN) >> 7, n0 = (ch - DIN) & 127;
#pragma unroll
            for (int j = 0; j < 8; ++j) *(u32x4*)(BROW + ((size_t)(cidx * 4 + g) * 128 + run * 8 + j) * 128 + n0) = pack8(o[j]);
#pragma unroll
            for (int i = 0; i < 8; ++i) { float t[8];
#pragma unroll
                for (int j = 0; j < 8; ++j) t[j] = o[j][i];
                *(u32x4*)(BT + ((size_t)(cidx * 4 + g) * 128 + n0 + i) * 128 + run * 8) = pack8(t); }
        } else {
            const int g = (ch - DIN - 512) >> 7, n0 = (ch - DIN - 512) & 127;
#pragma unroll
            for (int j = 0; j < 8; ++j) *(u32x4*)(CROW + ((size_t)(cidx * 4 + g) * 128 + run * 8 + j) * 128 + n0) = pack8(o[j]);
        }
        if ((cidx & 63) == 63 && run == 15) {
            const int b = cidx >> 6;
#pragma unroll
            for (int j = 0; j < 3; ++j) { float x[8]; unpack8(raw[8 + j], x); float* dst = C.out + O_CONVP + ((size_t)(layer * 2 + b) * 3 + j) * CONVD + ch;
                *(f32x4*)dst = (f32x4){x[0], x[1], x[2], x[3]}; *(f32x4*)(dst + 4) = (f32x4){x[4], x[5], x[6], x[7]}; }
        }
    }
    {
        const float* cst = C.in[3] + (size_t)layer * 32 * 3 * CONVD; float* XSS = (float*)(ws + WS_XSS);
        const int gt = C.gw * 64 + C.lane, ngt = C.ngw * 64;
        for (int e = gt; e < 32 * 384; e += ngt) {
            const int sb = e / 384, ch = (e % 384) * 8;
            float w[4][8], xin[11][8];
#pragma unroll
            for (int k = 0; k < 4; ++k) { const f32x4 a = *(const f32x4*)(cw + k * CONVD + ch), b = *(const f32x4*)(cw + k * CONVD + ch + 4);
#pragma unroll
                for (int i = 0; i < 4; ++i) { w[k][i] = a[i]; w[k][4 + i] = b[i]; } }
            float bs[8]; { const f32x4 a = *(const f32x4*)(cbias + ch), b = *(const f32x4*)(cbias + ch + 4);
#pragma unroll
                for (int i = 0; i < 4; ++i) { bs[i] = a[i]; bs[4 + i] = b[i]; } }
#pragma unroll
            for (int r = 0; r < 3; ++r) { const float* s = cst + ((size_t)sb * 3 + r) * CONVD + ch; const f32x4 a = *(const f32x4*)s, b = *(const f32x4*)(s + 4);
#pragma unroll
                for (int i = 0; i < 4; ++i) { xin[r][i] = a[i]; xin[r][4 + i] = b[i]; } }
#pragma unroll
            for (int r = 0; r < 8; ++r) { const u32x4 v = *(const u32x4*)(XBC + (size_t)(TP + sb * 8 + r) * CONVD + ch); unpack8(v, xin[3 + r]); }
#pragma unroll
            for (int j = 0; j < 8; ++j) { float o[8];
#pragma unroll
                for (int i = 0; i < 8; ++i) { float a = bs[i];
#pragma unroll
                    for (int k = 0; k < 4; ++k) a += w[k][i] * xin[j + k][i];
                    o[i] = silu_f(a); }
                float* dst = XSS + (size_t)(sb * 8 + j) * CONVD + ch;
                *(f32x4*)dst = (f32x4){o[0], o[1], o[2], o[3]}; *(f32x4*)(dst + 4) = (f32x4){o[4], o[5], o[6], o[7]}; }
#pragma unroll
            for (int j = 0; j < 3; ++j) { float* dst = C.out + O_CONVS + ((size_t)(layer * 32 + sb) * 3 + j) * CONVD + ch;
                *(f32x4*)dst = (f32x4){xin[8 + j][0], xin[8 + j][1], xin[8 + j][2], xin[8 + j][3]}; *(f32x4*)(dst + 4) = (f32x4){xin[8 + j][4], xin[8 + j][5], xin[8 + j][6], xin[8 + j][7]}; }
        }
    }
    {
        const float* DTRAW = (const float*)(ws + WS_DTRAW); float* DTC = (float*)(ws + WS_DTC); float* ACU = (float*)(ws + WS_ACU);
        const float* dtb = C.in[13] + layer * 32; const float* alog = C.in[14] + layer * 32;
        for (int task = C.gw; task < 128 * 32; task += C.ngw) {
            const int cidx = task >> 5, head = task & 31;
            const int t = cidx * 128 + 2 * C.lane;
            const float A = -__expf(alog[head]), bsv = dtb[head];
            const float d0 = softplus_f(DTRAW[(size_t)t * 32 + head] + bsv), d1 = softplus_f(DTRAW[(size_t)(t + 1) * 32 + head] + bsv);
            const float a0 = d0 * A, a1 = d1 * A;
            float x = a0 + a1;
#pragma unroll
            for (int o = 1; o < 64; o <<= 1) { const float v = __shfl_up(x, o); if (C.lane >= o) x += v; }
            *(f32x2*)(DTC + (size_t)task * 128 + 2 * C.lane) = (f32x2){d0, d1};
            *(f32x2*)(ACU + (size_t)task * 128 + 2 * C.lane) = (f32x2){x - a1, x};
        }
    }
}

#define MFMA16(a, b, c) __builtin_amdgcn_mfma_f32_16x16x32_bf16((a), (b), (c), 0, 0, 0)

__device__ __forceinline__ void s1_task(const Ctx& C, int cidx, int head) {
    unsigned char* ws = C.ws;
    const bf16* xt = (const bf16*)(ws + WS_XT) + (size_t)(cidx * 32 + head) * 64 * 128;
    const bf16* bt = (const bf16*)(ws + WS_BT) + (size_t)(cidx * 4 + (head >> 3)) * 128 * 128;
    const float* dtc = (const float*)(ws + WS_DTC) + (size_t)(cidx * 32 + head) * 128;
    const float* acu = (const float*)(ws + WS_ACU) + (size_t)(cidx * 32 + head) * 128;
    bf16* st = (bf16*)(ws + WS_STATES) + (size_t)(cidx * 32 + head) * 64 * 128;
    const int fr = C.lane & 15, fq = C.lane >> 4;
    const float aend = acu[127];
    f32x4 acc[8][4];
#pragma unroll
    for (int a = 0; a < 8; ++a)
#pragma unroll
        for (int b = 0; b < 4; ++b) acc[a][b] = (f32x4){0.f, 0.f, 0.f, 0.f};
#pragma unroll 1
    for (int ks = 0; ks < 4; ++ks) {
        const int s0 = ks * 32 + 8 * fq;
        float wv[8];
        { const f32x4 d0 = *(const f32x4*)(dtc + s0), d1 = *(const f32x4*)(dtc + s0 + 4), a0 = *(const f32x4*)(acu + s0), a1 = *(const f32x4*)(acu + s0 + 4);
#pragma unroll
          for (int j = 0; j < 4; ++j) { wv[j] = d0[j] * __expf(aend - a0[j]); wv[4 + j] = d1[j] * __expf(aend - a1[j]); } }
        bf16x8 bfr[8];
#pragma unroll
        for (int nt = 0; nt < 8; ++nt) bfr[nt] = *(const bf16x8*)(bt + (size_t)(nt * 16 + fr) * 128 + s0);
#pragma unroll
        for (int pt = 0; pt < 4; ++pt) {
            const u32x4 raw = *(const u32x4*)(xt + (size_t)(pt * 16 + fr) * 128 + s0);
            float x[8]; unpack8(raw, x);
#pragma unroll
            for (int j = 0; j < 8; ++j) x[j] *= wv[j];
            const bf16x8 afr = __builtin_bit_cast(bf16x8, pack8(x));
#pragma unroll
            for (int nt = 0; nt < 8; ++nt) acc[nt][pt] = MFMA16(bfr[nt], afr, acc[nt][pt]);
        }
    }
#pragma unroll
    for (int nt = 0; nt < 8; ++nt)
#pragma unroll
        for (int pt = 0; pt < 4; ++pt) { u32x2 w; w.x = pk2(acc[nt][pt][0], acc[nt][pt][1]); w.y = pk2(acc[nt][pt][2], acc[nt][pt][3]);
            *(u32x2*)(st + (size_t)(pt * 16 + fr) * 128 + nt * 16 + 4 * fq) = w; }
}

__device__ __forceinline__ void ssd_sample_task(const Ctx& C, int layer, int sb, int head, LAS float* wl) {
    unsigned char* ws = C.ws;
    const float* XSS = (const float*)(ws + WS_XSS); const float* DTRAW = (const float*)(ws + WS_DTRAW); const bf16* ZB = (const bf16*)(ws + WS_ZB);
    float* YSRAW = (float*)(ws + WS_YSRAW);
    const float* h0 = C.in[2] + ((size_t)(layer * 32 + sb) * 32 + head) * 64 * 128;
    float* hout = C.out + O_SSMS + ((size_t)(layer * 32 + sb) * 32 + head) * 64 * 128;
    const int g = head >> 3, lane = C.lane, tok0 = sb * 8;
    LAS float* Bl = wl;
    LAS float* Cl = wl + 1024;
    LAS float* Xl = wl + 2048;
    LAS float* XWl = wl + 2560;
    LAS float* Gl = wl + 3072;
    LAS float* Sc = wl + 3136;
    const float A = -__expf(C.in[14][layer * 32 + head]), dtb = C.in[13][layer * 32 + head], Dh = C.in[15][layer * 32 + head];
    float dtv[8], ac[8];
    { float run = 0.f;
#pragma unroll
      for (int s = 0; s < 8; ++s) { dtv[s] = softplus_f(DTRAW[(size_t)(TP + tok0 + s) * 32 + head] + dtb); run += dtv[s] * A; ac[s] = run; } }
    const float ac7 = ac[7];
    if (lane == 0) {
#pragma unroll
        for (int s = 0; s < 8; ++s) { Sc[s] = dtv[s]; Sc[8 + s] = ac[s]; }
    }
#pragma unroll
    for (int s = 0; s < 8; ++s) {
        const float* row = XSS + (size_t)(tok0 + s) * CONVD;
        *(LAS f32x2*)(Bl + s * 128 + 2 * lane) = *(const f32x2*)(row + DIN + g * 128 + 2 * lane);
        *(LAS f32x2*)(Cl + s * 128 + 2 * lane) = *(const f32x2*)(row + DIN + 512 + g * 128 + 2 * lane);
        const float xv = row[head * 64 + lane];
        Xl[s * 64 + lane] = xv; XWl[s * 64 + lane] = xv * dtv[s] * __expf(ac7 - ac[s]);
    }
    asm volatile("s_waitcnt lgkmcnt(0)" ::: "memory");
#pragma unroll 1
    for (int l = 0; l < 8; ++l) {
        const f32x2 cv = *(LAS f32x2*)(Cl + l * 128 + 2 * lane); const float acl = Sc[8 + l];
#pragma unroll 1
        for (int s = 0; s <= l; ++s) {
            const f32x2 bv = *(LAS f32x2*)(Bl + s * 128 + 2 * lane);
            float d = wave_sum(cv[0] * bv[0] + cv[1] * bv[1]);
            d = d * __expf(acl - Sc[8 + s]) * Sc[s] + ((s == l) ? Dh : 0.f);
            if (lane == 0) Gl[l * 8 + s] = d;
        }
    }
    asm volatile("s_waitcnt lgkmcnt(0)" ::: "memory");
    const int pi = lane >> 3, nj = lane & 7;
    const float cd = __expf(ac7);
    const float eal = __expf(Sc[8 + nj]);
#pragma unroll 1
    for (int pb = 0; pb < 8; ++pb) {
        const int p = pb * 8 + pi;
        float xw[8], yo[8];
#pragma unroll
        for (int s = 0; s < 8; ++s) { xw[s] = XWl[s * 64 + p]; yo[s] = 0.f; }
        f32x4 hv[4];
#pragma unroll
        for (int nb = 0; nb < 4; ++nb) hv[nb] = *(const f32x4*)(h0 + (size_t)p * 128 + nb * 32 + nj * 4);
#pragma unroll
        for (int nb = 0; nb < 4; ++nb) {
            const int n = nb * 32 + nj * 4;
            const f32x4 h4 = hv[nb];
            f32x4 hn = h4 * cd;
#pragma unroll
            for (int s = 0; s < 8; ++s) { const f32x4 b4 = *(LAS f32x4*)(Bl + s * 128 + n), c4 = *(LAS f32x4*)(Cl + s * 128 + n);
                hn += b4 * xw[s];
                yo[s] += (c4[0] * h4[0] + c4[1] * h4[1]) + (c4[2] * h4[2] + c4[3] * h4[3]); }
            *(f32x4*)(hout + (size_t)p * 128 + n) = hn;
            __builtin_amdgcn_sched_barrier(0);
        }
        float mine = 0.f;
#pragma unroll
        for (int l = 0; l < 8; ++l) { float v = yo[l]; v += __shfl_xor(v, 1); v += __shfl_xor(v, 2); v += __shfl_xor(v, 4); if (nj == l) mine = v; }
        const int l = nj;
        float y = mine * eal;
#pragma unroll 1
        for (int s = 0; s <= l; ++s) y += Gl[l * 8 + s] * Xl[s * 64 + p];
        const float z = bf1(ZB[(size_t)(TP + tok0 + l) * DIN + head * 64 + p]);
        YSRAW[(size_t)(tok0 + l) * DIN + head * 64 + p] = y * silu_f(z);
    }
    asm volatile("s_waitcnt lgkmcnt(0)" ::: "memory");
}

__device__ __forceinline__ void s2_scan(const Ctx& C, int layer, int rep) {
    unsigned char* ws = C.ws;
    bf16* ST = (bf16*)(ws + WS_STATES); const float* ACU = (const float*)(ws + WS_ACU);
    bf16* STw = rep ? (bf16*)(ws + WS_XBC) : ST; float* fin = rep ? (float*)(ws + WS_XBC + 70 * MiB) : C.out + O_SSMP;
    for (int e = blockIdx.x * 512 + C.tid; e < 2 * 32 * 64 * 32; e += C.G * 512) {
        const int n4 = e & 31, p = (e >> 5) & 63, head = (e >> 11) & 31, b = e >> 16;
        f32x4 h = (f32x4){0.f, 0.f, 0.f, 0.f};
#pragma unroll 1
        for (int c0 = 0; c0 < 64; c0 += 8) {
            u32x2 raw[8]; float cdv[8];
#pragma unroll
            for (int k = 0; k < 8; ++k) { const int cidx = b * 64 + c0 + k;
                raw[k] = *(const u32x2*)(ST + ((size_t)(cidx * 32 + head) * 64 + p) * 128 + n4 * 4);
                cdv[k] = ACU[(size_t)(cidx * 32 + head) * 128 + 127]; }
#pragma unroll
            for (int k = 0; k < 8; ++k) { const int cidx = b * 64 + c0 + k;
                u32x2 w; w.x = pk2(h[0], h[1]); w.y = pk2(h[2], h[3]);
                *(u32x2*)(STw + ((size_t)(cidx * 32 + head) * 64 + p) * 128 + n4 * 4) = w;
                const f32x4 s = (f32x4){bflo(raw[k].x), bfhi(raw[k].x), bflo(raw[k].y), bfhi(raw[k].y)};
                h = h * __expf(cdv[k]) + s; }
        }
        *(f32x4*)(fin + (((size_t)(layer * 2 + b) * 32 + head) * 64 + p) * 128 + n4 * 4) = h;
    }
}
__device__ __forceinline__ void sample_norm(const Ctx& C) {
    unsigned char* ws = C.ws; const float* YSRAW = (const float*)(ws + WS_YSRAW); bf16* YB = (bf16*)(ws + WS_YB);
    for (int task = C.gw; task < 256 * 4; task += C.ngw) {
        const int row = task >> 2, g = task & 3;
        const float* src = YSRAW + (size_t)row * DIN + g * 512 + C.lane * 8;
        const f32x4 a = *(const f32x4*)src, b = *(const f32x4*)(src + 4);
        float ss = (a[0] * a[0] + a[1] * a[1]) + (a[2] * a[2] + a[3] * a[3]) + (b[0] * b[0] + b[1] * b[1]) + (b[2] * b[2] + b[3] * b[3]);
        ss = wave_sum(ss);
        const float rs = rsqrtf(ss * (1.f / 512.f) + EPS);
        u32x4 w; w.x = pk2(a[0] * rs, a[1] * rs); w.y = pk2(a[2] * rs, a[3] * rs); w.z = pk2(b[0] * rs, b[1] * rs); w.w = pk2(b[2] * rs, b[3] * rs);
        *(u32x4*)(YB + (size_t)(TP + row) * DIN + g * 512 + C.lane * 8) = w;
    }
}

constexpr int S3_LD = 136;
constexpr int S3_CS = 0, S3_CB = 128 * S3_LD * 2, S3_BS = 2 * 128 * S3_LD * 2;
constexpr int S3_DA = 69632 + 66560;
constexpr int S3_YLD = 520;
__device__ __forceinline__ void s3_unit(const Ctx& C, int layer, int cidx, int g) {
    unsigned char* ws = C.ws;
    const bf16* CROW = (const bf16*)(ws + WS_CROW) + (size_t)(cidx * 4 + g) * 128 * 128;
    const bf16* BROW = (const bf16*)(ws + WS_BROW) + (size_t)(cidx * 4 + g) * 128 * 128;
    LAS bf16* Cs = (LAS bf16*)(C.lds + S3_CS); LAS bf16* Bs = (LAS bf16*)(C.lds + S3_BS); LAS bf16* CBs = (LAS bf16*)(C.lds + S3_CB);
    LAS bf16* Ys = (LAS bf16*)(C.lds + S3_BS);
    const int tid = C.tid, lane = C.lane, w = C.wave, fr = lane & 15, fq = lane >> 4;
#pragma unroll
    for (int i = 0; i < 4; ++i) { const int idx = tid + 512 * i, row = idx >> 4, chk = idx & 15;
        *(LAS u32x4*)(Cs + row * S3_LD + chk * 8) = *(const u32x4*)(CROW + row * 128 + chk * 8);
        *(LAS u32x4*)(Bs + row * S3_LD + chk * 8) = *(const u32x4*)(BROW + row * 128 + chk * 8); }
    __syncthreads();
    {
        f32x4 cb[8];
#pragma unroll
        for (int st = 0; st < 8; ++st) cb[st] = (f32x4){0.f, 0.f, 0.f, 0.f};
#pragma unroll
        for (int ks = 0; ks < 4; ++ks) {
            const bf16x8 cf = *(LAS bf16x8*)(Cs + (w * 16 + fr) * S3_LD + ks * 32 + 8 * fq);
#pragma unroll
            for (int st = 0; st < 8; ++st) if (st <= w) { const bf16x8 bf = *(LAS bf16x8*)(Bs + (st * 16 + fr) * S3_LD + ks * 32 + 8 * fq); cb[st] = MFMA16(bf, cf, cb[st]); }
        }
#pragma unroll
        for (int st = 0; st < 8; ++st) { u32x2 v; v.x = pk2(cb[st][0], cb[st][1]); v.y = pk2(cb[st][2], cb[st][3]);
            *(LAS u32x2*)(CBs + (w * 16 + fr) * S3_LD + st * 16 + 4 * fq) = v; }
    }
    __syncthreads();
    const int head = g * 8 + w;
    const bf16* xt = (const bf16*)(ws + WS_XT) + (size_t)(cidx * 32 + head) * 64 * 128;
    const bf16* hin = (const bf16*)(ws + WS_STATES) + (size_t)(cidx * 32 + head) * 64 * 128;
    const float* dtc = (const float*)(ws + WS_DTC) + (size_t)(cidx * 32 + head) * 128;
    const float* acu = (const float*)(ws + WS_ACU) + (size_t)(cidx * 32 + head) * 128;
    const float Dh = C.in[15][layer * 32 + head];
    LAS float* dtl = (LAS float*)(C.lds + S3_DA) + w * 256; LAS float* acl = dtl + 128;
    { const f32x2 d2 = *(const f32x2*)(dtc + 2 * lane), a2 = *(const f32x2*)(acu + 2 * lane); *(LAS f32x2*)(dtl + 2 * lane) = d2; *(LAS f32x2*)(acl + 2 * lane) = a2; }
    asm volatile("s_waitcnt lgkmcnt(0)" ::: "memory");
#pragma unroll 1
    for (int half = 0; half < 2; ++half) {
        bf16x8 hf[4][4];
#pragma unroll
        for (int ks = 0; ks < 4; ++ks)
#pragma unroll
            for (int pt = 0; pt < 4; ++pt) hf[ks][pt] = *(const bf16x8*)(hin + (size_t)(pt * 16 + fr) * 128 + ks * 32 + 8 * fq);
        f32x4 acc[4][4];
#pragma unroll
        for (int a = 0; a < 4; ++a)
#pragma unroll
            for (int b = 0; b < 4; ++b) acc[a][b] = (f32x4){0.f, 0.f, 0.f, 0.f};
#pragma unroll
        for (int ks = 0; ks < 4; ++ks) {
#pragma unroll
            for (int lt = 0; lt < 4; ++lt) { const bf16x8 cf = *(LAS bf16x8*)(Cs + ((4 * half + lt) * 16 + fr) * S3_LD + ks * 32 + 8 * fq);
#pragma unroll
                for (int pt = 0; pt < 4; ++pt) acc[lt][pt] = MFMA16(hf[ks][pt], cf, acc[lt][pt]); }
            __builtin_amdgcn_sched_barrier(0);
        }
        float al[4];
#pragma unroll
        for (int lt = 0; lt < 4; ++lt) { al[lt] = acl[(4 * half + lt) * 16 + fr]; const float e = __expf(al[lt]);
#pragma unroll
            for (int pt = 0; pt < 4; ++pt) acc[lt][pt] *= e; }
#pragma unroll 1
        for (int ks = 0; ks < 2 * half + 2; ++ks) {
            const int s0 = ks * 32 + 8 * fq;
            bf16x8 xf[4];
#pragma unroll
            for (int pt = 0; pt < 4; ++pt) xf[pt] = *(const bf16x8*)(xt + (size_t)(pt * 16 + fr) * 128 + s0);
            float ds[8], as[8];
            { const f32x4 d0 = *(LAS f32x4*)(dtl + s0), d1 = *(LAS f32x4*)(dtl + s0 + 4), a0 = *(LAS f32x4*)(acl + s0), a1 = *(LAS f32x4*)(acl + s0 + 4);
#pragma unroll
              for (int j = 0; j < 4; ++j) { ds[j] = d0[j]; ds[4 + j] = d1[j]; as[j] = a0[j]; as[4 + j] = a1[j]; } }
#pragma unroll
            for (int lt = 0; lt < 4; ++lt) if (4 * half + lt >= 2 * ks) {
                const int l = (4 * half + lt) * 16 + fr;
                const u32x4 raw = *(LAS u32x4*)(CBs + l * S3_LD + s0);
                float gv[8]; unpack8(raw, gv);
#pragma unroll
                for (int j = 0; j < 8; ++j) { const int s = s0 + j; float v = gv[j] * __expf(al[lt] - as[j]) * ds[j]; v = (s <= l) ? v : 0.f; gv[j] = (s == l) ? v + Dh : v; }
                const bf16x8 gf = __builtin_bit_cast(bf16x8, pack8(gv));
#pragma unroll
                for (int pt = 0; pt < 4; ++pt) acc[lt][pt] = MFMA16(xf[pt], gf, acc[lt][pt]);
            }
        }
#pragma unroll
        for (int lt = 0; lt < 4; ++lt)
#pragma unroll
            for (int pt = 0; pt < 4; ++pt) { u32x2 v; v.x = pk2(acc[lt][pt][0], acc[lt][pt][1]); v.y = pk2(acc[lt][pt][2], acc[lt][pt][3]);
                *(LAS u32x2*)(Ys + (lt * 16 + fr) * S3_YLD + w * 64 + pt * 16 + 4 * fq) = v; }
        __syncthreads();
        {
            const int lr = tid >> 3, oc = tid & 7; const size_t tok = (size_t)cidx * 128 + half * 64 + lr;
            const bf16* zrow = (const bf16*)(ws + WS_ZB) + tok * DIN + g * 512 + oc * 64;
            bf16* yrow = (bf16*)(ws + WS_YB) + tok * DIN + g * 512 + oc * 64;
            float v[8][8]; float ss = 0.f;
#pragma unroll
            for (int c = 0; c < 8; ++c) { const u32x4 yr = *(LAS u32x4*)(Ys + lr * S3_YLD + oc * 64 + c * 8); const u32x4 zr = *(const u32x4*)(zrow + c * 8);
                float zf[8]; unpack8(yr, v[c]); unpack8(zr, zf);
#pragma unroll
                for (int j = 0; j < 8; ++j) { v[c][j] *= silu_f(zf[j]); ss += v[c][j] * v[c][j]; } }
            ss += __shfl_xor(ss, 1); ss += __shfl_xor(ss, 2); ss += __shfl_xor(ss, 4);
            const float rs = rsqrtf(ss * (1.f / 512.f) + EPS);
#pragma unroll
            for (int c = 0; c < 8; ++c) {
#pragma unroll
                for (int j = 0; j < 8; ++j) v[c][j] *= rs;
                *(u32x4*)(yrow + c * 8) = pack8(v[c]); }
        }
        __syncthreads();
    }
}

template <int MODE>
__device__ __forceinline__ void side_gemm(const Ctx& C, const bf16* __restrict__ A, const bf16* __restrict__ Wt, int K,
                                          const bf16* Hin, bf16* Hout, float* Yf32, float* ssq_out, const float* ssq_in, const bf16* PP, bf16* OUT) {
    const int lane = C.lane, w = C.wave, fr = lane & 15, fq = lane >> 4, tid = C.tid;
    LAS float* red = (LAS float*)C.lds;
    const int kper = K >> 3;
    for (int tile = C.vcu; tile < 256; tile += C.G) {
        const int rg = tile >> 4, cg = tile & 15;
        const bf16* ap = A + (size_t)(TP + rg * 16 + fr) * K + w * kper + 8 * fq;
        const bf16* wp = Wt + (size_t)(cg * 64 + fr) * K + w * kper + 8 * fq;
        f32x4 acc[4];
#pragma unroll
        for (int ct = 0; ct < 4; ++ct) acc[ct] = (f32x4){0.f, 0.f, 0.f, 0.f};
#pragma unroll 1
        for (int k0 = 0; k0 < kper; k0 += 128) {
            bf16x8 af[4], wf[4][4];
#pragma unroll
            for (int s = 0; s < 4; ++s) if (k0 + 32 * s < kper) {
                af[s] = *(const bf16x8*)(ap + k0 + 32 * s);
#pragma unroll
                for (int ct = 0; ct < 4; ++ct) wf[s][ct] = *(const bf16x8*)(wp + (size_t)ct * 16 * K + k0 + 32 * s);
            }
#pragma unroll
            for (int s = 0; s < 4; ++s) if (k0 + 32 * s < kper) {
#pragma unroll
                for (int ct = 0; ct < 4; ++ct) acc[ct] = MFMA16(wf[s][ct], af[s], acc[ct]);
            }
        }
#pragma unroll
        for (int ct = 0; ct < 4; ++ct) *(LAS f32x4*)(red + (w * 16 + fr) * 64 + ct * 16 + 4 * fq) = acc[ct];
        __syncthreads();
        if (tid < 256) {
            const int m = tid >> 4, c4 = (tid & 15) * 4;
            f32x4 v = (f32x4){0.f, 0.f, 0.f, 0.f};
#pragma unroll
            for (int ww = 0; ww < 8; ++ww) v += *(LAS f32x4*)(red + (ww * 16 + m) * 64 + c4);
            const int row = TP + rg * 16 + m; const size_t off = (size_t)row * DM + cg * 64 + c4;
            if (MODE == 2) {
                u32x2 o; o.x = pk2(v[0], v[1]); o.y = pk2(v[2], v[3]); *(u32x2*)(OUT + off) = o;
            } else {
                if (MODE == 1) {
                    const float rs = rsqrtf(ssq_in[row] * (1.f / 1024.f) + EPS);
                    const u32x2 pr = *(const u32x2*)(PP + off);
                    v[0] = sigmoid_f(v[0] * rs) * bflo(pr.x); v[1] = sigmoid_f(v[1] * rs) * bfhi(pr.x); v[2] = sigmoid_f(v[2] * rs) * bflo(pr.y); v[3] = sigmoid_f(v[3] * rs) * bfhi(pr.y);
                }
                const u32x2 hr = *(const u32x2*)(Hin + off);
                const f32x4 h = (f32x4){bflo(hr.x), bfhi(hr.x), bflo(hr.y), bfhi(hr.y)} + v;
                if (Yf32 != nullptr) *(f32x4*)(Yf32 + off) = h;
                if (Hout != nullptr) { u32x2 o; o.x = pk2(h[0], h[1]); o.y = pk2(h[2], h[3]); *(u32x2*)(Hout + off) = o; }
                float ss = (h[0] * h[0] + h[1] * h[1]) + (h[2] * h[2] + h[3] * h[3]);
                ss += __shfl_xor(ss, 1); ss += __shfl_xor(ss, 2); ss += __shfl_xor(ss, 4); ss += __shfl_xor(ss, 8);
                if ((tid & 15) == 0 && ssq_out != nullptr) atomicAdd(ssq_out + row, ss);
            }
        }
        __syncthreads();
    }
}

__device__ __forceinline__ void p9_kvpass(const Ctx& C) {
    unsigned char* ws = C.ws;
    const bf16* KVRAW = (const bf16*)(ws + WS_KVRAW); bf16* KN = (bf16*)(ws + WS_KN); bf16* VT = (bf16*)(ws + WS_VT);
    float* KSS = (float*)(ws + WS_KSS); float* VSS = (float*)(ws + WS_VSS);
    const float* ropec = (const float*)(ws + WS_ROPEC); const float* ropes = (const float*)(ws + WS_ROPES);
    const float* knw = C.in[20];
    const int lane = C.lane, q4 = lane & 3;
    float wk[16];
#pragma unroll
    for (int j = 0; j < 8; ++j) { wk[j] = knw[8 * q4 + j]; wk[8 + j] = knw[32 + 8 * q4 + j]; }
    for (int pass = C.gw; pass < TT * 12 / 16; pass += C.ngw) {
        const int hr = pass * 16 + (lane >> 2), row = hr / 12, gk = hr % 12, gi = gk >> 2, kh = gk & 3;
        const bf16* src = KVRAW + (size_t)row * 1536 + gk * 64 + 8 * q4;
        float k[16], v[16];
        unpack8(*(const u32x4*)src, k); unpack8(*(const u32x4*)(src + 32), k + 8);
        unpack8(*(const u32x4*)(src + 768), v); unpack8(*(const u32x4*)(src + 768 + 32), v + 8);
        float ss = 0.f;
#pragma unroll
        for (int j = 0; j < 16; ++j) ss += k[j] * k[j];
        ss += __shfl_xor(ss, 1); ss += __shfl_xor(ss, 2);
        const float rs = rsqrtf(ss * (1.f / 64.f) + EPS);
        const int pos = (row < TP) ? (row & 8191) : 8192 + ((row - TP) & 7);
        float ko[16];
#pragma unroll
        for (int j = 0; j < 8; ++j) { const float x1 = k[j] * rs * wk[j], x2 = k[8 + j] * rs * wk[8 + j];
            const float c = ropec[pos * 32 + 8 * q4 + j], s = ropes[pos * 32 + 8 * q4 + j];
            ko[j] = x1 * c - x2 * s; ko[8 + j] = x2 * c + x1 * s; }
        bf16* kd = KN + (size_t)row * 768 + gk * 64 + 8 * q4;
        *(u32x4*)kd = pack8(ko); *(u32x4*)(kd + 32) = pack8(ko + 8);
        float* ok = nullptr; float* ov = nullptr;
        if (row < TP) {
            const int b = row >> 13, W = (gi == 0) ? 128 : (gi == 1) ? 512 : 2048;
            const size_t obase = (gi == 0) ? O_KVP1 : (gi == 1) ? O_KVP2 : O_KVP3;
            if (pos >= 8192 - W) { const int jw = pos - (8192 - W); ok = C.out + obase + ((size_t)(b * W + jw) * 2) * 256 + kh * 64 + 8 * q4; ov = ok + 256; }
        } else {
            const int rs_ = row - TP;
            const size_t obase = (gi == 0) ? O_KVS1 : (gi == 1) ? O_KVS2 : O_KVS3;
            ok = C.out + obase + ((size_t)rs_ * 2) * 256 + kh * 64 + 8 * q4; ov = ok + 256;
            float* k2 = KSS + (size_t)rs_ * 768 + gk * 64 + 8 * q4; float* v2 = VSS + (size_t)rs_ * 768 + gk * 64 + 8 * q4;
#pragma unroll
            for (int h2 = 0; h2 < 2; ++h2) {
                *(f32x4*)(k2 + 32 * h2) = (f32x4){ko[8 * h2], ko[8 * h2 + 1], ko[8 * h2 + 2], ko[8 * h2 + 3]}; *(f32x4*)(k2 + 32 * h2 + 4) = (f32x4){ko[8 * h2 + 4], ko[8 * h2 + 5], ko[8 * h2 + 6], ko[8 * h2 + 7]};
                *(f32x4*)(v2 + 32 * h2) = (f32x4){v[8 * h2], v[8 * h2 + 1], v[8 * h2 + 2], v[8 * h2 + 3]}; *(f32x4*)(v2 + 32 * h2 + 4) = (f32x4){v[8 * h2 + 4], v[8 * h2 + 5], v[8 * h2 + 6], v[8 * h2 + 7]}; }
        }
        if (ok != nullptr) {
#pragma unroll
            for (int h2 = 0; h2 < 2; ++h2) {
                *(f32x4*)(ok + 32 * h2) = (f32x4){ko[8 * h2], ko[8 * h2 + 1], ko[8 * h2 + 2], ko[8 * h2 + 3]}; *(f32x4*)(ok + 32 * h2 + 4) = (f32x4){ko[8 * h2 + 4], ko[8 * h2 + 5], ko[8 * h2 + 6], ko[8 * h2 + 7]};
                *(f32x4*)(ov + 32 * h2) = (f32x4){v[8 * h2], v[8 * h2 + 1], v[8 * h2 + 2], v[8 * h2 + 3]}; *(f32x4*)(ov + 32 * h2 + 4) = (f32x4){v[8 * h2 + 4], v[8 * h2 + 5], v[8 * h2 + 6], v[8 * h2 + 7]}; }
        }
    }
    {
        const int gt = C.gw * 64 + lane, ngt = C.ngw * 64;
        for (int e = gt; e < 2 * 12 * 8 * 1024; e += ngt) {
            const int ddc = e & 7, run = (e >> 3) & 1023, bg = e >> 13, gk = bg % 12, b = bg / 12, gi = gk >> 2;
            const int dsh = 2 * gi, d = 1 << dsh, Ld = 8192 >> dsh;
            const int pi0 = run * 8, r = pi0 / Ld, m0 = pi0 % Ld;
            float vv[8][8];
#pragma unroll
            for (int j = 0; j < 8; ++j) { const int tok = r + d * (m0 + j); unpack8(*(const u32x4*)(KVRAW + (size_t)(b * 8192 + tok) * 1536 + 768 + gk * 64 + ddc * 8), vv[j]); }
#pragma unroll
            for (int i = 0; i < 8; ++i) { float t[8];
#pragma unroll
                for (int j = 0; j < 8; ++j) t[j] = vv[j][i];
                *(u32x4*)(VT + ((size_t)(b * 12 + gk) * 64 + ddc * 8 + i) * 8192 + pi0) = pack8(t); }
        }
    }
}

constexpr size_t WS_PART = WS_XT;
constexpr size_t WS_LPART = WS_ZB + 33 * MiB;
__device__ __forceinline__ void attn_unit_decode(int gi, int x, int& b, int& kh, int& r, int& M0) {
    b = x >> 8; kh = (x >> 6) & 3; const int rb = x & 63, bpr = 64 >> (2 * gi);
    r = rb / bpr; M0 = (rb % bpr) * 128;
}
__device__ __forceinline__ void attn_stage(const Ctx& C, int gi, int x, LAS unsigned char* buf) {
    int b, kh, r, M0; attn_unit_decode(gi, x, b, kh, r, M0);
    const int dsh = 2 * gi, d = 1 << dsh, Ld = 8192 >> dsh, tid = C.tid;
    const bf16* kbase = (const bf16*)(C.ws + WS_KN) + (size_t)b * 8192 * 768 + gi * 256 + kh * 64;
    const bf16* vbase = (const bf16*)(C.ws + WS_VT) + ((size_t)(b * 12 + gi * 4 + kh) * 64) * 8192 + r * Ld;
    const unsigned wbase = (unsigned)(tid & ~63) * 16u;
#pragma unroll
    for (int i = 0; i < 4; ++i) { const int id = i * 512 + tid, row = id >> 3, c = id & 7; int m = M0 - 128 + row; m = m < 0 ? 0 : m;
        __builtin_amdgcn_global_load_lds((const unsigned*)(kbase + (size_t)(r + d * m) * 768 + ((c ^ ((row >> 1) & 7)) * 8)), (LAS unsigned*)(buf + i * 8192 + wbase), 16, 0, 0); }
#pragma unroll
    for (int i = 0; i < 4; ++i) { const int id = i * 512 + tid, row = id >> 5, c = id & 31; int p0 = M0 - 128 + ((c ^ (row & 15)) * 8); p0 = p0 < 0 ? 0 : p0;
        __builtin_amdgcn_global_load_lds((const unsigned*)(vbase + (size_t)row * 8192 + p0), (LAS unsigned*)(buf + 32768 + i * 8192 + wbase), 16, 0, 0); }
}

template <int GI0>
__device__ __forceinline__ void attn_band_phase(const Ctx& C, int j, unsigned pf_) {
    unsigned char* ws = C.ws;
    const int NU = GI0 ? 1024 : 512;
    const bf16* Q = (const bf16*)(ws + WS_Q); const bf16* GATE = (const bf16*)(ws + WS_GATE); bf16* OB = (bf16*)(ws + WS_OB);
    bf16* PART = (bf16*)(ws + WS_PART); float* LPART = (float*)(ws + WS_LPART);
    const float* ropec = (const float*)(ws + WS_ROPEC); const float* ropes = (const float*)(ws + WS_ROPES); const float* qnw = C.in[22] + j * 64;
    const int lane = C.lane, w = C.wave, fr = lane & 15, fq = lane >> 4, rep = w & 3, half = w >> 2;
    float cshift; { const float mq = wave_max(fabsf(qnw[lane])), mk = wave_max(fabsf(C.in[20][lane])); cshift = 8.f * mq * mk * 1.4426950408889634f; }
    __syncthreads();
    int u = C.vcu, bsel = 0;
    if (u < NU) attn_stage(C, GI0 ? 1 + (u >> 9) : 0, u & 511, C.lds);
#pragma unroll 1
    for (; u < NU; u += C.G, bsel ^= 1) {
        const int gi = GI0 ? 1 + (u >> 9) : 0; int b, kh, r, M0; attn_unit_decode(gi, u & 511, b, kh, r, M0);
        const int dsh = 2 * gi, d = 1 << dsh, head = kh * 4 + rep;
        LAS unsigned char* Kl = C.lds + bsel * 65536; LAS unsigned char* Vl = Kl + 32768;
        asm volatile("s_waitcnt vmcnt(0)" ::: "memory");
        __syncthreads();
        if (u + C.G < NU) attn_stage(C, GI0 ? 1 + ((u + C.G) >> 9) : 0, (u + C.G) & 511, C.lds + (bsel ^ 1) * 65536);
        if ((pf_ & 1u) && u + C.G < NU) attn_stage(C, GI0 ? 1 + ((u + C.G) >> 9) : 0, (u + C.G) & 511, C.lds + (bsel ^ 1) * 65536);
        {
            bf16x8 qf[4][2];
#pragma unroll
            for (int qt = 0; qt < 4; ++qt) {
                const int t = r + d * (M0 + half * 64 + qt * 16 + fr);
                const bf16* src = Q + (size_t)(b * 8192 + t) * 3072 + gi * 1024 + head * 64 + 8 * fq;
                float x[16]; unpack8(*(const u32x4*)src, x); unpack8(*(const u32x4*)(src + 32), x + 8);
                float ss = 0.f;
#pragma unroll
                for (int e = 0; e < 16; ++e) ss += x[e] * x[e];
                ss += __shfl_xor(ss, 16); ss += __shfl_xor(ss, 32);
                const float rs = rsqrtf(ss * (1.f / 64.f) + EPS);
                float o1[8], o2[8];
#pragma unroll
                for (int e = 0; e < 8; ++e) { const float x1 = x[e] * rs * qnw[8 * fq + e], x2 = x[8 + e] * rs * qnw[32 + 8 * fq + e];
                    const float c = ropec[t * 32 + 8 * fq + e], s = ropes[t * 32 + 8 * fq + e];
                    o1[e] = (x1 * c - x2 * s) * (0.125f * 1.4426950408889634f); o2[e] = (x2 * c + x1 * s) * (0.125f * 1.4426950408889634f); }
                qf[qt][0] = __builtin_bit_cast(bf16x8, pack8(o1)); qf[qt][1] = __builtin_bit_cast(bf16x8, pack8(o2));
                __builtin_amdgcn_sched_barrier(0);
            }
            f32x4 O[4][4]; float lsum[4];
#pragma unroll 1
            for (int rc = 0; rc < 1 + (int)((pf_ >> 1) & 1u); ++rc) {
#pragma unroll
            for (int a = 0; a < 4; ++a) { lsum[a] = 0.f;
#pragma unroll
                for (int c = 0; c < 4; ++c) O[a][c] = (f32x4){0.f, 0.f, 0.f, 0.f}; }
            const int Q0 = M0 + half * 64;
#pragma unroll 1
            for (int sk = 0; sk < 6; ++sk) {
                const int Rb = half * 64 + sk * 32, klo = M0 - 128 + Rb;
                bf16x8 kf[2][2], vf[4];
#pragma unroll
                for (int t16 = 0; t16 < 2; ++t16) { const int row = Rb + t16 * 16 + fr; const int sw = (fr >> 1) & 7;
                    kf[t16][0] = *(LAS bf16x8*)(Kl + row * 128 + ((fq ^ sw) * 16)); kf[t16][1] = *(LAS bf16x8*)(Kl + row * 128 + (((fq + 4) ^ sw) * 16)); }
#pragma unroll
                for (int dt = 0; dt < 4; ++dt) { const int row = dt * 16 + fr, ch = (Rb >> 3) + (fq >> 1);
                    const u32x2 lo = *(LAS u32x2*)(Vl + row * 512 + ((ch ^ fr) * 16) + (fq & 1) * 8), hi = *(LAS u32x2*)(Vl + row * 512 + (((ch + 2) ^ fr) * 16) + (fq & 1) * 8);
                    vf[dt] = __builtin_bit_cast(bf16x8, (u32x4){lo.x, lo.y, hi.x, hi.y}); }
#pragma unroll
                for (int qt = 0; qt < 4; ++qt) {
                    const int qlo = Q0 + qt * 16;
                    if (klo > qlo + 15 || klo + 31 < qlo - 128 || klo + 31 < 0) continue;
                    const bool full = (klo + 31 <= qlo) && (klo >= qlo + 15 - 128) && (klo >= 0);
                    const int mq = qlo + fr, lo_k = (mq - 128) > 0 ? (mq - 128) : 0;
                    f32x4 s0 = (f32x4){0.f, 0.f, 0.f, 0.f}, s1 = s0;
                    s0 = MFMA16(kf[0][0], qf[qt][0], s0); s1 = MFMA16(kf[1][0], qf[qt][0], s1);
                    s0 = MFMA16(kf[0][1], qf[qt][1], s0); s1 = MFMA16(kf[1][1], qf[qt][1], s1);
                    float p0[4], p1[4];
#pragma unroll
                    for (int e = 0; e < 4; ++e) { p0[e] = __builtin_amdgcn_exp2f(s0[e] - cshift); p1[e] = __builtin_amdgcn_exp2f(s1[e] - cshift); }
                    if (!full) {
#pragma unroll
                        for (int e = 0; e < 4; ++e) { const int ka = klo + 4 * fq + e, kc = ka + 16;
                            p0[e] = (ka >= lo_k && ka <= mq) ? p0[e] : 0.f; p1[e] = (kc >= lo_k && kc <= mq) ? p1[e] : 0.f; }
                    }
                    lsum[qt] += ((p0[0] + p0[1]) + (p0[2] + p0[3])) + ((p1[0] + p1[1]) + (p1[2] + p1[3]));
                    const bf16x8 pf = __builtin_bit_cast(bf16x8, (u32x4){pk2(p0[0], p0[1]), pk2(p0[2], p0[3]), pk2(p1[0], p1[1]), pk2(p1[2], p1[3])});
#pragma unroll
                    for (int dt = 0; dt < 4; ++dt) O[qt][dt] = MFMA16(vf[dt], pf, O[qt][dt]);
                }
            }
            }
            __syncthreads();
            LAS unsigned char* Ow = Kl + w * 8192; LAS float* lw = (LAS float*)(C.lds + 131072) + w * 64;
#pragma unroll
            for (int qt = 0; qt < 4; ++qt) {
                float l = lsum[qt]; l += __shfl_xor(l, 16); l += __shfl_xor(l, 32);
                if (fq == 0) lw[qt * 16 + fr] = l;
                const int row = qt * 16 + fr;
#pragma unroll
                for (int dt = 0; dt < 4; ++dt) { u32x2 o; o.x = pk2(O[qt][dt][0], O[qt][dt][1]); o.y = pk2(O[qt][dt][2], O[qt][dt][3]);
                    *(LAS u32x2*)(Ow + row * 128 + (((dt * 2 + (fq >> 1)) ^ (fr & 7)) * 16) + (fq & 1) * 8) = o; }
            }
            asm volatile("s_waitcnt lgkmcnt(0)" ::: "memory");
#pragma unroll 1
            for (int re = 0; re < 1 + (int)((pf_ >> 2) & 1u); ++re)
#pragma unroll
            for (int i = 0; i < 8; ++i) {
                const int row = i * 8 + (lane >> 3), c = lane & 7;
                const u32x4 ov = *(LAS u32x4*)(Ow + row * 128 + ((c ^ (row & 7)) * 16));
                const int t = r + d * (M0 + half * 64 + row);
                const size_t tok = (size_t)(b * 8192 + t), off = tok * 1024 + head * 64 + c * 8;
                if (GI0) {
                    *(u32x4*)(PART + (size_t)(gi - 1) * TP * 1024 + off) = ov;
                    if (c == 0) LPART[(size_t)(gi - 1) * TP * 16 + tok * 16 + head] = lw[row];
                } else {
                    const u32x4 a1 = *(const u32x4*)(PART + off), a2 = *(const u32x4*)(PART + (size_t)TP * 1024 + off), gr = *(const u32x4*)(GATE + off);
                    const float li = 1.f / (lw[row] + LPART[tok * 16 + head] + LPART[(size_t)TP * 16 + tok * 16 + head]);
                    float o8[8], x1[8], x2[8], g8[8]; unpack8(ov, o8); unpack8(a1, x1); unpack8(a2, x2); unpack8(gr, g8);
#pragma unroll
                    for (int e = 0; e < 8; ++e) o8[e] = (o8[e] + x1[e] + x2[e]) * li * silu_f(g8[e]);
                    *(u32x4*)(OB + off) = pack8(o8);
                }
            }
        }
    }
    asm volatile("s_waitcnt vmcnt(0)" ::: "memory");
    __syncthreads();
}

__device__ __forceinline__ void attn_sample_task(const Ctx& C, int j, int task, LAS float* wl) {
    unsigned char* ws = C.ws;
    const int t = task & 7, kh = (task >> 3) & 3, sb = task >> 5, lane = C.lane;
    const int row = TP + sb * 8 + t, pos = 8192 + t;
    const bf16* Q = (const bf16*)(ws + WS_Q); const bf16* GATE = (const bf16*)(ws + WS_GATE); bf16* OB = (bf16*)(ws + WS_OB);
    const float* KSS = (const float*)(ws + WS_KSS); const float* VSS = (const float*)(ws + WS_VSS);
    const float* ropec = (const float*)(ws + WS_ROPEC); const float* ropes = (const float*)(ws + WS_ROPES);
    const float* qnw = C.in[22] + j * 64;
    LAS float* qs = wl;
    LAS float* sc = wl + 768;
    const float cr = ropec[pos * 32 + (lane & 31)], sr = ropes[pos * 32 + (lane & 31)], wq = qnw[lane];
#pragma unroll
    for (int gi = 0; gi < 3; ++gi)
#pragma unroll
        for (int rep = 0; rep < 4; ++rep) {
            const float q = bf1(Q[(size_t)row * 3072 + gi * 1024 + (kh * 4 + rep) * 64 + lane]);
            const float ss = wave_sum(q * q);
            const float qn = q * rsqrtf(ss * (1.f / 64.f) + EPS) * wq;
            const float pr = __shfl_xor(qn, 32);
            const float o = (lane < 32) ? qn * cr - pr * sr : qn * cr + pr * sr;
            qs[(gi * 4 + rep) * 64 + lane] = o * 0.125f;
        }
    asm volatile("s_waitcnt lgkmcnt(0)" ::: "memory");
    const int kq = lane >> 4, c16 = lane & 15;
#pragma unroll 1
    for (int gi = 0; gi < 3; ++gi) {
        const int W = (gi == 0) ? 128 : (gi == 1) ? 512 : 2048, d = 1 << (2 * gi);
        const float* cache = C.in[4 + gi];
        f32x4 q4[4];
#pragma unroll
        for (int rep = 0; rep < 4; ++rep) q4[rep] = *(LAS f32x4*)(qs + (gi * 4 + rep) * 64 + 4 * c16);
#pragma unroll 1
        for (int it0 = 0; it0 < 33; it0 += 11) {
          f32x4 kv[11];
#pragma unroll
          for (int u = 0; u < 11; ++u) {
            int jj = (it0 + u) * 4 + kq; jj = jj <= 128 ? jj : 128;
            const int idx = W + t - jj * d;
            const float* src = (idx >= W) ? KSS + (size_t)(sb * 8 + idx - W) * 768 + gi * 256 + kh * 64 : cache + ((size_t)(sb * W + idx) * 2) * 256 + kh * 64;
            kv[u] = *(const f32x4*)(src + 4 * c16);
          }
#pragma unroll
          for (int u = 0; u < 11; ++u) {
            int jj = (it0 + u) * 4 + kq; const bool ok = jj <= 128; jj = ok ? jj : 128;
            const f32x4 k4 = kv[u];
            float mine = 0.f;
#pragma unroll
            for (int rep = 0; rep < 4; ++rep) {
                float s = (k4[0] * q4[rep][0] + k4[1] * q4[rep][1]) + (k4[2] * q4[rep][2] + k4[3] * q4[rep][3]);
                s += __shfl_xor(s, 1); s += __shfl_xor(s, 2); s += __shfl_xor(s, 4); s += __shfl_xor(s, 8);
                if (c16 == rep) mine = s;
            }
            if (c16 < 4 && ok) sc[(gi * 4 + c16) * 132 + jj] = mine;
          }
        }
    }
    asm volatile("s_waitcnt lgkmcnt(0)" ::: "memory");
    float linv[4];
#pragma unroll
    for (int rep = 0; rep < 4; ++rep) {
        float m = -3.0e38f;
#pragma unroll
        for (int gi = 0; gi < 3; ++gi)
            for (int jj = lane; jj <= 128; jj += 64) m = fmaxf(m, sc[(gi * 4 + rep) * 132 + jj]);
        m = wave_max(m);
        float sum = 0.f;
#pragma unroll
        for (int gi = 0; gi < 3; ++gi)
            for (int jj = lane; jj <= 128; jj += 64) { const float p = __expf(sc[(gi * 4 + rep) * 132 + jj] - m); sc[(gi * 4 + rep) * 132 + jj] = p; sum += p; }
        sum = wave_sum(sum);
        linv[rep] = 1.f / sum;
    }
    asm volatile("s_waitcnt lgkmcnt(0)" ::: "memory");
    f32x4 o[4];
#pragma unroll
    for (int rep = 0; rep < 4; ++rep) o[rep] = (f32x4){0.f, 0.f, 0.f, 0.f};
#pragma unroll 1
    for (int gi = 0; gi < 3; ++gi) {
        const int W = (gi == 0) ? 128 : (gi == 1) ? 512 : 2048, d = 1 << (2 * gi);
        const float* cache = C.in[4 + gi];
#pragma unroll 1
        for (int it0 = 0; it0 < 33; it0 += 11) {
          f32x4 vv[11];
#pragma unroll
          for (int u = 0; u < 11; ++u) {
            int jj = (it0 + u) * 4 + kq; jj = jj <= 128 ? jj : 128;
            const int idx = W + t - jj * d;
            const float* src = (idx >= W) ? VSS + (size_t)(sb * 8 + idx - W) * 768 + gi * 256 + kh * 64 : cache + ((size_t)(sb * W + idx) * 2 + 1) * 256 + kh * 64;
            vv[u] = *(const f32x4*)(src + 4 * c16);
          }
#pragma unroll
          for (int u = 0; u < 11; ++u) {
            int jj = (it0 + u) * 4 + kq; const bool ok = jj <= 128; jj = ok ? jj : 128;
            const f32x4 v4 = vv[u];
#pragma unroll
            for (int rep = 0; rep < 4; ++rep) { const float p = ok ? sc[(gi * 4 + rep) * 132 + jj] : 0.f; o[rep] += v4 * p; }
          }
        }
    }
#pragma unroll
    for (int rep = 0; rep < 4; ++rep)
#pragma unroll
        for (int e = 0; e < 4; ++e) { float v = o[rep][e]; v += __shfl_xor(v, 16); v += __shfl_xor(v, 32); o[rep][e] = v; }
    {
        f32x4 mine = o[0]; float li = linv[0];
#pragma unroll
        for (int rep = 1; rep < 4; ++rep) if (kq == rep) { mine = o[rep]; li = linv[rep]; }
        const size_t off = (size_t)row * 1024 + (kh * 4 + kq) * 64 + 4 * c16;
        const u32x2 gr = *(const u32x2*)(GATE + off);
        u32x2 w; w.x = pk2(mine[0] * li * silu_f(bflo(gr.x)), mine[1] * li * silu_f(bfhi(gr.x))); w.y = pk2(mine[2] * li * silu_f(bflo(gr.y)), mine[3] * li * silu_f(bfhi(gr.y)));
        *(u32x2*)(OB + off) = w;
    }
    asm volatile("s_waitcnt lgkmcnt(0)" ::: "memory");
}

constexpr int N_PHASES = 35;
#ifndef PH_MASK
#define PH_MASK 0xFFFFFFu
#endif
#define PHK(k) (((PH_MASK) >> (k)) & 1u)
#ifndef DUP_MASK
#define DUP_MASK 0ull
#endif
#ifndef MK_LAUNCH_PER_PHASE
#define MK_LAUNCH_PER_PHASE 0
#endif

__device__ __forceinline__ Ctx make_ctx(const Args& args, LAS unsigned char* lds) {
    Ctx C; int t = threadIdx.x; asm volatile("" : "+v"(t));
    int bx = blockIdx.x, G = gridDim.x; asm volatile("" : "+s"(bx), "+s"(G));
    C.lds = lds; C.tid = t; C.lane = t & 63; C.wave = __builtin_amdgcn_readfirstlane(t >> 6);
    C.G = G; C.vcu = (G % 8 == 0) ? (bx % 8) * (G / 8) + bx / 8 : bx;
    C.gw = C.vcu * 8 + C.wave; C.ngw = G * 8;
    C.in = args.in; C.out = args.out; C.ws = args.ws;
    return C;
}
template <class Epi> __device__ __forceinline__ void run_gemm(const Ctx& C, const bf16* A, const bf16* Bt, int N, int K, const Epi& E, int M = TT) {
    asm volatile("" : "+s"(K), "+s"(N), "+s"(M));
    pg8::Gemm g{A, Bt, M, N, K}; pg8::StaticOrder S; S.init(M, N, C.G, (int)blockIdx.x);
    pg8::gemm_phase<Epi, pg8::StaticOrder, true, true>(C.lds, g, S, E);
}

__global__ void __launch_bounds__(512, 2) mk_fwd(Args args) {
    extern __shared__ __attribute__((aligned(16))) unsigned char lds_raw[];
    LAS unsigned char* const ldsb = (LAS unsigned char*)lds_raw;
    for (int u = threadIdx.x; u < (LDS_BYTES - RING_BYTES) / 4; u += 512) ((LAS unsigned*)(ldsb + RING_BYTES))[u] = 0u;
    __syncthreads();
    const int lo = args.ph_lo, hi = args.ph_hi;
    if (hi - lo > 1) (void)xcd_barrier_post((unsigned*)(args.ws + WS_CTL) + CW_BAR, (volatile LAS unsigned*)(ldsb + MISC_OFF) + 8);
    for (int ph = lo; ph < hi; ++ph) {
        bool need_bar = true;
        const int nrep = 1 + (int)((args.dup >> ph) & 1ull);
#pragma unroll 1
        for (int rep = 0; rep < nrep; ++rep) {
        const Ctx C = make_ctx(args, ldsb);
        unsigned char* ws = C.ws;
        float* SSQ = (float*)(ws + WS_SSQ);
        bf16* HB0 = (bf16*)(ws + WS_HB); bf16* HB1 = (bf16*)C.out;
        bf16* PBUF[2] = {(bf16*)(ws + WS_PBUFA), (bf16*)(ws + WS_PBUFB)};
        bf16* PP = (bf16*)(ws + WS_PP);
        bf16* HB0w = rep ? (bf16*)(ws + WS_XT) : HB0; bf16* HB1w = rep ? (bf16*)(ws + WS_XT) : HB1; float* SSQd = SSQ + (size_t)8 * TT;
        float* Yfin = rep ? (float*)(ws + WS_ZB) : C.out;
        if (ph == 0) { if (PHK(0)) {
            const Ctx& Cp = C; p0_prologue(Cp);
            convert_p(Cp, 0, PBUF[0]);  }
        } else if (ph < 19) {
            const int i = (ph - 1) / 9, sub = (ph - 1) % 9;
            if (sub == 0) { if (PHK(1)) {
                EpiSplit<2048, 5120, 5120, 2048, 3072, 3072, true> E{SSQ + (size_t)(2 * i) * TT, (bf16*)(ws + WS_ZB), (bf16*)(ws + WS_XBC), nullptr, (float*)(ws + WS_DTRAW)};
                run_gemm(C, HB1, (const bf16*)(ws + (i ? WS_WIN1 : WS_WIN0)), MINP, 1024, E);  }
            } else if (sub == 1) { if (PHK(2)) {
                const Ctx& Cp = C; p2_conv(Cp, i);
                convert_p(Cp, i + 1, PBUF[(i + 1) & 1]);  }
            } else if (sub == 2) { need_bar = false; if (PHK(3)) {
                const Ctx& Cp = C; LAS float* wl = (LAS float*)(Cp.lds + Cp.wave * 16384);
                for (int task = Cp.gw; task < 1024; task += Cp.ngw) ssd_sample_task(Cp, i, task >> 5, task & 31, wl);  }
            } else if (sub == 3) { if (PHK(14)) {
                const Ctx& Cp = C; for (int task = Cp.ngw - 1 - Cp.gw; task < 4096; task += Cp.ngw) s1_task(Cp, task >> 5, task & 31);  }
            } else if (sub == 4) { if (PHK(4)) {
                const Ctx& Cp = C; s2_scan(Cp, i, rep);
                sample_norm(Cp);  }
            } else if (sub == 5) { if (PHK(5)) {
                const Ctx& Cp = C; for (int unit = Cp.vcu; unit < 512; unit += Cp.G) s3_unit(Cp, i, unit >> 2, unit & 3);  }
            } else if (sub == 6) { need_bar = false; if (PHK(6)) {
                EpiRes<0> E{HB1, HB0w, rep ? SSQd : SSQ + (size_t)(2 * i + 1) * TT, nullptr, nullptr, nullptr};
                run_gemm(C, (const bf16*)(ws + WS_YB), (const bf16*)(ws + (i ? WS_WOUT1 : WS_WOUT0)), 1024, 2048, E, TP);
                side_gemm<0>(C, (const bf16*)(ws + WS_YB), (const bf16*)(ws + (i ? WS_WOUT1 : WS_WOUT0)), 2048, HB1, HB0w, nullptr, E.ssq_out, nullptr, nullptr, nullptr); }
            } else if (sub == 7) { if (PHK(15)) {
                EpiPlain E2{PP, 1024};
                run_gemm(C, PBUF[i & 1], (const bf16*)(ws + WS_WP0 + (size_t)i * 512 * 1024), 1024, 256, E2, TP);
                side_gemm<2>(C, PBUF[i & 1], (const bf16*)(ws + WS_WP0 + (size_t)i * 512 * 1024), 256, nullptr, nullptr, nullptr, nullptr, nullptr, nullptr, PP); }
            } else { if (PHK(7)) {
                EpiRes<1> E{HB0, HB1w, rep ? SSQd : SSQ + (size_t)(2 * i + 2) * TT, SSQ + (size_t)(2 * i + 1) * TT, PP, nullptr};
                run_gemm(C, HB0, (const bf16*)(ws + WS_WG0 + (size_t)i * 2 * MiB), 1024, 1024, E, TP);
                side_gemm<1>(C, HB0, (const bf16*)(ws + WS_WG0 + (size_t)i * 2 * MiB), 1024, HB0, HB1w, nullptr, E.ssq_out, E.ssq_in, PP, nullptr); }
            }
        } else {
            const int j = (ph - 19) / 8, sub = (ph - 19) % 8, l = 2 + j;
            if (sub == 0) {
                if (j == 0) { if (PHK(8)) {
                    EpiSplit<1536, 4608, 5632, 1536, 3072, 1024, false> E{SSQ + (size_t)4 * TT, (bf16*)(ws + WS_KVRAW), (bf16*)(ws + WS_Q), (bf16*)(ws + WS_GATE), nullptr};
                    run_gemm(C, HB1, (const bf16*)(ws + WS_WKVA), 5632, 1024, E);  }
                } else { if (PHK(9)) {
                    EpiSplit<3072, 4096, 4096, 3072, 1024, 1024, false> E{SSQ + (size_t)6 * TT, (bf16*)(ws + WS_Q), (bf16*)(ws + WS_GATE), nullptr, nullptr};
                    run_gemm(C, HB1, (const bf16*)(ws + WS_WAIN1), 4096, 1024, E);  }
                }
            } else if (sub == 1) {
                if (j == 0) { if (PHK(10)) { const Ctx& Cp = C; p9_kvpass(Cp); convert_p(Cp, 3, PBUF[1]);  } } else need_bar = false;
            } else if (sub == 2) { need_bar = false; if (PHK(11)) {
                const Ctx& Cp = C; LAS float* wl = (LAS float*)(Cp.lds + Cp.wave * 16384);
                for (int task = Cp.gw; task < 1024; task += Cp.ngw) attn_sample_task(Cp, j, task, wl);  }
            } else if (sub == 3) { if (PHK(16)) {
                const Ctx& Cp = C; attn_band_phase<1>(Cp, j, (unsigned)(args.dup >> 60) & 7u); }
            } else if (sub == 4) { if (PHK(17)) {
                const Ctx& Cp = C; attn_band_phase<0>(Cp, j, (unsigned)(args.dup >> 60) & 7u); }
            } else if (sub == 5) { need_bar = false; if (PHK(12)) {
                EpiRes<0> E{HB1, HB0w, rep ? SSQd : SSQ + (size_t)(2 * l + 1) * TT, nullptr, nullptr, nullptr};
                run_gemm(C, (const bf16*)(ws + WS_OB), (const bf16*)(ws + (j ? WS_WAOUT1 : WS_WAOUT0)), 1024, 1024, E, TP);
                side_gemm<0>(C, (const bf16*)(ws + WS_OB), (const bf16*)(ws + (j ? WS_WAOUT1 : WS_WAOUT0)), 1024, HB1, HB0w, nullptr, E.ssq_out, nullptr, nullptr, nullptr); }
            } else if (sub == 6) { if (PHK(15)) {
                EpiPlain E2{PP, 1024};
                run_gemm(C, PBUF[l & 1], (const bf16*)(ws + WS_WP0 + (size_t)l * 512 * 1024), 1024, 256, E2, TP);
                side_gemm<2>(C, PBUF[l & 1], (const bf16*)(ws + WS_WP0 + (size_t)l * 512 * 1024), 256, nullptr, nullptr, nullptr, nullptr, nullptr, nullptr, PP); }
            } else { if (PHK(13)) {
                EpiRes<1> E{HB0, (l == 3 && !rep) ? nullptr : HB1w, rep ? SSQd : ((l < 3) ? SSQ + (size_t)(2 * l + 2) * TT : nullptr), SSQ + (size_t)(2 * l + 1) * TT, PP, (l == 3) ? Yfin : nullptr};
                run_gemm(C, HB0, (const bf16*)(ws + WS_WG0 + (size_t)l * 2 * MiB), 1024, 1024, E, TP);
                side_gemm<1>(C, HB0, (const bf16*)(ws + WS_WG0 + (size_t)l * 2 * MiB), 1024, HB0, E.Hout, E.Yf32, E.ssq_out, E.ssq_in, PP, nullptr); }
            }
        }
        }
        if (ph + 1 < hi && need_bar) { XcdBarrier bar; bar.bar = (unsigned*)(args.ws + WS_CTL) + CW_BAR; bar.x = xb_xcc_id(); bar.st = (volatile LAS unsigned*)(ldsb + MISC_OFF) + 8; xcd_barrier(bar); if (args.dup >> 63) xcd_barrier(bar); }
    }
}

extern "C" void kernel_launch(void* const* d_in, const int* in_sizes, int n_in, void* d_out, int out_size, void* d_ws, size_t ws_size, hipStream_t stream) {
    static int grid = 0;
    if (grid == 0) {
        int dev = 0, cus = 0;
        if (n_in != 27 || ws_size < WS_END) { fprintf(stderr, "kernel_launch: unexpected n_in %d or ws_size %zu\n", n_in, ws_size); grid = -1; return; }
        if (hipGetDevice(&dev) != hipSuccess || hipDeviceGetAttribute(&cus, hipDeviceAttributeMultiprocessorCount, dev) != hipSuccess) { grid = -1; return; }
        if (hipFuncSetAttribute((const void*)mk_fwd, hipFuncAttributeMaxDynamicSharedMemorySize, LDS_BYTES) != hipSuccess) { grid = -1; return; }
        grid = cus;
    }
    if (grid < 0) return;
    (void)hipMemsetAsync((char*)d_ws + WS_CTL, 0, WS_ZERO_BYTES, stream);
    Args a{};
    for (int i = 0; i < 27; ++i) a.in[i] = (const float*)d_in[i];
    a.out = (float*)d_out; a.ws = (unsigned char*)d_ws; a.dup = (unsigned long long)(DUP_MASK);
#if MK_LAUNCH_PER_PHASE
    for (int ph = 0; ph < N_PHASES; ++ph) { a.ph_lo = ph; a.ph_hi = ph + 1; hipLaunchKernelGGL(mk_fwd, dim3(grid), dim3(512), LDS_BYTES, stream, a); }
#else
    a.ph_lo = 0; a.ph_hi = N_PHASES;
    hipLaunchKernelGGL(mk_fwd, dim3(grid), dim3(512), LDS_BYTES, stream, a);
#endif
}
```
